# Optimizing an MI355X kernel written in HIP

```python
import math
import jax
import jax.numpy as jnp
from jax import lax
import numpy as np

D_MODEL = 1024
BATCH = 2
SEQ = 16384
DEPTH = 2

GRID_W = 64
CTX_LEN = 256
HEAD_DIM = 64
N_GROUP_HEADS = 4
NA_WIN_H = 8
NA_WIN_W = 16
MLA_Q_RANK = 256
MLA_KV_RANK = 128
MLA_NOPE_DIM = 64
MLA_ROPE_DIM = 32
MLA_V_DIM = 64
DIFF_QK_DIM = 32
DIFF_V_DIM = 64
GQA_KV_HEADS = 2
N_EXPERTS = 16
EC_CAPACITY = 2
D_FF_EXPERT = 2816
ROPE_THETA = 10000.0
NORM_EPS = 1e-6
Q_BLOCK = 128
N_MOD = 6

IN_SPLITS = (
    N_GROUP_HEADS * HEAD_DIM, N_GROUP_HEADS * HEAD_DIM, N_GROUP_HEADS * HEAD_DIM,
    MLA_Q_RANK, MLA_KV_RANK, MLA_ROPE_DIM,
    N_GROUP_HEADS * 2 * DIFF_QK_DIM, N_GROUP_HEADS * 2 * DIFF_QK_DIM, N_GROUP_HEADS * DIFF_V_DIM,
    N_GROUP_HEADS * HEAD_DIM, GQA_KV_HEADS * HEAD_DIM, GQA_KV_HEADS * HEAD_DIM,
)
D_IN = sum(IN_SPLITS)

kernel_name = 'hybrid_parallel_heads_ec_moe_diffusion'


def rms_norm(x, g):
    xf = x.astype(jnp.float32)
    y = xf * lax.rsqrt(jnp.mean(xf * xf, axis=-1, keepdims=True) + NORM_EPS)
    return (y * g.astype(jnp.float32)).astype(x.dtype)


def modulate(x, g, shift, scale):
    return rms_norm(x, g) * (1 + scale) + shift


def split_heads(t, n):
    return t.reshape(t.shape[:-1] + (n, t.shape[-1] // n))


def merge_heads(t):
    return t.reshape(t.shape[:-2] + (-1,))


def split_cols(t):
    pts, acc = [], 0
    for w in IN_SPLITS[:-1]:
        acc += w
        pts.append(acc)
    return jnp.split(t, pts, axis=-1)


def rope_1d(x, pos):
    n = x.shape[-1]
    inv = ROPE_THETA ** (-jnp.arange(0, n, 2, dtype=jnp.float32) / n)
    ang = pos.astype(jnp.float32)[:, None] * inv[None, :]
    bshape = (x.shape[1],) + (1,) * (x.ndim - 3) + (n // 2,)
    cos, sin = jnp.cos(ang).reshape(bshape), jnp.sin(ang).reshape(bshape)
    xf = x.astype(jnp.float32)
    x1, x2 = xf[..., : n // 2], xf[..., n // 2:]
    return jnp.concatenate([x1 * cos - x2 * sin, x1 * sin + x2 * cos], axis=-1).astype(x.dtype)


def rope_2d(x, row, col):
    half = x.shape[-1] // 2
    return jnp.concatenate([rope_1d(x[..., :half], row), rope_1d(x[..., half:], col)], axis=-1)


def attend(q, k, v):
    B, Sq, H, dk = q.shape
    scale = dk ** -0.5
    nb = Sq // Q_BLOCK
    qb = jnp.swapaxes(q.reshape(B, nb, Q_BLOCK, H, dk), 0, 1)

    def one_block(qblk):
        s = jnp.einsum('bqhd,bkhd->bhqk', qblk, k, preferred_element_type=jnp.float32) * scale
        p = jax.nn.softmax(s, axis=-1).astype(v.dtype)
        return jnp.einsum('bhqk,bkhd->bqhd', p, v)

    out = lax.map(one_block, qb)
    return jnp.swapaxes(out, 0, 1).reshape(B, Sq, H, v.shape[-1])


def neighbourhood_attend(q, k, v, kc, vc, rpb, rows):
    B, S, H, d = q.shape
    kh = min(NA_WIN_H, rows)
    n_loc = kh * NA_WIN_W
    scale = d ** -0.5
    qg = q.reshape(B, rows, GRID_W, H, d)
    kg = k.reshape(B, rows, GRID_W, H, d)
    vg = v.reshape(B, rows, GRID_W, H, d)
    cols = jnp.arange(GRID_W)
    col_idx = jnp.clip(cols - NA_WIN_W // 2, 0, GRID_W - NA_WIN_W)[:, None] + jnp.arange(NA_WIN_W)[None, :]
    col_bias_idx = col_idx - cols[:, None] + (NA_WIN_W - 1)

    def one_row(r):
        r0 = jnp.clip(r - kh // 2, 0, rows - kh)
        kr = lax.dynamic_slice_in_dim(kg, r0, kh, axis=1)[:, :, col_idx]
        vr = lax.dynamic_slice_in_dim(vg, r0, kh, axis=1)[:, :, col_idx]
        qr = lax.dynamic_index_in_dim(qg, r, axis=1, keepdims=False)
        row_bias_idx = r0 + jnp.arange(kh) - r + (NA_WIN_H - 1)
        bias = rpb[:, row_bias_idx[None, :, None], col_bias_idx[:, None, :]].astype(jnp.float32)
        s_loc = jnp.einsum('bqhd,bjqwhd->bhqjw', qr, kr, preferred_element_type=jnp.float32) * scale + bias[None]
        s_ctx = jnp.einsum('bqhd,bkhd->bhqk', qr, kc, preferred_element_type=jnp.float32) * scale
        p = jax.nn.softmax(jnp.concatenate([s_loc.reshape(B, H, GRID_W, n_loc), s_ctx], axis=-1), axis=-1).astype(v.dtype)
        p_loc = p[..., :n_loc].reshape(B, H, GRID_W, kh, NA_WIN_W)
        return (jnp.einsum('bhqjw,bjqwhd->bqhd', p_loc, vr)
                + jnp.einsum('bhqk,bkhd->bqhd', p[..., n_loc:], vc))

    out = lax.map(one_row, jnp.arange(rows))
    return jnp.swapaxes(out, 0, 1).reshape(B, S, H, d)


def na_mixer(p, pc, g_q, g_k, rpb, rows, need_ctx):
    q = rms_norm(split_heads(p[0], N_GROUP_HEADS), g_q)
    k = rms_norm(split_heads(p[1], N_GROUP_HEADS), g_k)
    v = split_heads(p[2], N_GROUP_HEADS)
    kc = rms_norm(split_heads(pc[1], N_GROUP_HEADS), g_k)
    vc = split_heads(pc[2], N_GROUP_HEADS)
    o = merge_heads(neighbourhood_attend(q, k, v, kc, vc, rpb, rows))
    oc = None
    if need_ctx:
        qc = rms_norm(split_heads(pc[0], N_GROUP_HEADS), g_q)
        oc = merge_heads(attend(qc, kc, vc))
    return o, oc


def mla_q(p_cq, g_cq, w_uq, g_q, pos):
    q = rms_norm(split_heads(rms_norm(p_cq, g_cq) @ w_uq, N_GROUP_HEADS), g_q)
    if pos is None:
        return q
    return jnp.concatenate([q[..., :MLA_NOPE_DIM], rope_2d(q[..., MLA_NOPE_DIM:], *pos)], axis=-1)


def mla_kv(p_ckv, p_kr, g_ckv, w_ukv, g_kn, g_kr, pos):
    kv = split_heads(rms_norm(p_ckv, g_ckv) @ w_ukv, N_GROUP_HEADS)
    k_nope = rms_norm(kv[..., :MLA_NOPE_DIM], g_kn)
    v = kv[..., MLA_NOPE_DIM:]
    k_rope = rms_norm(p_kr, g_kr)[:, :, None, :]
    if pos is not None:
        k_rope = rope_2d(k_rope, *pos)
    k = jnp.concatenate([k_nope, jnp.broadcast_to(k_rope, k_nope.shape[:-1] + (MLA_ROPE_DIM,))], axis=-1)
    return k, v


def mla_mixer(p, pc, g_cq, w_uq, g_q, g_ckv, w_ukv, g_kn, g_kr, pos, need_ctx):
    q = mla_q(p[0], g_cq, w_uq, g_q, pos)
    k, v = mla_kv(p[1], p[2], g_ckv, w_ukv, g_kn, g_kr, pos)
    kc, vc = mla_kv(pc[1], pc[2], g_ckv, w_ukv, g_kn, g_kr, None)
    o = merge_heads(attend(q, jnp.concatenate([kc, k], axis=1), jnp.concatenate([vc, v], axis=1)))
    oc = None
    if need_ctx:
        qc = mla_q(pc[0], g_cq, w_uq, g_q, None)
        oc = merge_heads(attend(qc, kc, vc))
    return o, oc


def diff_qk(t, g, pos):
    t = rms_norm(t.reshape(t.shape[:-1] + (N_GROUP_HEADS, 2, DIFF_QK_DIM)), g)
    return t if pos is None else rope_2d(t, *pos)


def diff_attend(q, k, v, lam, lam_init, g_sub):
    a1 = attend(q[..., 0, :], k[..., 0, :], v)
    a2 = attend(q[..., 1, :], k[..., 1, :], v)
    o = a1 - lam.astype(a1.dtype) * a2
    return merge_heads(rms_norm(o, g_sub) * (1 - lam_init))


def diff_mixer(p, pc, g_q, g_k, lam_p, g_sub, lam_init, pos, need_ctx):
    lp = lam_p.astype(jnp.float32)
    lam = jnp.exp(jnp.sum(lp[0] * lp[1])) - jnp.exp(jnp.sum(lp[2] * lp[3])) + lam_init
    q, k = diff_qk(p[0], g_q, pos), diff_qk(p[1], g_k, pos)
    v = split_heads(p[2], N_GROUP_HEADS)
    kc, vc = diff_qk(pc[1], g_k, None), split_heads(pc[2], N_GROUP_HEADS)
    o = diff_attend(q, jnp.concatenate([kc, k], axis=1), jnp.concatenate([vc, v], axis=1), lam, lam_init, g_sub)
    oc = None
    if need_ctx:
        oc = diff_attend(diff_qk(pc[0], g_q, None), kc, vc, lam, lam_init, g_sub)
    return o, oc


def gqa_kv(pk, pv, g_k, pos):
    rep = N_GROUP_HEADS // GQA_KV_HEADS
    k = rms_norm(split_heads(pk, GQA_KV_HEADS), g_k)
    if pos is not None:
        k = rope_2d(k, *pos)
    return jnp.repeat(k, rep, axis=2), jnp.repeat(split_heads(pv, GQA_KV_HEADS), rep, axis=2)


def gqa_q(pq, g_q, pos):
    q = rms_norm(split_heads(pq, N_GROUP_HEADS), g_q)
    return q if pos is None else rope_2d(q, *pos)


def gqa_mixer(p, pc, g_q, g_k, pos, need_ctx):
    q = gqa_q(p[0], g_q, pos)
    k, v = gqa_kv(p[1], p[2], g_k, pos)
    kc, vc = gqa_kv(pc[1], pc[2], g_k, None)
    o = merge_heads(attend(q, jnp.concatenate([kc, k], axis=1), jnp.concatenate([vc, v], axis=1)))
    oc = merge_heads(attend(gqa_q(pc[0], g_q, None), kc, vc)) if need_ctx else None
    return o, oc


def swiglu(xe, wg, wu, wd):
    return (jax.nn.silu(xe @ wg) * (xe @ wu)) @ wd


def expert_choice_ffn(h, w_router, w_gate, w_up, w_down):
    B, n, D = h.shape
    cap = EC_CAPACITY * n // N_EXPERTS
    logits = jnp.einsum('bnd,de->ben', h, w_router, preferred_element_type=jnp.float32)
    aff = jax.nn.softmax(logits, axis=1)
    gate, idx = lax.top_k(aff, cap)
    xe = jax.vmap(lambda hb, ib: hb[ib])(h, idx)
    ye = lax.map(lambda a: swiglu(*a), (jnp.swapaxes(xe, 0, 1), w_gate, w_up, w_down))
    ye = jnp.swapaxes(ye, 0, 1) * gate[..., None].astype(h.dtype)

    def combine(ib, yb):
        return jnp.zeros((n, D), yb.dtype).at[ib.reshape(-1)].add(yb.reshape(-1, D))

    return jax.vmap(combine)(idx, ye)


def setup_inputs(seed: int = 0) -> dict:
    key = jax.random.key(seed)
    ks = iter(jax.random.split(key, 32))
    L, D, H = DEPTH, D_MODEL, N_GROUP_HEADS

    def nrm(shape, s):
        return jax.random.normal(next(ks), shape, jnp.float32) * s

    def gain(shape):
        return 1.0 + nrm(shape, 0.02)

    return {
        'x': nrm((BATCH, SEQ, D), 1.0),
        'c': nrm((BATCH, D), 1.0),
        'ctx': nrm((BATCH, CTX_LEN, D), 1.0),
        'c_ctx': nrm((D,), 1.0),
        'w_mod': nrm((L, D, N_MOD * D), 0.5 * D ** -0.5),
        'b_mod': nrm((L, N_MOD * D), 0.01),
        'g_attn': gain((L, D)),
        'g_ffn': gain((L, D)),
        'w_in': nrm((L, D, D_IN), D ** -0.5),
        'g_na_q': gain((L, HEAD_DIM)),
        'g_na_k': gain((L, HEAD_DIM)),
        'na_rpb': nrm((L, H, 2 * NA_WIN_H - 1, 2 * NA_WIN_W - 1), 0.1),
        'g_mla_cq': gain((L, MLA_Q_RANK)),
        'w_mla_uq': nrm((L, MLA_Q_RANK, H * (MLA_NOPE_DIM + MLA_ROPE_DIM)), MLA_Q_RANK ** -0.5),
        'g_mla_q': gain((L, MLA_NOPE_DIM + MLA_ROPE_DIM)),
        'g_mla_ckv': gain((L, MLA_KV_RANK)),
        'w_mla_ukv': nrm((L, MLA_KV_RANK, H * (MLA_NOPE_DIM + MLA_V_DIM)), MLA_KV_RANK ** -0.5),
        'g_mla_k_nope': gain((L, MLA_NOPE_DIM)),
        'g_mla_k_rope': gain((L, MLA_ROPE_DIM)),
        'g_diff_q': gain((L, 2, DIFF_QK_DIM)),
        'g_diff_k': gain((L, 2, DIFF_QK_DIM)),
        'diff_lambda': nrm((L, 4, DIFF_QK_DIM), 0.1),
        'g_diff_sub': gain((L, DIFF_V_DIM)),
        'g_gqa_q': gain((L, HEAD_DIM)),
        'g_gqa_k': gain((L, HEAD_DIM)),
        'w_out': nrm((L, D, D), D ** -0.5),
        'w_router': nrm((L, D, N_EXPERTS), D ** -0.5),
        'w_gate': nrm((L, N_EXPERTS, D, D_FF_EXPERT), D ** -0.5),
        'w_up': nrm((L, N_EXPERTS, D, D_FF_EXPERT), D ** -0.5),
        'w_down': nrm((L, N_EXPERTS, D_FF_EXPERT, D), D_FF_EXPERT ** -0.5),
    }


def reference(x, c, ctx, c_ctx, w_mod, b_mod, g_attn, g_ffn, w_in, g_na_q, g_na_k, na_rpb,
              g_mla_cq, w_mla_uq, g_mla_q, g_mla_ckv, w_mla_ukv, g_mla_k_nope, g_mla_k_rope,
              g_diff_q, g_diff_k, diff_lambda, g_diff_sub, g_gqa_q, g_gqa_k, w_out,
              w_router, w_gate, w_up, w_down):
    B, S, D = x.shape
    rows = S // GRID_W
    t = jnp.arange(S, dtype=jnp.int32)
    pos = (t // GRID_W, t % GRID_W)
    xc = ctx
    silu_c = jax.nn.silu(c)
    silu_cc = jax.nn.silu(c_ctx)[None]
    for l in range(DEPTH):
        need_ctx = l < DEPTH - 1
        lam_init = 0.8 - 0.6 * math.exp(-0.3 * l)
        mod = jnp.split((silu_c @ w_mod[l] + b_mod[l])[:, None, :], N_MOD, axis=-1)
        mod_c = jnp.split((silu_cc @ w_mod[l] + b_mod[l])[:, None, :], N_MOD, axis=-1)

        p = split_cols(modulate(x, g_attn[l], mod[0], mod[1]) @ w_in[l])
        pc = split_cols(modulate(xc, g_attn[l], mod_c[0], mod_c[1]) @ w_in[l])
        o_na, oc_na = na_mixer(p[0:3], pc[0:3], g_na_q[l], g_na_k[l], na_rpb[l], rows, need_ctx)
        o_mla, oc_mla = mla_mixer(p[3:6], pc[3:6], g_mla_cq[l], w_mla_uq[l], g_mla_q[l], g_mla_ckv[l],
                                  w_mla_ukv[l], g_mla_k_nope[l], g_mla_k_rope[l], pos, need_ctx)
        o_diff, oc_diff = diff_mixer(p[6:9], pc[6:9], g_diff_q[l], g_diff_k[l], diff_lambda[l],
                                     g_diff_sub[l], lam_init, pos, need_ctx)
        o_gqa, oc_gqa = gqa_mixer(p[9:12], pc[9:12], g_gqa_q[l], g_gqa_k[l], pos, need_ctx)
        x = x + mod[2] * (jnp.concatenate([o_na, o_mla, o_diff, o_gqa], axis=-1) @ w_out[l])
        if need_ctx:
            xc = xc + mod_c[2] * (jnp.concatenate([oc_na, oc_mla, oc_diff, oc_gqa], axis=-1) @ w_out[l])

        x = x + mod[5] * expert_choice_ffn(modulate(x, g_ffn[l], mod[3], mod[4]),
                                           w_router[l], w_gate[l], w_up[l], w_down[l])
        if need_ctx:
            xc = xc + mod_c[5] * expert_choice_ffn(modulate(xc, g_ffn[l], mod_c[3], mod_c[4]),
                                                   w_router[l], w_gate[l], w_up[l], w_down[l])
    return x
```

```cpp
#include <hip/hip_runtime.h>
#include <cstdio>
#include <cstdint>
#ifndef MK_N_LAUNCHES
#define MK_N_LAUNCHES 1
#endif
#define MK_PROBE_KIND -1
#define MK_XPROBE 0
#define MK_PROBE_VAR 0
namespace pg8 {
#define PG8_LAS __attribute__((address_space(3)))
typedef unsigned short bf16_t;
typedef short bf16x8 __attribute__((ext_vector_type(8)));
typedef float f32x4 __attribute__((ext_vector_type(4)));
typedef unsigned u32x4 __attribute__((ext_vector_type(4)));
constexpr int BM = 256, BK = 64, HALF = 128, HTB = HALF * BK * 2  , STAGE_BYTES = 8 * HTB, NXCD = 8, WGM = 8;

__host__ __device__ __forceinline__ int lds_byte(int r, int c) { const int st = (r >> 4) * 2 + (c >> 5), rr = r & 15, cc = c & 31, ob = rr * 64 + cc * 2; return st * 1024 + (ob ^ (((ob >> 9) & 1) << 5)); }
__host__ __device__ __forceinline__ void stage_rc(int b, int& R, int& C) { const int st = b / 1024, sb = b % 1024, swz = sb ^ (((sb >> 9) & 1) << 5); R = (st >> 1) * 16 + swz / 64; C = (st & 1) * 32 + (swz % 64) / 2; }
__host__ __device__ __forceinline__ int perm32(int rho) { const int n = rho >> 4, i = rho & 15; return 8 * (i >> 2) + 4 * n + (i & 3); }

struct Unit { int pm, pn; };
struct Gemm { const bf16_t* A; const bf16_t* Bt; int M, N, K; };

struct StaticOrder {
    int nM, nN, nwg, G, c;
    __host__ __device__ void init(int M, int N, int G_, int c_) { nM = M / BM; nN = N / BM; nwg = nM * nN; G = G_; c = c_; }
    __host__ __device__ bool next(int i, Unit& u) const {
        const long L = (long)i * G + c; if (L >= nwg) return false;
        int wgid = (int)L; { const int q = nwg / NXCD, r = nwg % NXCD, xcd = wgid % NXCD, off = wgid / NXCD; wgid = (xcd < r ? xcd * (q + 1) : r * (q + 1) + (xcd - r) * q) + off; }
        const int nig = WGM * nN, gid = wgid / nig, fm = gid * WGM, gsz = (nM - fm) < WGM ? (nM - fm) : WGM;
        u.pm = fm + ((wgid % nig) % gsz); u.pn = (wgid % nig) / gsz; return true;
    }
    __device__ __forceinline__ void a_ready(const Unit&) const {}
    __device__ __forceinline__ void done(const Unit&) const {}
};

__device__ __forceinline__ unsigned cvt_pk_bf16(float lo, float hi) { unsigned r; asm volatile("v_cvt_pk_bf16_f32 %0, %1, %2" : "=v"(r) : "v"(lo), "v"(hi)); return r; }
typedef float f32x2 __attribute__((ext_vector_type(2)));
__device__ __forceinline__ f32x2 gelu_pk(f32x2 v) {
    const f32x2 av = __builtin_elementwise_abs(v), d = av * 0.2316418882f + 1.0f;
    f32x2 t; t.x = __builtin_amdgcn_rcpf(d.x); t.y = __builtin_amdgcn_rcpf(d.y);
    f32x2 q = t * 0.5307027145f + (-0.7265760135f); q = q * t + 0.7107068705f; q = q * t + (-0.142248368f); q = q * t + 0.127414796f; q = q * t;
    const f32x2 s = (v * v) * (-0.72134752044f);
    f32x2 e; e.x = __builtin_amdgcn_exp2f(s.x); e.y = __builtin_amdgcn_exp2f(s.y);
    const f32x2 m = v * (q * e), r = v - m;
    f32x2 o; o.x = v.x < 0.f ? m.x : r.x; o.y = v.y < 0.f ? m.y : r.y; return o;
}

template <int ACT  > struct EpiBf16 {
    static constexpr bool PERM = true, AFTER_DRAIN = false; static_assert(ACT == 0 || ACT == 1, "EpiBf16: ACT is 0 (none) or 1 (gelu_pk)");
    bf16_t* O; int ldc; const float* bias; int split_cols; size_t split_stride; float scale0;
    __device__ __forceinline__ void operator()(const f32x4 (&acc)[2][2][4][2], const Unit& u, int wr, int wc, int fr, int fq) const {
        const int row0 = u.pm * BM + wr * 64 + fr; int colt = u.pn * BM; bf16_t* base = O;
        float sc = 1.f; if (split_cols) { const int t = colt / split_cols; base += (size_t)t * split_stride; colt -= t * split_cols; if (t == 0) sc = scale0; }
        const int col0 = colt + wc * 32 + 8 * fq, bcol0 = u.pn * BM + wc * 32 + 8 * fq;
        f32x4 bv[2][2];
#pragma unroll
        for (int bj = 0; bj < 2; ++bj)
#pragma unroll
            for (int n = 0; n < 2; ++n) bv[bj][n] = bias ? *(const f32x4*)(bias + bcol0 + bj * HALF + 4 * n) : (f32x4){0.f, 0.f, 0.f, 0.f};
#pragma unroll
        for (int ai = 0; ai < 2; ++ai)
#pragma unroll
            for (int m = 0; m < 4; ++m) { bf16_t* rowp = base + (size_t)(row0 + ai * HALF + m * 16) * ldc + col0;
#pragma unroll
                for (int bj = 0; bj < 2; ++bj) { f32x4 v0 = acc[ai][bj][m][0] + bv[bj][0], v1 = acc[ai][bj][m][1] + bv[bj][1];
                    if (ACT == 1) { f32x2 a = gelu_pk((f32x2){v0[0], v0[1]}), b = gelu_pk((f32x2){v0[2], v0[3]}), c = gelu_pk((f32x2){v1[0], v1[1]}), d = gelu_pk((f32x2){v1[2], v1[3]});
                        v0 = (f32x4){a.x, a.y, b.x, b.y}; v1 = (f32x4){c.x, c.y, d.x, d.y}; }
                    v0 = v0 * sc; v1 = v1 * sc; u32x4 w; w.x = cvt_pk_bf16(v0[0], v0[1]); w.y = cvt_pk_bf16(v0[2], v0[3]); w.z = cvt_pk_bf16(v1[0], v1[1]); w.w = cvt_pk_bf16(v1[2], v1[3]);
                    *(u32x4*)(rowp + bj * HALF) = w; } }
    }
};
template <class S> constexpr bool sched_gather_v = false;
template <class Epi, class Sched, bool ALIGN_EPI = false, bool SP2 = false, bool HALF_ROWS = false, bool BTILED = false, bool ATILED = false>
__device__ __forceinline__ void gemm_phase(PG8_LAS unsigned char* lds, const Gemm g, const Sched& S, const Epi& E, int tid_in) {
    int tid_l = tid_in; asm volatile("" : "+v"(tid_l));
    const int tid = tid_l, wid = __builtin_amdgcn_readfirstlane(tid >> 6), lane = tid & 63, wr = wid >> 2, wc = wid & 3, fr = lane & 15, fq = lane >> 4;
    const int K = g.K, nt = K / BK;
    unsigned voffA[2], voffB[2];
#pragma unroll
    for (int i = 0; i < 2; ++i) { int R, C; stage_rc(tid * 16 + i * 8192, R, C); const int Rb = Epi::PERM ? ((R & ~31) + perm32(R & 31)) : R;
        voffA[i] = ATILED ? (unsigned)((R >> 5) * (K / 64) * 2048 + (R & 31) * 64 + C) * 2u : (unsigned)(R * K + C) * 2u; voffB[i] = BTILED ? (unsigned)((Rb >> 5) * (K / 64) * 2048 + (Rb & 31) * 64 + C) * 2u : (unsigned)(Rb * K + C) * 2u; }
    const size_t kstep = (size_t)(BK * 2);
    const size_t kstepA = ATILED ? (size_t)4096 : kstep;
    const size_t kstepB = BTILED ? (size_t)4096 : kstep;
    const size_t hstep = (size_t)HALF * K * 2;
    const size_t tstep = 2 * hstep;
    constexpr bool GATHER = sched_gather_v<Sched>;
    const size_t hstepA = GATHER ? (size_t)0 : hstep;
    const unsigned ldsw = (unsigned)wid * 1024u;
    const int aoff = lds_byte(wr * 64 + fr, fq * 8), boff = lds_byte(wc * 32 + fr, fq * 8);
#define PG8_SA(b, h) (((b) * 2 + (h)) * HTB)
#define PG8_SB(b, h) ((4 + (b) * 2 + (h)) * HTB)
#define PG8_STAGE(bufoff, gbase, voff) do { _Pragma("unroll") for (int _i = 0; _i < 2; ++_i) \
        __builtin_amdgcn_global_load_lds((const unsigned*)((const char*)(gbase) + (voff)[_i]), (PG8_LAS unsigned*)(lds + (bufoff) + ldsw + _i * 8192), 16, 0, 0); } while (0)
#define PG8_LDA(dst, b, h) do { _Pragma("unroll") for (int m = 0; m < 4; ++m) _Pragma("unroll") for (int k = 0; k < 2; ++k) dst[m][k] = *(const PG8_LAS bf16x8*)(lds + PG8_SA(b, h) + aoff + m * 2048 + k * 1024); } while (0)
#define PG8_LDB(dst, b, h) do { _Pragma("unroll") for (int n = 0; n < 2; ++n) _Pragma("unroll") for (int k = 0; k < 2; ++k) dst[n][k] = *(const PG8_LAS bf16x8*)(lds + PG8_SB(b, h) + boff + n * 2048 + k * 1024); } while (0)
#define PG8_MMA(ai, bj, At, Bt) do { __builtin_amdgcn_s_setprio(1); _Pragma("unroll") for (int m = 0; m < 4; ++m) _Pragma("unroll") for (int n = 0; n < 2; ++n) _Pragma("unroll") for (int k = 0; k < 2; ++k) \
        acc[ai][bj][m][n] = __builtin_amdgcn_mfma_f32_16x16x32_bf16(Bt[n][k], At[m][k], acc[ai][bj][m][n], 0, 0, 0); __builtin_amdgcn_s_setprio(0); } while (0)
#define PG8_WAIT_V(n) asm volatile("s_waitcnt vmcnt(" #n ")" ::: "memory")
#define PG8_WAIT_L(n) asm volatile("s_waitcnt lgkmcnt(" #n ")" ::: "memory")
#define PG8_BAR __builtin_amdgcn_s_barrier()
#define PG8_SCHED __builtin_amdgcn_sched_barrier(0)
    Unit cur, nxt; int ui = 0;
    if (!S.next(0, cur)) return;
    f32x4 acc[2][2][4][2];
#pragma unroll
    for (int a = 0; a < 2; ++a)
#pragma unroll
        for (int b = 0; b < 2; ++b)
#pragma unroll
            for (int m = 0; m < 4; ++m)
#pragma unroll
                for (int n = 0; n < 2; ++n) acc[a][b][m][n] = (f32x4){0.f, 0.f, 0.f, 0.f};
    bf16x8 At[4][2], B0[2][2], B1[2][2];
    const char* cA = GATHER ? (const char*)g.A : (const char*)g.A + (size_t)cur.pm * tstep; const char* cB = (const char*)g.Bt + (size_t)cur.pn * tstep;
    unsigned vA[2][2], nvA[2][2];
#define PG8_AOFF(dst, u) do { _Pragma("unroll") for (int _h = 0; _h < 2; ++_h) _Pragma("unroll") for (int _i = 0; _i < 2; ++_i) { \
        if constexpr (GATHER) { int R_, C_; stage_rc(tid * 16 + _i * 8192, R_, C_); dst[_h][_i] = (unsigned)S.aoff(u, _h * HALF + R_) * (unsigned)(K * 2) + (unsigned)(C_ * 2); } else dst[_h][_i] = voffA[_i]; } } while (0)
    PG8_AOFF(vA, cur);
#pragma unroll
    for (int _h = 0; _h < 2; ++_h)
#pragma unroll
        for (int _i = 0; _i < 2; ++_i) nvA[_h][_i] = vA[_h][_i];
    S.a_ready(cur);
    if constexpr (SP2) {
        PG8_STAGE(PG8_SB(0, 0), cB, voffB); PG8_STAGE(PG8_SB(0, 1), cB + hstep, voffB); PG8_STAGE(PG8_SA(0, 0), cA, vA[0]); PG8_STAGE(PG8_SA(0, 1), cA + hstepA, vA[1]);
        if (wr == 1) PG8_BAR;
        PG8_WAIT_V(2); PG8_BAR;
        PG8_STAGE(PG8_SB(1, 0), cB + kstepB, voffB); PG8_STAGE(PG8_SA(1, 0), cA + kstepA, vA[0]); PG8_STAGE(PG8_SB(1, 1), cB + hstep + kstepB, voffB);
        PG8_WAIT_V(6); PG8_BAR;
    } else {
        PG8_STAGE(PG8_SB(0, 0), cB, voffB); PG8_STAGE(PG8_SA(0, 0), cA, vA[0]); PG8_STAGE(PG8_SB(0, 1), cB + hstep, voffB); PG8_STAGE(PG8_SA(0, 1), cA + hstepA, vA[1]);
        if (wr == 1) PG8_BAR;
        PG8_WAIT_V(4); PG8_BAR;
        PG8_STAGE(PG8_SB(1, 0), cB + kstepB, voffB); PG8_STAGE(PG8_SA(1, 0), cA + kstepA, vA[0]); PG8_STAGE(PG8_SB(1, 1), cB + hstep + kstepB, voffB);
        PG8_WAIT_V(6); PG8_BAR;
    }
    for (;;) {
        const bool has_next = S.next(ui + 1, nxt);
        const char* nA = (has_next && !GATHER) ? (const char*)g.A + (size_t)nxt.pm * tstep : cA;
        if constexpr (GATHER) { if (has_next) PG8_AOFF(nvA, nxt); } const char* nB = has_next ? (const char*)g.Bt + (size_t)nxt.pn * tstep : cB;
#pragma unroll 1
        for (int t = 0; t < nt; t += 2) {
            const bool last = (t == nt - 2);
            const char* a1 = cA + (size_t)(t + 1) * kstepA;
            const char* a2 = last ? nA : cA + (size_t)(t + 2) * kstepA; const char* b2 = last ? nB : cB + (size_t)(t + 2) * kstepB;
            const char* a3 = a2 + kstepA; const char* b3 = b2 + kstepB;
            unsigned sA0[2], sA1[2]; sA0[0] = last ? nvA[0][0] : vA[0][0]; sA0[1] = last ? nvA[0][1] : vA[0][1]; sA1[0] = last ? nvA[1][0] : vA[1][0]; sA1[1] = last ? nvA[1][1] : vA[1][1];
            if (last && has_next) S.a_ready(nxt);
            if constexpr (SP2) {
            PG8_LDB(B0, 0, 0); PG8_LDB(B1, 0, 1); PG8_SCHED; PG8_LDA(At, 0, 0); PG8_STAGE(PG8_SA(1, 1), a1 + hstepA, vA[1]);
            PG8_WAIT_V(8); PG8_WAIT_L(0); PG8_BAR; if (!HALF_ROWS || wr == 0) { PG8_MMA(0, 0, At, B0); PG8_MMA(0, 1, At, B1); } PG8_BAR; PG8_SCHED;
            PG8_LDA(At, 0, 1); PG8_STAGE(PG8_SB(0, 0), b2, voffB); PG8_STAGE(PG8_SB(0, 1), b2 + hstep, voffB); PG8_STAGE(PG8_SA(0, 0), a2, sA0);
            PG8_WAIT_V(8); PG8_WAIT_L(0); PG8_BAR; if constexpr (!HALF_ROWS) { PG8_MMA(1, 0, At, B0); PG8_MMA(1, 1, At, B1); } PG8_BAR; PG8_SCHED;
            PG8_LDB(B0, 1, 0); PG8_LDB(B1, 1, 1); PG8_SCHED; PG8_LDA(At, 1, 0); PG8_STAGE(PG8_SA(0, 1), a2 + hstepA, sA1);
            PG8_WAIT_V(8); PG8_WAIT_L(0); PG8_BAR; if (!HALF_ROWS || wr == 0) { PG8_MMA(0, 0, At, B0); PG8_MMA(0, 1, At, B1); } PG8_BAR; PG8_SCHED;
            PG8_LDA(At, 1, 1); PG8_STAGE(PG8_SB(1, 0), b3, voffB); PG8_STAGE(PG8_SB(1, 1), b3 + hstep, voffB); PG8_STAGE(PG8_SA(1, 0), a3, sA0);
            PG8_WAIT_V(8); PG8_WAIT_L(0); PG8_BAR; if constexpr (!HALF_ROWS) { PG8_MMA(1, 0, At, B0); PG8_MMA(1, 1, At, B1); } PG8_BAR; PG8_SCHED;
            } else {
            PG8_LDB(B0, 0, 0); PG8_SCHED; PG8_LDA(At, 0, 0); PG8_STAGE(PG8_SA(1, 1), a1 + hstepA, vA[1]);
            PG8_WAIT_L(8); PG8_BAR; PG8_WAIT_L(0); PG8_MMA(0, 0, At, B0); PG8_BAR; PG8_SCHED;
            PG8_LDB(B1, 0, 1); PG8_STAGE(PG8_SB(0, 0), b2, voffB);
            PG8_BAR; PG8_WAIT_L(0); PG8_MMA(0, 1, At, B1); PG8_BAR;
            PG8_LDA(At, 0, 1); PG8_STAGE(PG8_SA(0, 0), a2, sA0);
            PG8_BAR; PG8_WAIT_L(0); PG8_MMA(1, 0, At, B0); PG8_BAR; PG8_SCHED;
            PG8_STAGE(PG8_SB(0, 1), b2 + hstep, voffB);
            PG8_WAIT_V(6); PG8_BAR; PG8_MMA(1, 1, At, B1); PG8_BAR;
            PG8_LDB(B0, 1, 0); PG8_SCHED; PG8_LDA(At, 1, 0); PG8_STAGE(PG8_SA(0, 1), a2 + hstepA, sA1);
            PG8_WAIT_L(8); PG8_BAR; PG8_WAIT_L(0); PG8_MMA(0, 0, At, B0); PG8_BAR; PG8_SCHED;
            PG8_LDB(B1, 1, 1); PG8_STAGE(PG8_SB(1, 0), b3, voffB);
            PG8_BAR; PG8_WAIT_L(0); PG8_MMA(0, 1, At, B1); PG8_BAR;
            PG8_LDA(At, 1, 1); PG8_STAGE(PG8_SA(1, 0), a3, sA0);
            PG8_BAR; PG8_WAIT_L(0); PG8_MMA(1, 0, At, B0); PG8_BAR; PG8_SCHED;
            PG8_STAGE(PG8_SB(1, 1), b3 + hstep, voffB);
            PG8_WAIT_V(6); PG8_BAR; PG8_MMA(1, 1, At, B1); PG8_BAR;
            }
        }
        if constexpr (ALIGN_EPI) { if (wr == 0) PG8_BAR; }
        if constexpr (!Epi::AFTER_DRAIN) { E(acc, cur, wr, wc, fr, fq); S.done(cur); }
        if (!has_next) break;
#pragma unroll
        for (int a = 0; a < 2; ++a)
#pragma unroll
            for (int b = 0; b < 2; ++b)
#pragma unroll
                for (int m = 0; m < 4; ++m)
#pragma unroll
                    for (int n = 0; n < 2; ++n) acc[a][b][m][n] = (f32x4){0.f, 0.f, 0.f, 0.f};
        cur = nxt; cA = nA; cB = nB; ++ui;
#pragma unroll
        for (int _h = 0; _h < 2; ++_h) { vA[_h][0] = nvA[_h][0]; vA[_h][1] = nvA[_h][1]; }
        if constexpr (ALIGN_EPI) { if (wr == 1) PG8_BAR; }
    }
    PG8_WAIT_V(0);
    if constexpr (!ALIGN_EPI) { if (wr == 0) PG8_BAR; }
    PG8_BAR;
    if constexpr (Epi::AFTER_DRAIN) { E.fused(acc, cur, wr, wc, fr, fq, lds, wid, lane); S.done(cur); }
#undef PG8_AOFF
#undef PG8_SA
#undef PG8_SB
#undef PG8_STAGE
#undef PG8_LDA
#undef PG8_LDB
#undef PG8_MMA
#undef PG8_WAIT_V
#undef PG8_WAIT_L
#undef PG8_BAR
#undef PG8_SCHED
}
}

namespace mk {
typedef unsigned short bf16;
typedef short bf16x8 __attribute__((ext_vector_type(8)));
typedef float f32x4 __attribute__((ext_vector_type(4)));
typedef float f32x16 __attribute__((ext_vector_type(16)));
typedef unsigned u32x4 __attribute__((ext_vector_type(4)));
typedef unsigned u32x2 __attribute__((ext_vector_type(2)));
#define LAS __attribute__((address_space(3)))
#define GAS __attribute__((address_space(1)))

constexpr int D = 1024, NB = 2, SEQ = 16384, CTXL = 256;
constexpr int NLAT = NB * SEQ, NCTX = NB * CTXL, NROW = NLAT + NCTX;
constexpr int NP = 2560;
constexpr int NTILE = 260;
constexpr int DFF = 2816, NE = 16;
constexpr int XE_LAT = 65536, XE_ALL = 69632;
constexpr float EPS = 1e-6f;
constexpr float LOG2E = 1.4426950408889634f;

constexpr size_t MiB = (size_t)1 << 20;
constexpr size_t WS_CTL = 0, CTL_ZERO_BYTES = 1 * MiB;
constexpr size_t WS_MOD = 1 * MiB;
constexpr size_t WS_LAM = WS_MOD + 160 * 1024;
constexpr size_t WS_ROPE = WS_MOD + 256 * 1024;
constexpr size_t WS_WIN = 2 * MiB, WS_W2 = 7 * MiB, WS_WOUT = 8 * MiB, WS_WGU = 16 * MiB, WS_WD = 192 * MiB;
constexpr size_t WS_X1 = 280 * MiB, WS_X2 = 410 * MiB, WS_H2 = 540 * MiB, WS_Y = 605 * MiB;
constexpr size_t WS_AFF = 741 * MiB, WS_SEL = 744 * MiB, WS_SRCROW = 747 * MiB, WS_GATEV = 747 * MiB + 512 * 1024;
constexpr size_t WS_H = 748 * MiB, WS_P = 813 * MiB, WS_A2 = 976 * MiB, WS_U = 1001 * MiB;
constexpr size_t WS_QNA = 1066 * MiB, WS_QMLA = 1083 * MiB, WS_QDIFF = 1108 * MiB, WS_QGQA = 1125 * MiB;
constexpr size_t WS_KNA = 1142 * MiB, WS_KMLA = 1159 * MiB, WS_KDIFF = 1184 * MiB, WS_KGQA = 1201 * MiB;
constexpr size_t WS_VNA = 1210 * MiB, WS_VMLA = 1227 * MiB, WS_VDIFF = 1244 * MiB, WS_VGQA = 1261 * MiB;
constexpr size_t WS_O = 1270 * MiB;
constexpr size_t WS_XE = 748 * MiB, WS_ACT = 884 * MiB;
constexpr size_t WS_END = 1336 * MiB;
constexpr size_t WS_X2B = 16 * MiB, WS_WGU1 = 410 * MiB, WS_WGU1B = 1345 * MiB, WS_NEED = 1400 * MiB;
constexpr int GU_SPLIT_E = 11, GU_GAP_TILES = (int)((WS_WGU1B - WS_WGU1 - (size_t)GU_SPLIT_E * 11 * MiB) / (512 * 1024));
static_assert(GU_GAP_TILES % 22 == 0 && GU_GAP_TILES > 0, "gate/up split");
constexpr size_t OUT_WD1 = 0, OUT_WIN1 = 88 * MiB, OUT_W21 = 93 * MiB, OUT_WOUT1 = 94 * MiB;
static_assert(WS_ACT + (size_t)XE_ALL * DFF * 2 <= WS_O + (size_t)NROW * D * 2 && WS_O + (size_t)NROW * D * 2 <= WS_END, "ws map");
static_assert(WS_XE + (size_t)XE_ALL * D * 2 <= WS_ACT && WS_P + (size_t)NROW * NP * 2 <= WS_A2 && WS_Y + (size_t)XE_ALL * D * 2 <= WS_AFF, "ws map");

constexpr int CW_TMO = 0, CW_BAR = 4096;

constexpr int RING_BYTES = 131072;
constexpr int MISC_OFF = RING_BYTES + 320;
constexpr int LDS_BYTES = 147456;

struct Args { const float* in[30]; float* out; unsigned char* ws; int ph_lo, ph_hi, li, pad; };
enum { I_X = 0, I_C, I_CTX, I_CCTX, I_WMOD, I_BMOD, I_GATTN, I_GFFN, I_WIN, I_GNAQ, I_GNAK, I_RPB, I_GCQ, I_WUQ, I_GMQ, I_GCKV, I_WUKV, I_GKN, I_GKR,
       I_GDQ, I_GDK, I_DLAM, I_GDSUB, I_GGQ, I_GGK, I_WOUT, I_WROUTER, I_WGATE, I_WUP, I_WDOWN };

__device__ __forceinline__ bf16* w_in(const Args& a, int l) { return (bf16*)(l == 0 ? a.ws + WS_WIN : (unsigned char*)a.out + OUT_WIN1); }
__device__ __forceinline__ bf16* w_2(const Args& a, int l) { return (bf16*)(l == 0 ? a.ws + WS_W2 : (unsigned char*)a.out + OUT_W21); }
__device__ __forceinline__ bf16* w_out(const Args& a, int l) { return (bf16*)(l == 0 ? a.ws + WS_WOUT : (unsigned char*)a.out + OUT_WOUT1); }
__device__ __forceinline__ bf16* w_gu(const Args& a, int l) { return (bf16*)(a.ws + (l == 0 ? WS_WGU : WS_WGU1)); }
__device__ __forceinline__ bf16* w_d(const Args& a, int l) { return (bf16*)(l == 0 ? a.ws + WS_WD : (unsigned char*)a.out + OUT_WD1); }
__device__ __forceinline__ float* x2_of(const Args& a) { return (float*)(a.ws + WS_X2B); }
#if defined(MK_PROBE_KIND) && MK_PROBE_KIND >= 0
#define PV(bit) ((a.pad >> (bit)) & 1)
#else
#define PV(bit) 0
#endif
__device__ __forceinline__ float bf2f(unsigned short h) { return __uint_as_float((unsigned)h << 16); }
typedef float f32x2_t __attribute__((ext_vector_type(2))); typedef __bf16 bf16x2_t __attribute__((ext_vector_type(2)));
__device__ __forceinline__ unsigned pk2(float lo, float hi) { f32x2_t v = {lo, hi}; bf16x2_t b = __builtin_convertvector(v, bf16x2_t); return __builtin_bit_cast(unsigned, b); }
__device__ __forceinline__ int lane_now() { int l; asm volatile("v_mbcnt_lo_u32_b32 %0, -1, 0\n\tv_mbcnt_hi_u32_b32 %0, -1, %0" : "=v"(l)); return l; }
__device__ __forceinline__ int shx_i(int v, int m) { return __builtin_amdgcn_ds_bpermute((lane_now() ^ m) << 2, v); }
__device__ __forceinline__ float shx(float v, int m) { return __int_as_float(shx_i(__float_as_int(v), m)); }
__device__ __forceinline__ float shl(float v, int src_lane) { return __int_as_float(__builtin_amdgcn_ds_bpermute(src_lane << 2, __float_as_int(v))); }
__device__ __forceinline__ float wave_sum(float v) {
#pragma unroll
    for (int o = 1; o < 64; o <<= 1) v += shx(v, o);
    return v;
}
__device__ __forceinline__ int mset_of_row(int m) { return m < SEQ ? 0 : (m < NLAT ? 1 : 2); }
#define LDS_WAIT() asm volatile("s_waitcnt lgkmcnt(0)" ::: "memory")
#define VM_WAIT() asm volatile("s_waitcnt vmcnt(0)" ::: "memory")

__device__ __forceinline__ void pro_phase(const Args& a, LAS unsigned char* lds, int tid, int bid, int G) {
    LAS float* sc = (LAS float*)lds;
    LAS float* part = sc + 3 * 1024;
    float* MOD = (float*)(a.ws + WS_MOD);
    for (int u = bid; u < 96; u += G) {
        const int l = u / 48, cb = (u % 48) * 128;
        for (int i = tid; i < 3 * 1024; i += 512) { const int s = i >> 10, k = i & 1023; const float cv = s < 2 ? a.in[I_C][s * 1024 + k] : a.in[I_CCTX][k]; sc[i] = cv / (1.f + expf(-cv)); }
        __syncthreads();
        const int col = tid & 127, kq = tid >> 7;
        const float* w = a.in[I_WMOD] + (size_t)l * 1024 * 6144 + cb + col;
        float a0 = 0.f, a1 = 0.f, a2 = 0.f;
#pragma unroll 1
        for (int k0 = kq * 256; k0 < kq * 256 + 256; k0 += 32) {
            float wv[32];
#pragma unroll
            for (int i = 0; i < 32; ++i) wv[i] = w[(size_t)(k0 + i) * 6144];
            __builtin_amdgcn_sched_barrier(0);
#pragma unroll
            for (int i = 0; i < 32; ++i) { a0 += sc[k0 + i] * wv[i]; a1 += sc[1024 + k0 + i] * wv[i]; a2 += sc[2048 + k0 + i] * wv[i]; }
        }
        part[(kq * 3 + 0) * 128 + col] = a0; part[(kq * 3 + 1) * 128 + col] = a1; part[(kq * 3 + 2) * 128 + col] = a2;
        __syncthreads();
        if (tid < 384) { const int s = tid >> 7, c = tid & 127;
            const float r = ((part[(0 * 3 + s) * 128 + c] + part[(1 * 3 + s) * 128 + c]) + (part[(2 * 3 + s) * 128 + c] + part[(3 * 3 + s) * 128 + c])) + a.in[I_BMOD][l * 6144 + cb + c];
            MOD[(l * 3 + s) * 6144 + cb + c] = r; }
        __syncthreads();
    }
    if (bid == 0 && tid < 2) {
        const float* lp = a.in[I_DLAM] + tid * 128; float s0 = 0.f, s1 = 0.f;
        for (int i = 0; i < 32; ++i) { s0 += lp[i] * lp[32 + i]; s1 += lp[64 + i] * lp[96 + i]; }
        const float lam_init = 0.8f - 0.6f * expf(-0.3f * (float)tid);
        ((float*)(a.ws + WS_LAM))[2 * tid] = expf(s0) - expf(s1) + lam_init; ((float*)(a.ws + WS_LAM))[2 * tid + 1] = 1.f - lam_init;
    }
}

__device__ __forceinline__ void conv_item(const float* src, size_t sld, bf16* dst, size_t dld, bool zero, LAS float* scr, int lane) {
    const int c = lane & 7;
    if (zero) {
#pragma unroll
        for (int j = 0; j < 4; ++j) { const int n = (lane >> 3) + 8 * j; *(u32x4*)(dst + (size_t)n * dld + 8 * c) = (u32x4){0u, 0u, 0u, 0u}; }
        return;
    }
    f32x4 v[8];
#pragma unroll
    for (int i = 0; i < 8; ++i) { const int kk = 8 * i + (lane >> 3), c4 = 4 * (lane & 7); v[i] = *(const f32x4*)(src + (size_t)kk * sld + c4); }
    __builtin_amdgcn_sched_barrier(0);
#pragma unroll
    for (int i = 0; i < 8; ++i) { const int kk = 8 * i + (lane >> 3), c4 = 4 * (lane & 7); LAS float* d = scr + kk * 33 + c4; d[0] = v[i].x; d[1] = v[i].y; d[2] = v[i].z; d[3] = v[i].w; }
    LDS_WAIT(); asm volatile("" ::: "memory");
#pragma unroll
    for (int j = 0; j < 4; ++j) { const int n = (lane >> 3) + 8 * j; const LAS float* s = scr + (8 * c) * 33 + n;
        u32x4 o; o.x = pk2(s[0 * 33], s[1 * 33]); o.y = pk2(s[2 * 33], s[3 * 33]); o.z = pk2(s[4 * 33], s[5 * 33]); o.w = pk2(s[6 * 33], s[7 * 33]);
        *(u32x4*)(dst + (size_t)n * dld + 8 * c) = o; }
    LDS_WAIT(); asm volatile("" ::: "memory");
}
constexpr int CV_WIN = 1280, CV_WOUT = 512, CV_W2 = 1024, CV_GU = 16 * 2816, CV_D = 16 * 1408, CV_ALL = CV_WIN + CV_WOUT + CV_W2 + CV_GU + CV_D;
__device__ __forceinline__ void conv_items(const Args& a, int l, int lo, int hi, LAS unsigned char* lds, int lane, int wave, int gw, int NGW) {
    LAS float* scr = (LAS float*)(lds + wave * 8704);
    bf16* WIN = w_in(a, l); bf16* W2 = w_2(a, l); bf16* WOUT = w_out(a, l); bf16* WGU = w_gu(a, l); bf16* WD = w_d(a, l);
    for (int it0 = lo + gw; it0 < hi; it0 += NGW) {
        int it = it0;
        if (it < CV_WIN) { const int kb = it / 80, nb = it % 80, n0 = 32 * nb, k0 = 64 * kb; const bool zero = n0 >= 2464;
            const int sc = n0 < 1152 ? n0 : (n0 < 2432 ? n0 + 32 : n0 - 2432 + 1152);
            conv_item(a.in[I_WIN] + (size_t)l * 1024 * 2464 + (size_t)k0 * 2464 + (zero ? 0 : sc), 2464, WIN + ((size_t)(n0 >> 5) * 16 + kb) * 2048, 64, zero, scr, lane); continue; }
        it -= CV_WIN;
        if (it < CV_WOUT) { const int kb = it / 32, nb = it % 32, n0 = 32 * nb, k0 = 64 * kb;
            conv_item(a.in[I_WOUT] + (size_t)l * 1024 * 1024 + (size_t)k0 * 1024 + n0, 1024, WOUT + ((size_t)(n0 >> 5) * 16 + kb) * 2048, 64, false, scr, lane); continue; }
        it -= CV_WOUT;
        if (it < CV_W2) { const int n = it;
#pragma unroll
            for (int i = 0; i < 6; ++i) { const int k = lane + 64 * i; float v = 0.f;
                if (n < 512) { const int h = n >> 7, j = n & 127; if (j < 96 && k < 256) v = a.in[I_WUQ][(size_t)l * 256 * 384 + (size_t)k * 384 + 96 * h + j]; }
                else { if (k >= 256) v = a.in[I_WUKV][(size_t)l * 128 * 512 + (size_t)(k - 256) * 512 + (n - 512)]; }
                W2[((((size_t)(n >> 5) * 24 + (k >> 4)) * 64) + ((k >> 3) & 1) * 32 + (n & 31)) * 8 + (k & 7)] = (bf16)(pk2(v, 0.f) & 0xffffu); }
            continue; }
        it -= CV_W2;
        if (it < CV_GU) { const int e = it / 2816, r = it % 2816, kb = r / 176, nb = r % 176, n0 = 32 * nb, k0 = 64 * kb, pn = n0 >> 8, half = (n0 >> 7) & 1, j0 = n0 & 127;
            const float* src = (half ? a.in[I_WUP] : a.in[I_WGATE]) + ((size_t)(l * 16 + e) * 1024 + k0) * 2816 + 128 * pn + j0;
            const size_t gap = (l == 1 && e >= GU_SPLIT_E) ? (size_t)GU_GAP_TILES * 256 * 1024 : 0;
            conv_item(src, 2816, WGU + ((size_t)((e * 5632 + n0) >> 5) * 16 + kb) * 2048 + gap, 64, false, scr, lane); continue; }
        it -= CV_GU;
        { const int e = it / 1408, r = it % 1408, kb = r / 32, nb = r % 32, n0 = 32 * nb, k0 = 64 * kb;
            conv_item(a.in[I_WDOWN] + ((size_t)(l * 16 + e) * 2816 + k0) * 1024 + n0, 1024, WD + ((size_t)((e * 1024 + n0) >> 5) * 44 + kb) * 2048, 64, false, scr, lane); }
    }
}

__device__ __forceinline__ int xe_rowbase(int set4, int e) { return set4 < 2 ? (set4 * 16 + e) * 2048 : XE_LAT + e * 256 + (set4 - 2) * 32; }
__device__ __forceinline__ void combine_row(const Args& a, int l, int m, int lane, f32x4 (&v)[4], const f32x4 (&g2)[4]) {
    const float* X1 = (const float*)(a.ws + WS_X1); const bf16* Y = (const bf16*)(a.ws + WS_Y); const int* SEL = (const int*)(a.ws + WS_SEL);
    const int set4 = m < SEQ ? 0 : (m < NLAT ? 1 : (m < NLAT + CTXL ? 2 : 3));
    f32x4 s[4];
#pragma unroll
    for (int j = 0; j < 4; ++j) s[j] = (f32x4){0.f, 0.f, 0.f, 0.f};
    f32x4 xr[4];
#pragma unroll
    for (int j = 0; j < 4; ++j) xr[j] = *(const f32x4*)(X1 + (size_t)m * D + 4 * lane + 256 * j);
#define ACC_Y(w_) do { _Pragma("unroll") for (int j = 0; j < 4; ++j) { s[j].x += __uint_as_float(w_[j].x << 16); s[j].y += __uint_as_float(w_[j].x & 0xffff0000u); s[j].z += __uint_as_float(w_[j].y << 16); s[j].w += __uint_as_float(w_[j].y & 0xffff0000u); } } while (0)
    const int myslot = (lane < 16) ? SEL[(size_t)m * 16 + lane] : -1;
    unsigned mask = (unsigned)__ballot(myslot >= 0);
    while (mask) {
        const int ea = __builtin_ctz(mask); mask &= mask - 1u;
        const bf16* ya = Y + (size_t)(xe_rowbase(set4, ea) + __builtin_amdgcn_readlane(myslot, ea)) * D + 4 * lane;
        u32x2 wa[4];
#pragma unroll
        for (int j = 0; j < 4; ++j) wa[j] = *(const u32x2*)(ya + 256 * j);
        if (mask) {
            const int eb = __builtin_ctz(mask); mask &= mask - 1u;
            const bf16* yb = Y + (size_t)(xe_rowbase(set4, eb) + __builtin_amdgcn_readlane(myslot, eb)) * D + 4 * lane;
            u32x2 wb[4];
#pragma unroll
            for (int j = 0; j < 4; ++j) wb[j] = *(const u32x2*)(yb + 256 * j);
            ACC_Y(wa); ACC_Y(wb);
        } else { ACC_Y(wa); }
    }
#undef ACC_Y
#pragma unroll
    for (int j = 0; j < 4; ++j) v[j] = xr[j] + g2[j] * s[j];
}
__device__ __forceinline__ void ld_gate2(const Args& a, int l, int set, int lane, f32x4 (&g2)[4]) {
    const float* MOD = (const float*)(a.ws + WS_MOD) + (size_t)(l * 3 + set) * 6144;
#pragma unroll
    for (int j = 0; j < 4; ++j) g2[j] = *(const f32x4*)(MOD + 5 * 1024 + 4 * lane + 256 * j);
}
__device__ __forceinline__ void modul_phase(const Args& a, int l, int lane, int wave, int vcu, int G) {
    const int gw = vcu * 8 + wave, NGW = G * 8;
    bf16* H = (bf16*)(a.ws + WS_H); float* X2 = x2_of(a);
    const float* gat = a.in[I_GATTN] + l * D;
    int cset = -1; f32x4 gg[4], sh[4], g2[4];
#pragma unroll
    for (int j = 0; j < 4; ++j) { gg[j] = (f32x4){0.f, 0.f, 0.f, 0.f}; sh[j] = gg[j]; g2[j] = gg[j]; }
    f32x4 vn[4];
#define MD_SRC(m_) ((m_) < NLAT ? a.in[I_X] + (size_t)(m_) * D : a.in[I_CTX] + (size_t)((m_) - NLAT) * D)
    if (l == 0 && gw < NROW) { const float* src = MD_SRC(gw);
#pragma unroll
        for (int j = 0; j < 4; ++j) vn[j] = *(const f32x4*)(src + 4 * lane + 256 * j); }
    for (int m = gw; m < NROW; m += NGW) {
        const int set = mset_of_row(m);
        if (set != cset) { cset = set; const float* MOD = (const float*)(a.ws + WS_MOD) + (size_t)(l * 3 + set) * 6144;
#pragma unroll
            for (int j = 0; j < 4; ++j) { const int c = 4 * lane + 256 * j; const f32x4 g = *(const f32x4*)(gat + c), scl = *(const f32x4*)(MOD + 1024 + c); sh[j] = *(const f32x4*)(MOD + c); gg[j] = g * (scl + 1.f); }
            if (l == 1) ld_gate2(a, 0, set, lane, g2); }
        f32x4 v[4];
        if (l == 0) {
#pragma unroll
            for (int j = 0; j < 4; ++j) v[j] = vn[j];
            if (m + NGW < NROW) { const float* src = MD_SRC(m + NGW);
#pragma unroll
                for (int j = 0; j < 4; ++j) vn[j] = *(const f32x4*)(src + 4 * lane + 256 * j); }
            __builtin_amdgcn_sched_barrier(0); }
        else { combine_row(a, 0, m, lane, v, g2);
#pragma unroll
            for (int j = 0; j < 4; ++j) *(f32x4*)(X2 + (size_t)m * D + 4 * lane + 256 * j) = v[j]; }
        float ss = 0.f;
#pragma unroll
        for (int j = 0; j < 4; ++j) ss += (v[j].x * v[j].x + v[j].y * v[j].y) + (v[j].z * v[j].z + v[j].w * v[j].w);
        const float rstd = rsqrtf(wave_sum(ss) * (1.f / D) + EPS);
#pragma unroll
        for (int j = 0; j < 4; ++j) { const int c = 4 * lane + 256 * j; const f32x4 h = v[j] * rstd * gg[j] + sh[j];
            u32x2 o; o.x = pk2(h.x, h.y); o.y = pk2(h.z, h.w); *(u32x2*)(H + (size_t)m * D + c) = o; }
    }
#undef MD_SRC
}
__device__ __forceinline__ void final_phase(const Args& a, int lane, int wave, int vcu, int G) {
    const int gw = vcu * 8 + wave, NGW = G * 8;
    int cset = -1; f32x4 g2[4];
#pragma unroll
    for (int j = 0; j < 4; ++j) g2[j] = (f32x4){0.f, 0.f, 0.f, 0.f};
    for (int m = gw; m < NLAT; m += NGW) {
        const int set = mset_of_row(m);
        if (set != cset) { cset = set; ld_gate2(a, 1, set, lane, g2); }
        f32x4 v[4]; combine_row(a, 1, m, lane, v, g2);
#pragma unroll
        for (int j = 0; j < 4; ++j) *(f32x4*)(a.out + (size_t)m * D + 4 * lane + 256 * j) = v[j];
    }
}
#define XB_TMO      128
#define XB_XCNT(j)  (256  + 64 * (j))
#define XB_XSUB(j)  (1280 + 64 * (j))
#define XB_XGEN(j)  (2304 + 64 * (j))
#define XB_TOP      3328
#define XB_TOPGEN   3392
#define XCD_BAR_WORDS 3456
#define XB_SPIN_CAP (1u << 18)

__device__ __forceinline__ unsigned xb_ld(unsigned* p)              { return __hip_atomic_load(p, __ATOMIC_RELAXED, __HIP_MEMORY_SCOPE_AGENT); }
__device__ __forceinline__ unsigned xb_add(unsigned* p, unsigned v) { return __hip_atomic_fetch_add(p, v, __ATOMIC_RELAXED, __HIP_MEMORY_SCOPE_AGENT); }
__device__ __forceinline__ unsigned xb_xcc_id() { return (unsigned)__builtin_amdgcn_s_getreg((3 << 11) | 20) & 0xFu; }
#define XB_SPIN(cond, bar) do { unsigned _sp = 0; while (cond) { __builtin_amdgcn_s_sleep(1); \
    if ((++_sp & 255u) == 0u) { if (xb_ld(&(bar)[XB_TMO])) break; if (_sp > XB_SPIN_CAP) { atomicAdd(&(bar)[XB_TMO], 1u); break; } } } } while (0)

struct XcdBarrier {
    unsigned* bar; unsigned x;
    volatile LAS unsigned* st;
};

__device__ __forceinline__ XcdBarrier xcd_barrier_post(unsigned* bar, volatile LAS unsigned* st, bool t0  ) {
    XcdBarrier b; b.bar = bar; b.x = xb_xcc_id(); b.st = st;
    if (t0) (void)xb_add(&bar[XB_XCNT(b.x)], 1u);
    return b;
}
__device__ __forceinline__ void xcd_barrier_complete(unsigned* bar, unsigned x, unsigned& nloc, unsigned& nx) {
    const unsigned G = gridDim.x * gridDim.y * gridDim.z;
    unsigned sum, cnt, mine, sp = 0u;
    for (;;) {
        sum = 0u; cnt = 0u; mine = 0u;
#pragma unroll
        for (unsigned j = 0; j < 16; ++j) { const unsigned c = xb_ld(&bar[XB_XCNT(j)]); sum += c; cnt += (c > 0u) ? 1u : 0u; mine = (j == x) ? c : mine; }
        if (sum == G) break;
        __builtin_amdgcn_s_sleep(1);
        if ((++sp & 255u) == 0u) { if (xb_ld(&bar[XB_TMO])) break; if (sp > XB_SPIN_CAP) { atomicAdd(&bar[XB_TMO], 1u); break; } }
    }
    nloc = mine > 0u ? mine : 1u; nx = cnt > 0u ? cnt : 1u;
}

__device__ __forceinline__ void xcd_barrier(const XcdBarrier& b, bool t0  ) {
    asm volatile("s_waitcnt vmcnt(0)" ::: "memory");
    __syncthreads();
    if (t0) {
        unsigned* bar = b.bar;
        __builtin_amdgcn_s_waitcnt(0);
        unsigned nloc = b.st[0], nx = b.st[1];
        if (nloc == 0u) { xcd_barrier_complete(bar, b.x, nloc, nx); b.st[0] = nloc; b.st[1] = nx; }
        const unsigned old = xb_add(&bar[XB_XSUB(b.x)], 1u);
        const unsigned gen = old / nloc;
        if (old + 1u == (gen + 1u) * nloc) {
            __builtin_amdgcn_fence(__ATOMIC_RELEASE, "agent");
            asm volatile("s_waitcnt vmcnt(0)" ::: "memory");
            const unsigned og = xb_add(&bar[XB_TOP], 1u);
            const unsigned tg = og / nx;
            if (og + 1u == (tg + 1u) * nx) xb_add(&bar[XB_TOPGEN], 1u);
            else XB_SPIN(xb_ld(&bar[XB_TOPGEN]) == tg, bar);
            __builtin_amdgcn_fence(__ATOMIC_ACQUIRE, "agent");
            xb_add(&bar[XB_XGEN(b.x)], 1u);
            asm volatile("s_waitcnt vmcnt(0)" ::: "memory");
        } else {
            XB_SPIN(xb_ld(&bar[XB_XGEN(b.x)]) == gen, bar);
            __builtin_amdgcn_fence(__ATOMIC_ACQUIRE, "agent");
            asm volatile("s_waitcnt vmcnt(0)" ::: "memory");
        }
    }
    __syncthreads();
}

struct TokTile { int m0; int b; int ktile; int prow; bool lat; };
__device__ __forceinline__ TokTile tok_tile(int T) {
    TokTile t; t.m0 = 64 * T;
    if (T < 512) { t.b = T >> 8; t.prow = T & 255; t.ktile = 4 + t.prow; t.lat = true; }
    else { const int c = T - 512; t.b = c >> 2; t.ktile = c & 3; t.prow = 0; t.lat = false; }
    return t;
}
template <int N> __device__ __forceinline__ void ld_row(const bf16* p, float (&v)[N]) {
#pragma unroll
    for (int i = 0; i < N / 8; ++i) { const u32x4 w = *(const u32x4*)(p + 8 * i);
        v[8 * i + 0] = __uint_as_float(w.x << 16); v[8 * i + 1] = __uint_as_float(w.x & 0xffff0000u); v[8 * i + 2] = __uint_as_float(w.y << 16); v[8 * i + 3] = __uint_as_float(w.y & 0xffff0000u);
        v[8 * i + 4] = __uint_as_float(w.z << 16); v[8 * i + 5] = __uint_as_float(w.z & 0xffff0000u); v[8 * i + 6] = __uint_as_float(w.w << 16); v[8 * i + 7] = __uint_as_float(w.w & 0xffff0000u); }
}
template <int N> __device__ __forceinline__ void up_row(const u32x4 (&raw)[8], float (&v)[N]) {
#pragma unroll
    for (int i = 0; i < N / 8; ++i) { const u32x4 w = raw[i];
        v[8 * i + 0] = __uint_as_float(w.x << 16); v[8 * i + 1] = __uint_as_float(w.x & 0xffff0000u); v[8 * i + 2] = __uint_as_float(w.y << 16); v[8 * i + 3] = __uint_as_float(w.y & 0xffff0000u);
        v[8 * i + 4] = __uint_as_float(w.z << 16); v[8 * i + 5] = __uint_as_float(w.z & 0xffff0000u); v[8 * i + 6] = __uint_as_float(w.w << 16); v[8 * i + 7] = __uint_as_float(w.w & 0xffff0000u); }
}
template <int N> __device__ __forceinline__ void rms_gain(float (&v)[N], const float* g) {
    float ss = 0.f;
#pragma unroll
    for (int i = 0; i < N; ++i) ss += v[i] * v[i];
    const float r = rsqrtf(ss * (1.f / N) + EPS);
#pragma unroll
    for (int i = 0; i < N; ++i) v[i] = v[i] * r * g[i];
}
constexpr float ROPE_INVR[16] = {1.591549431e-01f, 8.949940161e-02f, 5.032921210e-02f, 2.830219583e-02f, 1.591549431e-02f, 8.949940161e-03f, 5.032921210e-03f, 2.830219583e-03f,
                                 1.591549431e-03f, 8.949940161e-04f, 5.032921210e-04f, 2.830219583e-04f, 1.591549431e-04f, 8.949940161e-05f, 5.032921210e-05f, 2.830219583e-05f};
template <int OFF, int NR, int N> __device__ __forceinline__ void rope2d(float (&v)[N], float tr, float tc) {
    constexpr int Q = NR / 4, FS = 64 / NR;
#pragma unroll
    for (int d = 0; d < Q; ++d) {
        { const float t = __builtin_amdgcn_fractf(tr * ROPE_INVR[FS * d]); const float c = __builtin_amdgcn_cosf(t), s = __builtin_amdgcn_sinf(t); const float x1 = v[OFF + d], x2 = v[OFF + Q + d]; v[OFF + d] = x1 * c - x2 * s; v[OFF + Q + d] = x1 * s + x2 * c; }
        { const float t = __builtin_amdgcn_fractf(tc * ROPE_INVR[FS * d]); const float c = __builtin_amdgcn_cosf(t), s = __builtin_amdgcn_sinf(t); const float x1 = v[OFF + 2 * Q + d], x2 = v[OFF + 3 * Q + d]; v[OFF + 2 * Q + d] = x1 * c - x2 * s; v[OFF + 3 * Q + d] = x1 * s + x2 * c; }
    }
}
template <int N> __device__ __forceinline__ void st_row(bf16* p, const float (&v)[N], float sc) {
#pragma unroll
    for (int i = 0; i < N / 8; ++i) { u32x4 w; w.x = pk2(v[8 * i] * sc, v[8 * i + 1] * sc); w.y = pk2(v[8 * i + 2] * sc, v[8 * i + 3] * sc); w.z = pk2(v[8 * i + 4] * sc, v[8 * i + 5] * sc); w.w = pk2(v[8 * i + 6] * sc, v[8 * i + 7] * sc);
        *(u32x4*)(p + 8 * i) = w; }
}
template <int N> __device__ __forceinline__ void st_ktile(bf16* tile, int chunk0, const float (&v)[N], int lane) {
#pragma unroll
    for (int i = 0; i < N / 8; ++i) { u32x4 w; w.x = pk2(v[8 * i], v[8 * i + 1]); w.y = pk2(v[8 * i + 2], v[8 * i + 3]); w.z = pk2(v[8 * i + 4], v[8 * i + 5]); w.w = pk2(v[8 * i + 6], v[8 * i + 7]);
        *(u32x4*)(tile + (size_t)(chunk0 + i) * 512 + lane * 8) = w; }
}
__device__ __forceinline__ void st_vtile(bf16* tile, const float (&v)[64], LAS bf16* scr, int lane) {
#pragma unroll
    for (int dv = 0; dv < 64; dv += 2) { const unsigned w = pk2(v[dv], v[dv + 1]); scr[dv * 72 + lane] = (bf16)(w & 0xffffu); scr[(dv + 1) * 72 + lane] = (bf16)(w >> 16); }
    LDS_WAIT(); asm volatile("" ::: "memory");
#pragma unroll
    for (int kc = 0; kc < 8; ++kc) { const u32x4 w = *(const LAS u32x4*)(scr + lane * 72 + kc * 8); *(u32x4*)(tile + (size_t)kc * 512 + lane * 8) = w; }
    LDS_WAIT(); asm volatile("" ::: "memory");
}
template <int N> __device__ __forceinline__ void ld_row_oct(const bf16* p, float (&v)[N]) {
#pragma unroll
    for (int i = 0; i < N / 8; ++i) { const u32x4 w = *(const u32x4*)(p + 512 * i);
        v[8 * i + 0] = __uint_as_float(w.x << 16); v[8 * i + 1] = __uint_as_float(w.x & 0xffff0000u); v[8 * i + 2] = __uint_as_float(w.y << 16); v[8 * i + 3] = __uint_as_float(w.y & 0xffff0000u);
        v[8 * i + 4] = __uint_as_float(w.z << 16); v[8 * i + 5] = __uint_as_float(w.z & 0xffff0000u); v[8 * i + 6] = __uint_as_float(w.w << 16); v[8 * i + 7] = __uint_as_float(w.w & 0xffff0000u); }
}
template <int NCH> __device__ __forceinline__ void norm_wide(const bf16* src, const float* g, bf16* a2f, int m, int k0) {
    float ss = 0.f;
    { u32x4 w[NCH * 8];
#pragma unroll
      for (int i = 0; i < NCH * 8; ++i) w[i] = *(const u32x4*)(src + 512 * i);
      __builtin_amdgcn_sched_barrier(0);
#pragma unroll
      for (int i = 0; i < NCH * 8; ++i) { const float a0 = __uint_as_float(w[i].x << 16), a1 = __uint_as_float(w[i].x & 0xffff0000u), a2 = __uint_as_float(w[i].y << 16), a3 = __uint_as_float(w[i].y & 0xffff0000u),
                                                      a4 = __uint_as_float(w[i].z << 16), a5 = __uint_as_float(w[i].z & 0xffff0000u), a6 = __uint_as_float(w[i].w << 16), a7 = __uint_as_float(w[i].w & 0xffff0000u);
          ss += ((a0 * a0 + a1 * a1) + (a2 * a2 + a3 * a3)) + ((a4 * a4 + a5 * a5) + (a6 * a6 + a7 * a7)); } }
    const float r = rsqrtf(ss * (1.f / (64 * NCH)) + EPS);
    asm volatile("" ::: "memory");
    { u32x4 w[NCH * 8];
#pragma unroll
      for (int i = 0; i < NCH * 8; ++i) w[i] = *(const u32x4*)(src + 512 * i);
      __builtin_amdgcn_sched_barrier(0);
#pragma unroll
      for (int i = 0; i < NCH * 8; ++i) { const float* gi = g + 8 * i; const int k = k0 + 8 * i;
          const float a0 = __uint_as_float(w[i].x << 16) * r * gi[0], a1 = __uint_as_float(w[i].x & 0xffff0000u) * r * gi[1], a2 = __uint_as_float(w[i].y << 16) * r * gi[2], a3 = __uint_as_float(w[i].y & 0xffff0000u) * r * gi[3],
                      a4 = __uint_as_float(w[i].z << 16) * r * gi[4], a5 = __uint_as_float(w[i].z & 0xffff0000u) * r * gi[5], a6 = __uint_as_float(w[i].w << 16) * r * gi[6], a7 = __uint_as_float(w[i].w & 0xffff0000u) * r * gi[7];
          u32x4 o; o.x = pk2(a0, a1); o.y = pk2(a2, a3); o.z = pk2(a4, a5); o.w = pk2(a6, a7);
          *(u32x4*)(a2f + ((((size_t)(m >> 5) * 24 + (k >> 4)) * 64) + ((k >> 3) & 1) * 32 + (m & 31)) * 8) = o; } }
}
constexpr int NJ1 = 43, NJ2 = 12, NTT = NROW / 64;
constexpr float C2_64 = 0.125f * LOG2E, C2_32 = 0.17677669529663687f * LOG2E, C2_96 = 0.10206207261596575f * LOG2E;
__device__ __forceinline__ bf16* ktile_ptr(unsigned char* ws, size_t off, int nheads, int dk, int b, int h, int kt) { return (bf16*)(ws + off) + ((size_t)(b * nheads + h) * NTILE + kt) * (size_t)(64 * dk); }

__device__ __forceinline__ int job1_col(int j) {
    if (j < 4) return 64 * j; if (j < 8) return 256 + 64 * (j - 4); if (j < 12) return 512 + 64 * (j - 8); if (j == 12) return 768; if (j == 13) return 1024; if (j == 14) return 2432;
    if (j < 23) return 1152 + 32 * (j - 15); if (j < 31) return 1408 + 32 * (j - 23); if (j < 35) return 1664 + 64 * (j - 31); if (j < 39) return 1920 + 64 * (j - 35); if (j < 41) return 2176 + 64 * (j - 39);
    return 2304 + 64 * (j - 41);
}
__device__ __forceinline__ void prep1_phase(const Args& a, int l, LAS unsigned char* lds, int lane_in, int wave, int vcu, int G) {
    LAS bf16* scr = (LAS bf16*)(lds + wave * 9216);
    const int gw = vcu * 8 + wave, NGW = G * 8;
    const bf16* P = (const bf16*)(a.ws + WS_P);
    u32x4 raw[8];
#define P1_LOAD(it_, lane_) do { const int T_ = (it_) / NJ1, j_ = (it_) % NJ1; const bf16* p_ = P + (((size_t)T_ * (NP / 8) + (job1_col(j_) >> 3)) * 64 + (lane_)) * 8; _Pragma("unroll") for (int i_ = 0; i_ < 8; ++i_) raw[i_] = *(const u32x4*)(p_ + 512 * i_); } while (0)
#define P1_NEXT() do { if (it + NGW < NTT * NJ1) P1_LOAD(it + NGW, lane); __builtin_amdgcn_sched_barrier(0); } while (0)
    if (gw < NTT * NJ1) P1_LOAD(gw, lane_in);
    for (int it = gw; it < NTT * NJ1; it += NGW) {
        int lane = lane_in; asm volatile("" : "+v"(lane));
        const int T = it / NJ1, j = it % NJ1; const TokTile tt = tok_tile(T); const int m = tt.m0 + lane;
        const float tr = (float)tt.prow, tc = (float)lane;
        if (j < 4) { float v[64]; up_row<64>(raw, v); P1_NEXT(); rms_gain<64>(v, a.in[I_GNAQ] + l * 64); st_row<64>((bf16*)(a.ws + WS_QNA) + (size_t)m * 256 + 64 * j, v, C2_64); }
        else if (j < 8) { const int h = j - 4; float v[64]; up_row<64>(raw, v); P1_NEXT(); rms_gain<64>(v, a.in[I_GNAK] + l * 64); st_ktile<64>(ktile_ptr(a.ws, WS_KNA, 4, 64, tt.b, h, tt.ktile), 0, v, lane); }
        else if (j < 12) { const int h = j - 8; float v[64]; up_row<64>(raw, v); P1_NEXT(); st_vtile(ktile_ptr(a.ws, WS_VNA, 4, 64, tt.b, h, tt.ktile), v, scr, lane); }
        else if (j == 12) { P1_NEXT(); norm_wide<4>(P + (((size_t)T * (NP / 8) + 96) * 64 + lane) * 8, a.in[I_GCQ] + l * 256, (bf16*)(a.ws + WS_A2), m, 0); }
        else if (j == 13) { P1_NEXT(); norm_wide<2>(P + (((size_t)T * (NP / 8) + 128) * 64 + lane) * 8, a.in[I_GCKV] + l * 128, (bf16*)(a.ws + WS_A2), m, 256); }
        else if (j == 14) { float v[32]; up_row<32>(raw, v); P1_NEXT(); rms_gain<32>(v, a.in[I_GKR] + l * 32); if (tt.lat) rope2d<0, 32, 32>(v, tr, tc);
#pragma unroll
            for (int h = 0; h < 4; ++h) st_ktile<32>(ktile_ptr(a.ws, WS_KMLA, 4, 96, tt.b, h, tt.ktile), 8, v, lane); }
        else if (j < 23) { const int h = (j - 15) >> 1, c = (j - 15) & 1; float v[32]; up_row<32>(raw, v); P1_NEXT(); rms_gain<32>(v, a.in[I_GDQ] + l * 64 + 32 * c); if (tt.lat) rope2d<0, 32, 32>(v, tr, tc);
            st_row<32>((bf16*)(a.ws + WS_QDIFF) + (size_t)m * 256 + 64 * h + 32 * c, v, C2_32); }
        else if (j < 31) { const int h = (j - 23) >> 1, c = (j - 23) & 1; float v[32]; up_row<32>(raw, v); P1_NEXT(); rms_gain<32>(v, a.in[I_GDK] + l * 64 + 32 * c); if (tt.lat) rope2d<0, 32, 32>(v, tr, tc);
            st_ktile<32>(ktile_ptr(a.ws, WS_KDIFF, 4, 64, tt.b, h, tt.ktile), 4 * c, v, lane); }
        else if (j < 35) { const int h = j - 31; float v[64]; up_row<64>(raw, v); P1_NEXT(); st_vtile(ktile_ptr(a.ws, WS_VDIFF, 4, 64, tt.b, h, tt.ktile), v, scr, lane); }
        else if (j < 39) { const int h = j - 35; float v[64]; up_row<64>(raw, v); P1_NEXT(); rms_gain<64>(v, a.in[I_GGQ] + l * 64); if (tt.lat) rope2d<0, 64, 64>(v, tr, tc);
            st_row<64>((bf16*)(a.ws + WS_QGQA) + (size_t)m * 256 + 64 * h, v, C2_64); }
        else if (j < 41) { const int h = j - 39; float v[64]; up_row<64>(raw, v); P1_NEXT(); rms_gain<64>(v, a.in[I_GGK] + l * 64); if (tt.lat) rope2d<0, 64, 64>(v, tr, tc);
            st_ktile<64>(ktile_ptr(a.ws, WS_KGQA, 2, 64, tt.b, h, tt.ktile), 0, v, lane); }
        else { const int h = j - 41; float v[64]; up_row<64>(raw, v); P1_NEXT(); st_vtile(ktile_ptr(a.ws, WS_VGQA, 2, 64, tt.b, h, tt.ktile), v, scr, lane); }
    }
#undef P1_LOAD
#undef P1_NEXT
}
__device__ __forceinline__ void prep2_phase(const Args& a, int l, LAS unsigned char* lds, int lane_in, int wave, int vcu, int G) {
    LAS bf16* scr = (LAS bf16*)(lds + wave * 9216);
    const int gw = vcu * 8 + wave, NGW = G * 8;
    const bf16* U = (const bf16*)(a.ws + WS_U);
    u32x4 raw[8];
#define P2_LOAD(it_, lane_) do { const int T_ = (it_) / NJ2, j_ = (it_) % NJ2; const bf16* p_ = U + (size_t)(64 * T_ + (lane_)) * D + (j_ < 4 ? 128 * j_ : (j_ < 8 ? 512 + 128 * (j_ - 4) : 512 + 128 * (j_ - 8) + 64)); \
        _Pragma("unroll") for (int i_ = 0; i_ < 8; ++i_) raw[i_] = *(const u32x4*)(p_ + 8 * i_); } while (0)
#define P2_NEXT() do { if (it + NGW < NTT * NJ2) P2_LOAD(it + NGW, lane); __builtin_amdgcn_sched_barrier(0); } while (0)
    if (gw < NTT * NJ2) P2_LOAD(gw, lane_in);
    for (int it = gw; it < NTT * NJ2; it += NGW) {
        int lane = lane_in; asm volatile("" : "+v"(lane));
        const int T = it / NJ2, j = it % NJ2; const TokTile tt = tok_tile(T); const int m = tt.m0 + lane;
        const bf16* urow = U + (size_t)m * D; const float tr = (float)tt.prow, tc = (float)lane;
        if (j < 4) { const bf16* src = urow + 128 * j; const float* g = a.in[I_GMQ] + l * 96; bf16* dst = (bf16*)(a.ws + WS_QMLA) + (size_t)m * 384 + 96 * j; float ss = 0.f;
            P2_NEXT();
#pragma unroll
            for (int c = 0; c < 3; ++c) { asm volatile("" ::: "memory"); float v[32]; ld_row<32>(src + 32 * c, v);
#pragma unroll
                for (int i = 0; i < 32; ++i) ss += v[i] * v[i]; }
            const float r = rsqrtf(ss * (1.f / 96.f) + EPS);
#pragma unroll
            for (int c = 0; c < 3; ++c) { asm volatile("" ::: "memory"); float v[32]; ld_row<32>(src + 32 * c, v);
#pragma unroll
                for (int i = 0; i < 32; ++i) v[i] = v[i] * r * g[32 * c + i];
                if (c == 2 && tt.lat) rope2d<0, 32, 32>(v, tr, tc);
                st_row<32>(dst + 32 * c, v, C2_96); } }
        else if (j < 8) { const int h = j - 4; float v[64]; up_row<64>(raw, v); P2_NEXT(); rms_gain<64>(v, a.in[I_GKN] + l * 64); st_ktile<64>(ktile_ptr(a.ws, WS_KMLA, 4, 96, tt.b, h, tt.ktile), 0, v, lane); }
        else { const int h = j - 8; float v[64]; up_row<64>(raw, v); P2_NEXT(); st_vtile(ktile_ptr(a.ws, WS_VMLA, 4, 64, tt.b, h, tt.ktile), v, scr, lane); }
    }
#undef P2_LOAD
#undef P2_NEXT
}

__device__ __forceinline__ int pi32(int r) { return (r & 0x13) | ((r & 4) << 1) | ((r & 8) >> 1); }
__device__ __forceinline__ bf16x8 pack8(const f32x16& p, int base) {
    u32x4 w; w.x = pk2(p[base], p[base + 1]); w.y = pk2(p[base + 2], p[base + 3]); w.z = pk2(p[base + 4], p[base + 5]); w.w = pk2(p[base + 6], p[base + 7]);
    return __builtin_bit_cast(bf16x8, w);
}
#define MFMA32(A, B, C) __builtin_amdgcn_mfma_f32_32x32x16_bf16((A), (B), (C), 0, 0, 0)
__device__ __forceinline__ void store_ot(bf16* orow, const f32x16& o0, const f32x16& o1, int hi) {
#pragma unroll
    for (int g = 0; g < 4; ++g) {
        u32x2 w0, w1; w0.x = pk2(o0[4 * g], o0[4 * g + 1]); w0.y = pk2(o0[4 * g + 2], o0[4 * g + 3]); w1.x = pk2(o1[4 * g], o1[4 * g + 1]); w1.y = pk2(o1[4 * g + 2], o1[4 * g + 3]);
        *(u32x2*)(orow + 8 * g + 4 * hi) = w0; *(u32x2*)(orow + 32 + 8 * g + 4 * hi) = w1;
    }
}
#define SBAR() __builtin_amdgcn_sched_barrier(0)
#define EX2(x) __builtin_amdgcn_exp2f(x)
#define ZERO16 ((f32x16){})
__device__ __forceinline__ float fadd_s(float a, float b) { float r; asm("v_add_f32_e32 %0, %1, %2" : "=v"(r) : "v"(a), "v"(b)); return r; }
#define FADD(a, b) fadd_s((a), (b))
#if defined(MK_XPROBE) && MK_XPROBE == 2
#define XPROBE(x) do { float d0_, d1_; asm volatile("v_exp_f32 %0, %2\n\tv_exp_f32 %1, %2" : "=&v"(d0_), "=&v"(d1_) : "v"(x)); } while (0)
#else
#define XPROBE(x) do { } while (0)
#endif
#define ATT_GQA_PRE(KCUR1) do { \
        kf0 = *(const LAS bf16x8*)(KCUR1 + 0); \
        kf1 = *(const LAS bf16x8*)(KCUR1 + 2048); \
    } while (0)
#define ATT_GQA_ITER(KCUR1, KNEXT0, KNEXT1, VPREV1, VCUR0) do { \
        kf2 = *(const LAS bf16x8*)(KCUR1 + 4096); \
        SB_a = MFMA32(kf0, qa[0], ZERO16); \
        SA_a[0] = EX2(SA_a[0]); SA_a[1] = EX2(SA_a[1]); \
        SBAR(); \
        SB_b = MFMA32(kf0, qb[0], ZERO16); \
        la += SA_a[0]; la += SA_a[1]; PA_a_lo[0] = pk2(SA_a[0], SA_a[1]); XPROBE(SA_a[0]); \
        SA_a[2] = EX2(SA_a[2]); SA_a[3] = EX2(SA_a[3]); \
        SBAR(); \
        kf3 = *(const LAS bf16x8*)(KCUR1 + 6144); \
        SB_a = MFMA32(kf1, qa[1], SB_a); \
        la += SA_a[2]; la += SA_a[3]; PA_a_lo[1] = pk2(SA_a[2], SA_a[3]); XPROBE(SA_a[2]); \
        SA_a[4] = EX2(SA_a[4]); SA_a[5] = EX2(SA_a[5]); \
        SBAR(); \
        SB_b = MFMA32(kf1, qb[1], SB_b); \
        la += SA_a[4]; la += SA_a[5]; PA_a_lo[2] = pk2(SA_a[4], SA_a[5]); XPROBE(SA_a[4]); \
        SA_a[6] = EX2(SA_a[6]); SA_a[7] = EX2(SA_a[7]); \
        SBAR(); \
        vf0 = *(const LAS bf16x8*)(VPREV1 + 0); \
        SB_a = MFMA32(kf2, qa[2], SB_a); \
        la += SA_a[6]; la += SA_a[7]; PA_a_lo[3] = pk2(SA_a[6], SA_a[7]); XPROBE(SA_a[6]); \
        SA_a[8] = EX2(SA_a[8]); SA_a[9] = EX2(SA_a[9]); \
        SBAR(); \
        vf1 = *(const LAS bf16x8*)(VPREV1 + 512); \
        SB_b = MFMA32(kf2, qb[2], SB_b); \
        la += SA_a[8]; la += SA_a[9]; PA_a_hi[0] = pk2(SA_a[8], SA_a[9]); XPROBE(SA_a[8]); \
        SA_a[10] = EX2(SA_a[10]); SA_a[11] = EX2(SA_a[11]); \
        SBAR(); \
        SB_a = MFMA32(kf3, qa[3], SB_a); \
        la += SA_a[10]; la += SA_a[11]; PA_a_hi[1] = pk2(SA_a[10], SA_a[11]); XPROBE(SA_a[10]); \
        SA_a[12] = EX2(SA_a[12]); SA_a[13] = EX2(SA_a[13]); \
        SBAR(); \
        SB_b = MFMA32(kf3, qb[3], SB_b); \
        la += SA_a[12]; la += SA_a[13]; PA_a_hi[2] = pk2(SA_a[12], SA_a[13]); XPROBE(SA_a[12]); \
        SA_a[14] = EX2(SA_a[14]); SA_a[15] = EX2(SA_a[15]); \
        SBAR(); \
        vf2 = *(const LAS bf16x8*)(VPREV1 + 2048); \
        oa0 = MFMA32(vf0, PB_a_lo, oa0); \
        la += SA_a[14]; la += SA_a[15]; PA_a_hi[3] = pk2(SA_a[14], SA_a[15]); XPROBE(SA_a[14]); \
        SA_b[0] = EX2(SA_b[0]); SA_b[1] = EX2(SA_b[1]); \
        SBAR(); \
        vf3 = *(const LAS bf16x8*)(VPREV1 + 2560); \
        oa1 = MFMA32(vf1, PB_a_lo, oa1); \
        lb += SA_b[0]; lb += SA_b[1]; PA_b_lo[0] = pk2(SA_b[0], SA_b[1]); XPROBE(SA_b[0]); \
        SA_b[2] = EX2(SA_b[2]); SA_b[3] = EX2(SA_b[3]); \
        SBAR(); \
        ob0 = MFMA32(vf0, PB_b_lo, ob0); \
        lb += SA_b[2]; lb += SA_b[3]; PA_b_lo[1] = pk2(SA_b[2], SA_b[3]); XPROBE(SA_b[2]); \
        SA_b[4] = EX2(SA_b[4]); SA_b[5] = EX2(SA_b[5]); \
        SBAR(); \
        ob1 = MFMA32(vf1, PB_b_lo, ob1); \
        lb += SA_b[4]; lb += SA_b[5]; PA_b_lo[2] = pk2(SA_b[4], SA_b[5]); XPROBE(SA_b[4]); \
        SA_b[6] = EX2(SA_b[6]); SA_b[7] = EX2(SA_b[7]); \
        SBAR(); \
        kf0 = *(const LAS bf16x8*)(KNEXT0 + 0); \
        oa0 = MFMA32(vf2, PB_a_hi, oa0); \
        lb += SA_b[6]; lb += SA_b[7]; PA_b_lo[3] = pk2(SA_b[6], SA_b[7]); XPROBE(SA_b[6]); \
        SA_b[8] = EX2(SA_b[8]); SA_b[9] = EX2(SA_b[9]); \
        SBAR(); \
        oa1 = MFMA32(vf3, PB_a_hi, oa1); \
        lb += SA_b[8]; lb += SA_b[9]; PA_b_hi[0] = pk2(SA_b[8], SA_b[9]); XPROBE(SA_b[8]); \
        SA_b[10] = EX2(SA_b[10]); SA_b[11] = EX2(SA_b[11]); \
        SBAR(); \
        kf1 = *(const LAS bf16x8*)(KNEXT0 + 2048); \
        ob0 = MFMA32(vf2, PB_b_hi, ob0); \
        lb += SA_b[10]; lb += SA_b[11]; PA_b_hi[1] = pk2(SA_b[10], SA_b[11]); XPROBE(SA_b[10]); \
        SA_b[12] = EX2(SA_b[12]); SA_b[13] = EX2(SA_b[13]); \
        SBAR(); \
        ob1 = MFMA32(vf3, PB_b_hi, ob1); \
        lb += SA_b[12]; lb += SA_b[13]; PA_b_hi[2] = pk2(SA_b[12], SA_b[13]); XPROBE(SA_b[12]); \
        SA_b[14] = EX2(SA_b[14]); SA_b[15] = EX2(SA_b[15]); \
        lb += SA_b[14]; lb += SA_b[15]; PA_b_hi[3] = pk2(SA_b[14], SA_b[15]); XPROBE(SA_b[14]); \
        SBAR(); \
        kf2 = *(const LAS bf16x8*)(KNEXT0 + 4096); \
        SA_a = MFMA32(kf0, qa[0], ZERO16); \
        SB_a[0] = EX2(SB_a[0]); SB_a[1] = EX2(SB_a[1]); \
        SBAR(); \
        SA_b = MFMA32(kf0, qb[0], ZERO16); \
        la += SB_a[0]; la += SB_a[1]; PB_a_lo[0] = pk2(SB_a[0], SB_a[1]); XPROBE(SB_a[0]); \
        SB_a[2] = EX2(SB_a[2]); SB_a[3] = EX2(SB_a[3]); \
        SBAR(); \
        kf3 = *(const LAS bf16x8*)(KNEXT0 + 6144); \
        SA_a = MFMA32(kf1, qa[1], SA_a); \
        la += SB_a[2]; la += SB_a[3]; PB_a_lo[1] = pk2(SB_a[2], SB_a[3]); XPROBE(SB_a[2]); \
        SB_a[4] = EX2(SB_a[4]); SB_a[5] = EX2(SB_a[5]); \
        SBAR(); \
        SA_b = MFMA32(kf1, qb[1], SA_b); \
        la += SB_a[4]; la += SB_a[5]; PB_a_lo[2] = pk2(SB_a[4], SB_a[5]); XPROBE(SB_a[4]); \
        SB_a[6] = EX2(SB_a[6]); SB_a[7] = EX2(SB_a[7]); \
        SBAR(); \
        vf0 = *(const LAS bf16x8*)(VCUR0 + 0); \
        SA_a = MFMA32(kf2, qa[2], SA_a); \
        la += SB_a[6]; la += SB_a[7]; PB_a_lo[3] = pk2(SB_a[6], SB_a[7]); XPROBE(SB_a[6]); \
        SB_a[8] = EX2(SB_a[8]); SB_a[9] = EX2(SB_a[9]); \
        SBAR(); \
        vf1 = *(const LAS bf16x8*)(VCUR0 + 512); \
        SA_b = MFMA32(kf2, qb[2], SA_b); \
        la += SB_a[8]; la += SB_a[9]; PB_a_hi[0] = pk2(SB_a[8], SB_a[9]); XPROBE(SB_a[8]); \
        SB_a[10] = EX2(SB_a[10]); SB_a[11] = EX2(SB_a[11]); \
        SBAR(); \
        SA_a = MFMA32(kf3, qa[3], SA_a); \
        la += SB_a[10]; la += SB_a[11]; PB_a_hi[1] = pk2(SB_a[10], SB_a[11]); XPROBE(SB_a[10]); \
        SB_a[12] = EX2(SB_a[12]); SB_a[13] = EX2(SB_a[13]); \
        SBAR(); \
        SA_b = MFMA32(kf3, qb[3], SA_b); \
        la += SB_a[12]; la += SB_a[13]; PB_a_hi[2] = pk2(SB_a[12], SB_a[13]); XPROBE(SB_a[12]); \
        SB_a[14] = EX2(SB_a[14]); SB_a[15] = EX2(SB_a[15]); \
        SBAR(); \
        vf2 = *(const LAS bf16x8*)(VCUR0 + 2048); \
        oa0 = MFMA32(vf0, PA_a_lo, oa0); \
        la += SB_a[14]; la += SB_a[15]; PB_a_hi[3] = pk2(SB_a[14], SB_a[15]); XPROBE(SB_a[14]); \
        SB_b[0] = EX2(SB_b[0]); SB_b[1] = EX2(SB_b[1]); \
        SBAR(); \
        vf3 = *(const LAS bf16x8*)(VCUR0 + 2560); \
        oa1 = MFMA32(vf1, PA_a_lo, oa1); \
        lb += SB_b[0]; lb += SB_b[1]; PB_b_lo[0] = pk2(SB_b[0], SB_b[1]); XPROBE(SB_b[0]); \
        SB_b[2] = EX2(SB_b[2]); SB_b[3] = EX2(SB_b[3]); \
        SBAR(); \
        ob0 = MFMA32(vf0, PA_b_lo, ob0); \
        lb += SB_b[2]; lb += SB_b[3]; PB_b_lo[1] = pk2(SB_b[2], SB_b[3]); XPROBE(SB_b[2]); \
        SB_b[4] = EX2(SB_b[4]); SB_b[5] = EX2(SB_b[5]); \
        SBAR(); \
        ob1 = MFMA32(vf1, PA_b_lo, ob1); \
        lb += SB_b[4]; lb += SB_b[5]; PB_b_lo[2] = pk2(SB_b[4], SB_b[5]); XPROBE(SB_b[4]); \
        SB_b[6] = EX2(SB_b[6]); SB_b[7] = EX2(SB_b[7]); \
        SBAR(); \
        kf0 = *(const LAS bf16x8*)(KNEXT1 + 0); \
        oa0 = MFMA32(vf2, PA_a_hi, oa0); \
        lb += SB_b[6]; lb += SB_b[7]; PB_b_lo[3] = pk2(SB_b[6], SB_b[7]); XPROBE(SB_b[6]); \
        SB_b[8] = EX2(SB_b[8]); SB_b[9] = EX2(SB_b[9]); \
        SBAR(); \
        oa1 = MFMA32(vf3, PA_a_hi, oa1); \
        lb += SB_b[8]; lb += SB_b[9]; PB_b_hi[0] = pk2(SB_b[8], SB_b[9]); XPROBE(SB_b[8]); \
        SB_b[10] = EX2(SB_b[10]); SB_b[11] = EX2(SB_b[11]); \
        SBAR(); \
        kf1 = *(const LAS bf16x8*)(KNEXT1 + 2048); \
        ob0 = MFMA32(vf2, PA_b_hi, ob0); \
        lb += SB_b[10]; lb += SB_b[11]; PB_b_hi[1] = pk2(SB_b[10], SB_b[11]); XPROBE(SB_b[10]); \
        SB_b[12] = EX2(SB_b[12]); SB_b[13] = EX2(SB_b[13]); \
        SBAR(); \
        ob1 = MFMA32(vf3, PA_b_hi, ob1); \
        lb += SB_b[12]; lb += SB_b[13]; PB_b_hi[2] = pk2(SB_b[12], SB_b[13]); XPROBE(SB_b[12]); \
        SB_b[14] = EX2(SB_b[14]); SB_b[15] = EX2(SB_b[15]); \
        lb += SB_b[14]; lb += SB_b[15]; PB_b_hi[3] = pk2(SB_b[14], SB_b[15]); XPROBE(SB_b[14]); \
        SBAR(); \
    } while (0)

#define ATT_MLA_PRE(KCUR1) do { \
        kf0 = *(const LAS bf16x8*)(KCUR1 + 0); \
        kf1 = *(const LAS bf16x8*)(KCUR1 + 2048); \
    } while (0)
#define ATT_MLA_ITER(KCUR1, KNEXT0, KNEXT1, VPREV1, VCUR0) do { \
        kf2 = *(const LAS bf16x8*)(KCUR1 + 4096); \
        SB_a = MFMA32(kf0, qa[0], ZERO16); \
        SA_a[0] = EX2(SA_a[0]); SA_a[1] = EX2(SA_a[1]); \
        SBAR(); \
        SB_b = MFMA32(kf0, qb[0], ZERO16); \
        la += SA_a[0]; la += SA_a[1]; PA_a_lo[0] = pk2(SA_a[0], SA_a[1]); XPROBE(SA_a[0]); \
        SA_a[2] = EX2(SA_a[2]); SA_a[3] = EX2(SA_a[3]); \
        SBAR(); \
        kf3 = *(const LAS bf16x8*)(KCUR1 + 6144); \
        SB_a = MFMA32(kf1, qa[1], SB_a); \
        la += SA_a[2]; la += SA_a[3]; PA_a_lo[1] = pk2(SA_a[2], SA_a[3]); XPROBE(SA_a[2]); \
        SA_a[4] = EX2(SA_a[4]); SA_a[5] = EX2(SA_a[5]); \
        SBAR(); \
        SB_b = MFMA32(kf1, qb[1], SB_b); \
        la += SA_a[4]; la += SA_a[5]; PA_a_lo[2] = pk2(SA_a[4], SA_a[5]); XPROBE(SA_a[4]); \
        SA_a[6] = EX2(SA_a[6]); SA_a[7] = EX2(SA_a[7]); \
        SBAR(); \
        kf0 = *(const LAS bf16x8*)(KCUR1 + 8192); \
        SB_a = MFMA32(kf2, qa[2], SB_a); \
        la += SA_a[6]; la += SA_a[7]; PA_a_lo[3] = pk2(SA_a[6], SA_a[7]); XPROBE(SA_a[6]); \
        SBAR(); \
        SB_b = MFMA32(kf2, qb[2], SB_b); \
        SA_a[8] = EX2(SA_a[8]); SA_a[9] = EX2(SA_a[9]); \
        SBAR(); \
        kf1 = *(const LAS bf16x8*)(KCUR1 + 10240); \
        SB_a = MFMA32(kf3, qa[3], SB_a); \
        la += SA_a[8]; la += SA_a[9]; PA_a_hi[0] = pk2(SA_a[8], SA_a[9]); XPROBE(SA_a[8]); \
        SA_a[10] = EX2(SA_a[10]); SA_a[11] = EX2(SA_a[11]); \
        SBAR(); \
        SB_b = MFMA32(kf3, qb[3], SB_b); \
        la += SA_a[10]; la += SA_a[11]; PA_a_hi[1] = pk2(SA_a[10], SA_a[11]); XPROBE(SA_a[10]); \
        SA_a[12] = EX2(SA_a[12]); SA_a[13] = EX2(SA_a[13]); \
        SBAR(); \
        vf0 = *(const LAS bf16x8*)(VPREV1 + 0); \
        SB_a = MFMA32(kf0, qa[4], SB_a); \
        la += SA_a[12]; la += SA_a[13]; PA_a_hi[2] = pk2(SA_a[12], SA_a[13]); XPROBE(SA_a[12]); \
        SA_a[14] = EX2(SA_a[14]); SA_a[15] = EX2(SA_a[15]); \
        SBAR(); \
        vf1 = *(const LAS bf16x8*)(VPREV1 + 512); \
        SB_b = MFMA32(kf0, qb[4], SB_b); \
        la += SA_a[14]; la += SA_a[15]; PA_a_hi[3] = pk2(SA_a[14], SA_a[15]); XPROBE(SA_a[14]); \
        SBAR(); \
        SB_a = MFMA32(kf1, qa[5], SB_a); \
        SA_b[0] = EX2(SA_b[0]); SA_b[1] = EX2(SA_b[1]); \
        SBAR(); \
        SB_b = MFMA32(kf1, qb[5], SB_b); \
        lb += SA_b[0]; lb += SA_b[1]; PA_b_lo[0] = pk2(SA_b[0], SA_b[1]); XPROBE(SA_b[0]); \
        SA_b[2] = EX2(SA_b[2]); SA_b[3] = EX2(SA_b[3]); \
        SBAR(); \
        vf2 = *(const LAS bf16x8*)(VPREV1 + 2048); \
        oa0 = MFMA32(vf0, PB_a_lo, oa0); \
        lb += SA_b[2]; lb += SA_b[3]; PA_b_lo[1] = pk2(SA_b[2], SA_b[3]); XPROBE(SA_b[2]); \
        SA_b[4] = EX2(SA_b[4]); SA_b[5] = EX2(SA_b[5]); \
        SBAR(); \
        vf3 = *(const LAS bf16x8*)(VPREV1 + 2560); \
        oa1 = MFMA32(vf1, PB_a_lo, oa1); \
        lb += SA_b[4]; lb += SA_b[5]; PA_b_lo[2] = pk2(SA_b[4], SA_b[5]); XPROBE(SA_b[4]); \
        SA_b[6] = EX2(SA_b[6]); SA_b[7] = EX2(SA_b[7]); \
        SBAR(); \
        ob0 = MFMA32(vf0, PB_b_lo, ob0); \
        lb += SA_b[6]; lb += SA_b[7]; PA_b_lo[3] = pk2(SA_b[6], SA_b[7]); XPROBE(SA_b[6]); \
        SBAR(); \
        ob1 = MFMA32(vf1, PB_b_lo, ob1); \
        SA_b[8] = EX2(SA_b[8]); SA_b[9] = EX2(SA_b[9]); \
        SBAR(); \
        kf0 = *(const LAS bf16x8*)(KNEXT0 + 0); \
        oa0 = MFMA32(vf2, PB_a_hi, oa0); \
        lb += SA_b[8]; lb += SA_b[9]; PA_b_hi[0] = pk2(SA_b[8], SA_b[9]); XPROBE(SA_b[8]); \
        SA_b[10] = EX2(SA_b[10]); SA_b[11] = EX2(SA_b[11]); \
        SBAR(); \
        oa1 = MFMA32(vf3, PB_a_hi, oa1); \
        lb += SA_b[10]; lb += SA_b[11]; PA_b_hi[1] = pk2(SA_b[10], SA_b[11]); XPROBE(SA_b[10]); \
        SA_b[12] = EX2(SA_b[12]); SA_b[13] = EX2(SA_b[13]); \
        SBAR(); \
        kf1 = *(const LAS bf16x8*)(KNEXT0 + 2048); \
        ob0 = MFMA32(vf2, PB_b_hi, ob0); \
        lb += SA_b[12]; lb += SA_b[13]; PA_b_hi[2] = pk2(SA_b[12], SA_b[13]); XPROBE(SA_b[12]); \
        SA_b[14] = EX2(SA_b[14]); SA_b[15] = EX2(SA_b[15]); \
        SBAR(); \
        ob1 = MFMA32(vf3, PB_b_hi, ob1); \
        lb += SA_b[14]; lb += SA_b[15]; PA_b_hi[3] = pk2(SA_b[14], SA_b[15]); XPROBE(SA_b[14]); \
        SBAR(); \
        kf2 = *(const LAS bf16x8*)(KNEXT0 + 4096); \
        SA_a = MFMA32(kf0, qa[0], ZERO16); \
        SB_a[0] = EX2(SB_a[0]); SB_a[1] = EX2(SB_a[1]); \
        SBAR(); \
        SA_b = MFMA32(kf0, qb[0], ZERO16); \
        la += SB_a[0]; la += SB_a[1]; PB_a_lo[0] = pk2(SB_a[0], SB_a[1]); XPROBE(SB_a[0]); \
        SB_a[2] = EX2(SB_a[2]); SB_a[3] = EX2(SB_a[3]); \
        SBAR(); \
        kf3 = *(const LAS bf16x8*)(KNEXT0 + 6144); \
        SA_a = MFMA32(kf1, qa[1], SA_a); \
        la += SB_a[2]; la += SB_a[3]; PB_a_lo[1] = pk2(SB_a[2], SB_a[3]); XPROBE(SB_a[2]); \
        SB_a[4] = EX2(SB_a[4]); SB_a[5] = EX2(SB_a[5]); \
        SBAR(); \
        SA_b = MFMA32(kf1, qb[1], SA_b); \
        la += SB_a[4]; la += SB_a[5]; PB_a_lo[2] = pk2(SB_a[4], SB_a[5]); XPROBE(SB_a[4]); \
        SB_a[6] = EX2(SB_a[6]); SB_a[7] = EX2(SB_a[7]); \
        SBAR(); \
        kf0 = *(const LAS bf16x8*)(KNEXT0 + 8192); \
        SA_a = MFMA32(kf2, qa[2], SA_a); \
        la += SB_a[6]; la += SB_a[7]; PB_a_lo[3] = pk2(SB_a[6], SB_a[7]); XPROBE(SB_a[6]); \
        SBAR(); \
        SA_b = MFMA32(kf2, qb[2], SA_b); \
        SB_a[8] = EX2(SB_a[8]); SB_a[9] = EX2(SB_a[9]); \
        SBAR(); \
        kf1 = *(const LAS bf16x8*)(KNEXT0 + 10240); \
        SA_a = MFMA32(kf3, qa[3], SA_a); \
        la += SB_a[8]; la += SB_a[9]; PB_a_hi[0] = pk2(SB_a[8], SB_a[9]); XPROBE(SB_a[8]); \
        SB_a[10] = EX2(SB_a[10]); SB_a[11] = EX2(SB_a[11]); \
        SBAR(); \
        SA_b = MFMA32(kf3, qb[3], SA_b); \
        la += SB_a[10]; la += SB_a[11]; PB_a_hi[1] = pk2(SB_a[10], SB_a[11]); XPROBE(SB_a[10]); \
        SB_a[12] = EX2(SB_a[12]); SB_a[13] = EX2(SB_a[13]); \
        SBAR(); \
        vf0 = *(const LAS bf16x8*)(VCUR0 + 0); \
        SA_a = MFMA32(kf0, qa[4], SA_a); \
        la += SB_a[12]; la += SB_a[13]; PB_a_hi[2] = pk2(SB_a[12], SB_a[13]); XPROBE(SB_a[12]); \
        SB_a[14] = EX2(SB_a[14]); SB_a[15] = EX2(SB_a[15]); \
        SBAR(); \
        vf1 = *(const LAS bf16x8*)(VCUR0 + 512); \
        SA_b = MFMA32(kf0, qb[4], SA_b); \
        la += SB_a[14]; la += SB_a[15]; PB_a_hi[3] = pk2(SB_a[14], SB_a[15]); XPROBE(SB_a[14]); \
        SBAR(); \
        SA_a = MFMA32(kf1, qa[5], SA_a); \
        SB_b[0] = EX2(SB_b[0]); SB_b[1] = EX2(SB_b[1]); \
        SBAR(); \
        SA_b = MFMA32(kf1, qb[5], SA_b); \
        lb += SB_b[0]; lb += SB_b[1]; PB_b_lo[0] = pk2(SB_b[0], SB_b[1]); XPROBE(SB_b[0]); \
        SB_b[2] = EX2(SB_b[2]); SB_b[3] = EX2(SB_b[3]); \
        SBAR(); \
        vf2 = *(const LAS bf16x8*)(VCUR0 + 2048); \
        oa0 = MFMA32(vf0, PA_a_lo, oa0); \
        lb += SB_b[2]; lb += SB_b[3]; PB_b_lo[1] = pk2(SB_b[2], SB_b[3]); XPROBE(SB_b[2]); \
        SB_b[4] = EX2(SB_b[4]); SB_b[5] = EX2(SB_b[5]); \
        SBAR(); \
        vf3 = *(const LAS bf16x8*)(VCUR0 + 2560); \
        oa1 = MFMA32(vf1, PA_a_lo, oa1); \
        lb += SB_b[4]; lb += SB_b[5]; PB_b_lo[2] = pk2(SB_b[4], SB_b[5]); XPROBE(SB_b[4]); \
        SB_b[6] = EX2(SB_b[6]); SB_b[7] = EX2(SB_b[7]); \
        SBAR(); \
        ob0 = MFMA32(vf0, PA_b_lo, ob0); \
        lb += SB_b[6]; lb += SB_b[7]; PB_b_lo[3] = pk2(SB_b[6], SB_b[7]); XPROBE(SB_b[6]); \
        SBAR(); \
        ob1 = MFMA32(vf1, PA_b_lo, ob1); \
        SB_b[8] = EX2(SB_b[8]); SB_b[9] = EX2(SB_b[9]); \
        SBAR(); \
        kf0 = *(const LAS bf16x8*)(KNEXT1 + 0); \
        oa0 = MFMA32(vf2, PA_a_hi, oa0); \
        lb += SB_b[8]; lb += SB_b[9]; PB_b_hi[0] = pk2(SB_b[8], SB_b[9]); XPROBE(SB_b[8]); \
        SB_b[10] = EX2(SB_b[10]); SB_b[11] = EX2(SB_b[11]); \
        SBAR(); \
        oa1 = MFMA32(vf3, PA_a_hi, oa1); \
        lb += SB_b[10]; lb += SB_b[11]; PB_b_hi[1] = pk2(SB_b[10], SB_b[11]); XPROBE(SB_b[10]); \
        SB_b[12] = EX2(SB_b[12]); SB_b[13] = EX2(SB_b[13]); \
        SBAR(); \
        kf1 = *(const LAS bf16x8*)(KNEXT1 + 2048); \
        ob0 = MFMA32(vf2, PA_b_hi, ob0); \
        lb += SB_b[12]; lb += SB_b[13]; PB_b_hi[2] = pk2(SB_b[12], SB_b[13]); XPROBE(SB_b[12]); \
        SB_b[14] = EX2(SB_b[14]); SB_b[15] = EX2(SB_b[15]); \
        SBAR(); \
        ob1 = MFMA32(vf3, PA_b_hi, ob1); \
        lb += SB_b[14]; lb += SB_b[15]; PB_b_hi[3] = pk2(SB_b[14], SB_b[15]); XPROBE(SB_b[14]); \
        SBAR(); \
    } while (0)

#define ATT_DIFF_PRE(KCUR1) do { \
        kf0 = *(const LAS bf16x8*)(KCUR1 + 0); \
        kf1 = *(const LAS bf16x8*)(KCUR1 + 4096); \
        kf2 = *(const LAS bf16x8*)(KCUR1 + 2048); \
        kf3 = *(const LAS bf16x8*)(KCUR1 + 6144); \
    } while (0)
#define ATT_DIFF_ITER(KCUR1, KNEXT0, KNEXT1, VPREV1, VCUR0) do { \
        vf0 = *(const LAS bf16x8*)(VPREV1 + 0); \
        SB_a = MFMA32(kf0, qa[0], ZERO16); \
        SA_a[0] = EX2(SA_a[0]); SA_a[1] = EX2(SA_a[1]); \
        SA_a[2] = EX2(SA_a[2]); SA_a[3] = EX2(SA_a[3]); \
        SBAR(); \
        vf1 = *(const LAS bf16x8*)(VPREV1 + 512); \
        SB_b = MFMA32(kf1, qb[0], ZERO16); \
        la += SA_a[0]; la += SA_a[1]; PA_a_lo[0] = pk2(SA_a[0], SA_a[1]); XPROBE(SA_a[0]); \
        la += SA_a[2]; la += SA_a[3]; PA_a_lo[1] = pk2(SA_a[2], SA_a[3]); XPROBE(SA_a[2]); \
        SA_a[4] = EX2(SA_a[4]); SA_a[5] = EX2(SA_a[5]); \
        SBAR(); \
        SB_a = MFMA32(kf2, qa[1], SB_a); \
        la += SA_a[4]; la += SA_a[5]; PA_a_lo[2] = pk2(SA_a[4], SA_a[5]); XPROBE(SA_a[4]); \
        SA_a[6] = EX2(SA_a[6]); SA_a[7] = EX2(SA_a[7]); \
        SBAR(); \
        SB_b = MFMA32(kf3, qb[1], SB_b); \
        la += SA_a[6]; la += SA_a[7]; PA_a_lo[3] = pk2(SA_a[6], SA_a[7]); XPROBE(SA_a[6]); \
        SA_a[8] = EX2(SA_a[8]); SA_a[9] = EX2(SA_a[9]); \
        SA_a[10] = EX2(SA_a[10]); SA_a[11] = EX2(SA_a[11]); \
        SBAR(); \
        vf2 = *(const LAS bf16x8*)(VPREV1 + 2048); \
        oa0 = MFMA32(vf0, PB_a_lo, oa0); \
        la += SA_a[8]; la += SA_a[9]; PA_a_hi[0] = pk2(SA_a[8], SA_a[9]); XPROBE(SA_a[8]); \
        la += SA_a[10]; la += SA_a[11]; PA_a_hi[1] = pk2(SA_a[10], SA_a[11]); XPROBE(SA_a[10]); \
        SA_a[12] = EX2(SA_a[12]); SA_a[13] = EX2(SA_a[13]); \
        SBAR(); \
        vf3 = *(const LAS bf16x8*)(VPREV1 + 2560); \
        oa1 = MFMA32(vf1, PB_a_lo, oa1); \
        la += SA_a[12]; la += SA_a[13]; PA_a_hi[2] = pk2(SA_a[12], SA_a[13]); XPROBE(SA_a[12]); \
        SA_a[14] = EX2(SA_a[14]); SA_a[15] = EX2(SA_a[15]); \
        SBAR(); \
        ob0 = MFMA32(vf0, PB_b_lo, ob0); \
        la += SA_a[14]; la += SA_a[15]; PA_a_hi[3] = pk2(SA_a[14], SA_a[15]); XPROBE(SA_a[14]); \
        SA_b[0] = EX2(SA_b[0]); SA_b[1] = EX2(SA_b[1]); \
        SA_b[2] = EX2(SA_b[2]); SA_b[3] = EX2(SA_b[3]); \
        SBAR(); \
        ob1 = MFMA32(vf1, PB_b_lo, ob1); \
        lb += SA_b[0]; lb += SA_b[1]; PA_b_lo[0] = pk2(SA_b[0], SA_b[1]); XPROBE(SA_b[0]); \
        lb += SA_b[2]; lb += SA_b[3]; PA_b_lo[1] = pk2(SA_b[2], SA_b[3]); XPROBE(SA_b[2]); \
        SA_b[4] = EX2(SA_b[4]); SA_b[5] = EX2(SA_b[5]); \
        SBAR(); \
        kf0 = *(const LAS bf16x8*)(KNEXT0 + 0); \
        oa0 = MFMA32(vf2, PB_a_hi, oa0); \
        lb += SA_b[4]; lb += SA_b[5]; PA_b_lo[2] = pk2(SA_b[4], SA_b[5]); XPROBE(SA_b[4]); \
        SA_b[6] = EX2(SA_b[6]); SA_b[7] = EX2(SA_b[7]); \
        SBAR(); \
        kf1 = *(const LAS bf16x8*)(KNEXT0 + 4096); \
        oa1 = MFMA32(vf3, PB_a_hi, oa1); \
        lb += SA_b[6]; lb += SA_b[7]; PA_b_lo[3] = pk2(SA_b[6], SA_b[7]); XPROBE(SA_b[6]); \
        SA_b[8] = EX2(SA_b[8]); SA_b[9] = EX2(SA_b[9]); \
        SA_b[10] = EX2(SA_b[10]); SA_b[11] = EX2(SA_b[11]); \
        SBAR(); \
        kf2 = *(const LAS bf16x8*)(KNEXT0 + 2048); \
        ob0 = MFMA32(vf2, PB_b_hi, ob0); \
        lb += SA_b[8]; lb += SA_b[9]; PA_b_hi[0] = pk2(SA_b[8], SA_b[9]); XPROBE(SA_b[8]); \
        lb += SA_b[10]; lb += SA_b[11]; PA_b_hi[1] = pk2(SA_b[10], SA_b[11]); XPROBE(SA_b[10]); \
        SA_b[12] = EX2(SA_b[12]); SA_b[13] = EX2(SA_b[13]); \
        SBAR(); \
        kf3 = *(const LAS bf16x8*)(KNEXT0 + 6144); \
        ob1 = MFMA32(vf3, PB_b_hi, ob1); \
        lb += SA_b[12]; lb += SA_b[13]; PA_b_hi[2] = pk2(SA_b[12], SA_b[13]); XPROBE(SA_b[12]); \
        SA_b[14] = EX2(SA_b[14]); SA_b[15] = EX2(SA_b[15]); \
        lb += SA_b[14]; lb += SA_b[15]; PA_b_hi[3] = pk2(SA_b[14], SA_b[15]); XPROBE(SA_b[14]); \
        SBAR(); \
        vf0 = *(const LAS bf16x8*)(VCUR0 + 0); \
        SA_a = MFMA32(kf0, qa[0], ZERO16); \
        SB_a[0] = EX2(SB_a[0]); SB_a[1] = EX2(SB_a[1]); \
        SB_a[2] = EX2(SB_a[2]); SB_a[3] = EX2(SB_a[3]); \
        SBAR(); \
        vf1 = *(const LAS bf16x8*)(VCUR0 + 512); \
        SA_b = MFMA32(kf1, qb[0], ZERO16); \
        la += SB_a[0]; la += SB_a[1]; PB_a_lo[0] = pk2(SB_a[0], SB_a[1]); XPROBE(SB_a[0]); \
        la += SB_a[2]; la += SB_a[3]; PB_a_lo[1] = pk2(SB_a[2], SB_a[3]); XPROBE(SB_a[2]); \
        SB_a[4] = EX2(SB_a[4]); SB_a[5] = EX2(SB_a[5]); \
        SBAR(); \
        SA_a = MFMA32(kf2, qa[1], SA_a); \
        la += SB_a[4]; la += SB_a[5]; PB_a_lo[2] = pk2(SB_a[4], SB_a[5]); XPROBE(SB_a[4]); \
        SB_a[6] = EX2(SB_a[6]); SB_a[7] = EX2(SB_a[7]); \
        SBAR(); \
        SA_b = MFMA32(kf3, qb[1], SA_b); \
        la += SB_a[6]; la += SB_a[7]; PB_a_lo[3] = pk2(SB_a[6], SB_a[7]); XPROBE(SB_a[6]); \
        SB_a[8] = EX2(SB_a[8]); SB_a[9] = EX2(SB_a[9]); \
        SB_a[10] = EX2(SB_a[10]); SB_a[11] = EX2(SB_a[11]); \
        SBAR(); \
        vf2 = *(const LAS bf16x8*)(VCUR0 + 2048); \
        oa0 = MFMA32(vf0, PA_a_lo, oa0); \
        la += SB_a[8]; la += SB_a[9]; PB_a_hi[0] = pk2(SB_a[8], SB_a[9]); XPROBE(SB_a[8]); \
        la += SB_a[10]; la += SB_a[11]; PB_a_hi[1] = pk2(SB_a[10], SB_a[11]); XPROBE(SB_a[10]); \
        SB_a[12] = EX2(SB_a[12]); SB_a[13] = EX2(SB_a[13]); \
        SBAR(); \
        vf3 = *(const LAS bf16x8*)(VCUR0 + 2560); \
        oa1 = MFMA32(vf1, PA_a_lo, oa1); \
        la += SB_a[12]; la += SB_a[13]; PB_a_hi[2] = pk2(SB_a[12], SB_a[13]); XPROBE(SB_a[12]); \
        SB_a[14] = EX2(SB_a[14]); SB_a[15] = EX2(SB_a[15]); \
        SBAR(); \
        ob0 = MFMA32(vf0, PA_b_lo, ob0); \
        la += SB_a[14]; la += SB_a[15]; PB_a_hi[3] = pk2(SB_a[14], SB_a[15]); XPROBE(SB_a[14]); \
        SB_b[0] = EX2(SB_b[0]); SB_b[1] = EX2(SB_b[1]); \
        SB_b[2] = EX2(SB_b[2]); SB_b[3] = EX2(SB_b[3]); \
        SBAR(); \
        ob1 = MFMA32(vf1, PA_b_lo, ob1); \
        lb += SB_b[0]; lb += SB_b[1]; PB_b_lo[0] = pk2(SB_b[0], SB_b[1]); XPROBE(SB_b[0]); \
        lb += SB_b[2]; lb += SB_b[3]; PB_b_lo[1] = pk2(SB_b[2], SB_b[3]); XPROBE(SB_b[2]); \
        SB_b[4] = EX2(SB_b[4]); SB_b[5] = EX2(SB_b[5]); \
        SBAR(); \
        kf0 = *(const LAS bf16x8*)(KNEXT1 + 0); \
        oa0 = MFMA32(vf2, PA_a_hi, oa0); \
        lb += SB_b[4]; lb += SB_b[5]; PB_b_lo[2] = pk2(SB_b[4], SB_b[5]); XPROBE(SB_b[4]); \
        SB_b[6] = EX2(SB_b[6]); SB_b[7] = EX2(SB_b[7]); \
        SBAR(); \
        kf1 = *(const LAS bf16x8*)(KNEXT1 + 4096); \
        oa1 = MFMA32(vf3, PA_a_hi, oa1); \
        lb += SB_b[6]; lb += SB_b[7]; PB_b_lo[3] = pk2(SB_b[6], SB_b[7]); XPROBE(SB_b[6]); \
        SB_b[8] = EX2(SB_b[8]); SB_b[9] = EX2(SB_b[9]); \
        SB_b[10] = EX2(SB_b[10]); SB_b[11] = EX2(SB_b[11]); \
        SBAR(); \
        kf2 = *(const LAS bf16x8*)(KNEXT1 + 2048); \
        ob0 = MFMA32(vf2, PA_b_hi, ob0); \
        lb += SB_b[8]; lb += SB_b[9]; PB_b_hi[0] = pk2(SB_b[8], SB_b[9]); XPROBE(SB_b[8]); \
        lb += SB_b[10]; lb += SB_b[11]; PB_b_hi[1] = pk2(SB_b[10], SB_b[11]); XPROBE(SB_b[10]); \
        SB_b[12] = EX2(SB_b[12]); SB_b[13] = EX2(SB_b[13]); \
        SBAR(); \
        kf3 = *(const LAS bf16x8*)(KNEXT1 + 6144); \
        ob1 = MFMA32(vf3, PA_b_hi, ob1); \
        lb += SB_b[12]; lb += SB_b[13]; PB_b_hi[2] = pk2(SB_b[12], SB_b[13]); XPROBE(SB_b[12]); \
        SB_b[14] = EX2(SB_b[14]); SB_b[15] = EX2(SB_b[15]); \
        lb += SB_b[14]; lb += SB_b[15]; PB_b_hi[3] = pk2(SB_b[14], SB_b[15]); XPROBE(SB_b[14]); \
        SBAR(); \
    } while (0)

template <int DK, bool DIFF>
__device__ __forceinline__ void attn_dense_unit(const bf16* Q, int qp, int wave_rows, int nrows, size_t q_off1, const bf16* Kt, const bf16* Vt, int ntiles, bf16* O, size_t o_off1,
                                                LAS unsigned char* lds, int tid_in, const float* lamp, const float* gsub) {
    int tid = tid_in; asm volatile("" : "+v"(tid));
    constexpr int KB = 128 * DK;
    constexpr int KPIECES = DK / 8;
    constexpr int BUF = KB + 8192;
    constexpr int NS = DIFF ? 2 : DK / 16;
    const int lane = tid & 63, r = lane & 31, hi = lane >> 5; const int wid = __builtin_amdgcn_readfirstlane(tid >> 6);
    const bool valid = wave_rows * wid < nrows;
    const size_t wrow = valid ? (size_t)(wave_rows * wid + r) : (size_t)r;
    const bf16* qrow = Q + wrow * qp;
    bf16x8 qa[NS], qb[NS];
#pragma unroll
    for (int s = 0; s < NS; ++s) { qa[s] = *(const bf16x8*)(qrow + 16 * s + 8 * hi); qb[s] = *(const bf16x8*)(qrow + (DIFF ? 32 : q_off1) + 16 * s + 8 * hi); }
    f32x16 oa0 = {}, oa1 = {}, ob0 = {}, ob1 = {}; float la = 0.f, lb = 0.f;
    const int koff = hi * 1024 + pi32(r) * 16, voff = hi * 1024 + r * 16;
#define ATT_STAGE(t, slot) do { \
        const char* kg = (const char*)Kt + (size_t)(t) * KB; const char* vg = (const char*)Vt + (size_t)(t) * 8192; \
        __builtin_amdgcn_global_load_lds((const unsigned*)(kg + wid * 1024 + lane * 16), (LAS unsigned*)(lds + (slot) * BUF + wid * 1024), 16, 0, 0); \
        if (KPIECES > 8 && wid < KPIECES - 8) __builtin_amdgcn_global_load_lds((const unsigned*)(kg + (wid + 8) * 1024 + lane * 16), (LAS unsigned*)(lds + (slot) * BUF + (wid + 8) * 1024), 16, 0, 0); \
        __builtin_amdgcn_global_load_lds((const unsigned*)(vg + wid * 1024 + lane * 16), (LAS unsigned*)(lds + (slot) * BUF + KB + wid * 1024), 16, 0, 0); } while (0)
    ATT_STAGE(0, 0); ATT_STAGE(1, 1);
    VM_WAIT(); __syncthreads();
    f32x16 SA_a = {}, SA_b = {}, SB_a, SB_b;
    u32x4 PA_a_lo_, PA_a_hi_, PA_b_lo_, PA_b_hi_, PB_a_lo_, PB_a_hi_, PB_b_lo_, PB_b_hi_;
    { unsigned z = 0u; asm volatile("" : "+v"(z)); PB_a_lo_ = (u32x4){z, z, z, z}; PB_a_hi_ = PB_a_lo_; PB_b_lo_ = PB_a_lo_; PB_b_hi_ = PB_a_lo_; }
    bf16x8 kf0, kf1, kf2, kf3, vf0, vf1, vf2, vf3;
#define PA_a_lo PA_a_lo_
#define PA_a_hi PA_a_hi_
#define PA_b_lo PA_b_lo_
#define PA_b_hi PA_b_hi_
#define PB_a_lo PB_a_lo_
#define PB_a_hi PB_a_hi_
#define PB_b_lo PB_b_lo_
#define PB_b_hi PB_b_hi_
#undef MFMA32
#define MFMA32(A, B, C) __builtin_amdgcn_mfma_f32_32x32x16_bf16(__builtin_bit_cast(bf16x8, (A)), __builtin_bit_cast(bf16x8, (B)), (C), 0, 0, 0)
    {
        const LAS unsigned char* kp_ = lds + koff;
#pragma unroll
        for (int st = 0; st < NS; ++st) {
            if constexpr (!DIFF) { const bf16x8 kf = *(const LAS bf16x8*)(kp_ + st * 2048); SA_a = MFMA32(kf, qa[st], SA_a); SA_b = MFMA32(kf, qb[st], SA_b); }
            else { const bf16x8 k1 = *(const LAS bf16x8*)(kp_ + st * 2048), k2 = *(const LAS bf16x8*)(kp_ + (st + 2) * 2048); SA_a = MFMA32(k1, qa[st], SA_a); SA_b = MFMA32(k2, qb[st], SA_b); } }
    }
    if constexpr (DIFF) { ATT_DIFF_PRE(lds + 512 + koff); } else if constexpr (DK == 96) { ATT_MLA_PRE(lds + 512 + koff); } else { ATT_GQA_PRE(lds + 512 + koff); }
    int sp = 0, s0 = 0, s1 = 1, s2 = 2;
#pragma unroll 1
    for (int t = 0; t < ntiles; ++t) {
        { const int tn = min(t + 2, ntiles - 1); ATT_STAGE(tn, s2); }
        const LAS unsigned char* kcur1 = lds + s0 * BUF + 512 + koff; const LAS unsigned char* knext0 = lds + s1 * BUF + koff; const LAS unsigned char* knext1 = knext0 + 512;
        const LAS unsigned char* vprev1 = lds + sp * BUF + KB + 4096 + voff; const LAS unsigned char* vcur0 = lds + s0 * BUF + KB + voff;
        if constexpr (DIFF) { ATT_DIFF_ITER(kcur1, knext0, knext1, vprev1, vcur0); }
        else if constexpr (DK == 96) { ATT_MLA_ITER(kcur1, knext0, knext1, vprev1, vcur0); }
        else { ATT_GQA_ITER(kcur1, knext0, knext1, vprev1, vcur0); }
        sp = s0; s0 = s1; s1 = s2; s2 = (s2 + 1) & 3;
        VM_WAIT(); __syncthreads();
    }
    {
        const LAS unsigned char* vp_ = lds + sp * BUF + KB + 4096 + voff;
        const bf16x8 v00 = *(const LAS bf16x8*)(vp_), v01 = *(const LAS bf16x8*)(vp_ + 512), v10 = *(const LAS bf16x8*)(vp_ + 2048), v11 = *(const LAS bf16x8*)(vp_ + 2560);
        oa0 = MFMA32(v00, PB_a_lo, oa0); oa1 = MFMA32(v01, PB_a_lo, oa1); ob0 = MFMA32(v00, PB_b_lo, ob0); ob1 = MFMA32(v01, PB_b_lo, ob1);
        oa0 = MFMA32(v10, PB_a_hi, oa0); oa1 = MFMA32(v11, PB_a_hi, oa1); ob0 = MFMA32(v10, PB_b_hi, ob0); ob1 = MFMA32(v11, PB_b_hi, ob1);
    }
#undef MFMA32
#define MFMA32(A, B, C) __builtin_amdgcn_mfma_f32_32x32x16_bf16((A), (B), (C), 0, 0, 0)
#undef PA_a_lo
#undef PA_a_hi
#undef PA_b_lo
#undef PA_b_hi
#undef PB_a_lo
#undef PB_a_hi
#undef PB_b_lo
#undef PB_b_hi
#undef ATT_STAGE
    int tid2 = tid_in; asm volatile("" : "+v"(tid2));
    const int lane2 = tid2 & 63, r2 = lane2 & 31, hi2 = lane2 >> 5; const int wid2 = __builtin_amdgcn_readfirstlane(tid2 >> 6);
    const bool valid2 = wave_rows * wid2 < nrows;
    bf16* orow = O + (valid2 ? (size_t)(wave_rows * wid2 + r2) : (size_t)r2) * D;
    la += shx(la, 32); lb += shx(lb, 32);
    if constexpr (!DIFF) {
        const float ia = __builtin_amdgcn_rcpf(la), ib = __builtin_amdgcn_rcpf(lb);
#pragma unroll
        for (int i = 0; i < 16; ++i) { oa0[i] *= ia; oa1[i] *= ia; ob0[i] *= ib; ob1[i] *= ib; }
        if (valid2) { store_ot(orow, oa0, oa1, hi2); store_ot(orow + o_off1, ob0, ob1, hi2); }
    } else {
        const float lam = lamp[0], lam_scale = lamp[1]; const float ia = __builtin_amdgcn_rcpf(la), ib = lam * __builtin_amdgcn_rcpf(lb); float ss = 0.f;
#pragma unroll
        for (int i = 0; i < 16; ++i) { oa0[i] = oa0[i] * ia - ob0[i] * ib; oa1[i] = oa1[i] * ia - ob1[i] * ib; ss += oa0[i] * oa0[i] + oa1[i] * oa1[i]; }
        ss += shx(ss, 32);
        const float rr = rsqrtf(ss * (1.f / 64.f) + EPS) * lam_scale;
#pragma unroll
        for (int i = 0; i < 16; ++i) { const int dv = 8 * (i >> 2) + 4 * hi2 + (i & 3); oa0[i] *= rr * gsub[dv]; oa1[i] *= rr * gsub[32 + dv]; }
        if (valid2) store_ot(orow, oa0, oa1, hi2);
    }
    __syncthreads();
}
__device__ __forceinline__ void attn_na_unit(const Args& a, int b, int h, int g, LAS unsigned char* lds, const LAS float* bias_l, int tid_in) {
    int tid = tid_in; asm volatile("" : "+v"(tid));
    const int lane = tid & 63, r = lane & 31, hi = lane >> 5; const int wid = __builtin_amdgcn_readfirstlane(tid >> 6);
    const int wr = wid >> 1, qb = wid & 1, gr = 4 * g + wr;
    const int m = b * SEQ + gr * 64 + 32 * qb + r;
    const bf16* qrow = (const bf16*)(a.ws + WS_QNA) + (size_t)m * 256 + 64 * h;
    bf16x8 qf[4];
#pragma unroll
    for (int s = 0; s < 4; ++s) qf[s] = *(const bf16x8*)(qrow + 16 * s + 8 * hi);
    const int c = 32 * qb + r, c0 = min(max(c - 8, 0), 48), r0 = min(max(gr - 4, 0), 248);
    const int lo = min(max(4 * g - 4, 0), 248), hiw = min(max(4 * g - 1, 0), 248) + 7, ntile = 4 + (hiw - lo + 1);
    const bf16* Kt = ktile_ptr(a.ws, WS_KNA, 4, 64, b, h, 0); const bf16* Vt = ktile_ptr(a.ws, WS_VNA, 4, 64, b, h, 0);
    f32x16 o0 = {}, o1 = {}; float l0 = 0.f;
    const int koff = hi * 1024 + pi32(r) * 16, voff = hi * 1024 + r * 16;
    int boff[2][16];
#pragma unroll
    for (int kb = 0; kb < 2; ++kb)
#pragma unroll
        for (int i = 0; i < 16; ++i) { const int kc = 32 * kb + 16 * (i >> 3) + 8 * hi + (i & 7); const bool ok = (kc >= c0) && (kc < c0 + 16);
            boff[kb][i] = 4 * (ok ? min(max(kc - c + 15, 0), 30) : 31); }
#define NA_STAGE(t, buf) do { const int kt_ = (t) < 4 ? (t) : 4 + lo + ((t) - 4); \
        const char* kg = (const char*)Kt + (size_t)kt_ * 8192; const char* vg = (const char*)Vt + (size_t)kt_ * 8192; \
        __builtin_amdgcn_global_load_lds((const unsigned*)(kg + wid * 1024 + lane * 16), (LAS unsigned*)(lds + (buf) * 16384 + wid * 1024), 16, 0, 0); \
        __builtin_amdgcn_global_load_lds((const unsigned*)(vg + wid * 1024 + lane * 16), (LAS unsigned*)(lds + (buf) * 16384 + 8192 + wid * 1024), 16, 0, 0); } while (0)
    NA_STAGE(0, 0); NA_STAGE(1, 1); NA_STAGE(2, 2);
#pragma unroll 1
    for (int t = 0; t < ntile; ++t) {
        if (t + 2 < ntile) asm volatile("s_waitcnt vmcnt(4)" ::: "memory"); else if (t + 1 < ntile) asm volatile("s_waitcnt vmcnt(2)" ::: "memory"); else VM_WAIT();
        __syncthreads();
        if (t + 3 < ntile) NA_STAGE(t + 3, (t + 3) & 3);
        const int wrow = lo + (t - 4);
        const bool win = t >= 4; const bool rel = !win || (wrow >= r0 && wrow < r0 + 8);
        if (rel) {
            const LAS unsigned char* kb_ = lds + (t & 3) * 16384; const LAS unsigned char* vb_ = kb_ + 8192;
            const LAS unsigned char* brow = (const LAS unsigned char*)bias_l + (win ? (wrow - gr + 7) * 128 : 0);
#pragma unroll
            for (int kb = 0; kb < 2; ++kb) {
                f32x16 s = {};
#pragma unroll
                for (int st = 0; st < 4; ++st) { const bf16x8 kf = *(const LAS bf16x8*)(kb_ + st * 2048 + kb * 512 + koff); s = MFMA32(kf, qf[st], s); }
                const bool dead0 = win && kb == 0 && qb == 1, dead1 = win && kb == 1 && qb == 0;
                if (win) {
#pragma unroll
                    for (int hf = 0; hf < 2; ++hf) {
                        if (hf == 0 ? dead0 : dead1) {
#pragma unroll
                            for (int i = 8 * hf; i < 8 * hf + 8; ++i) s[i] = 0.f;
                        } else {
#pragma unroll
                            for (int i = 8 * hf; i < 8 * hf + 8; ++i) { const float bias = *(const LAS float*)(brow + boff[kb][i]); s[i] = __builtin_amdgcn_exp2f(s[i] + bias); l0 += s[i]; }
                        }
                    }
                } else {
#pragma unroll
                    for (int i = 0; i < 16; ++i) { s[i] = __builtin_amdgcn_exp2f(s[i]); l0 += s[i]; }
                }
                const bf16x8 p0 = pack8(s, 0), p1 = pack8(s, 8);
                const bf16x8 v00 = *(const LAS bf16x8*)(vb_ + (4 * kb + 0) * 1024 + voff), v01 = *(const LAS bf16x8*)(vb_ + (4 * kb + 0) * 1024 + 512 + voff);
                const bf16x8 v10 = *(const LAS bf16x8*)(vb_ + (4 * kb + 2) * 1024 + voff), v11 = *(const LAS bf16x8*)(vb_ + (4 * kb + 2) * 1024 + 512 + voff);
                if (!dead0) { o0 = MFMA32(v00, p0, o0); o1 = MFMA32(v01, p0, o1); }
                if (!dead1) { o0 = MFMA32(v10, p1, o0); o1 = MFMA32(v11, p1, o1); }
            }
        }
    }
#undef NA_STAGE
    l0 += shx(l0, 32);
    const float i0 = __builtin_amdgcn_rcpf(l0);
#pragma unroll
    for (int i = 0; i < 16; ++i) { o0[i] *= i0; o1[i] *= i0; }
    store_ot((bf16*)(a.ws + WS_O) + (size_t)m * D + 64 * h, o0, o1, hi);
    __syncthreads();
}
__device__ __forceinline__ void attn_phase(const Args& a, int l, LAS unsigned char* lds, int tid, int vcu, int G) {
    unsigned char* ws = a.ws; bf16* O = (bf16*)(ws + WS_O);
    const float* lamp = (const float*)(ws + WS_LAM) + 2 * l; const float* gsub = a.in[I_GDSUB] + l * 64;
    const bool ctxq = (l == 0);
#define CTX_LOOP(c, coff, n) for (int c = (((vcu - (coff)) % G) + G) % G; c < (ctxq ? (n) : 0); c += G)
    for (int u = vcu; u < 256; u += G) { const int bh = u >> 5, b = bh >> 2, h = bh & 3; const size_t m0 = (size_t)b * SEQ + 512 * (u & 31);
        attn_dense_unit<96, false>((const bf16*)(ws + WS_QMLA) + m0 * 384 + 96 * h, 384, 64, 512, (size_t)32 * 384, ktile_ptr(ws, WS_KMLA, 4, 96, b, h, 0), ktile_ptr(ws, WS_VMLA, 4, 64, b, h, 0), NTILE,
                                   O + m0 * D + 256 + 64 * h, (size_t)32 * D, lds, tid, lamp, gsub); }
    CTX_LOOP(c, 0, 8) { const int b = c >> 2, h = c & 3; const size_t m0 = (size_t)NLAT + b * CTXL;
        attn_dense_unit<96, false>((const bf16*)(ws + WS_QMLA) + m0 * 384 + 96 * h, 384, 64, 256, (size_t)32 * 384, ktile_ptr(ws, WS_KMLA, 4, 96, b, h, 0), ktile_ptr(ws, WS_VMLA, 4, 64, b, h, 0), 4,
                                   O + m0 * D + 256 + 64 * h, (size_t)32 * D, lds, tid, lamp, gsub); }
    for (int u = vcu; u < 512; u += G) { const int bh = (u & 255) >> 5, qt = (u & 31) + 32 * (u >> 8), b = bh >> 2, h = bh & 3; const size_t m0 = (size_t)b * SEQ + 256 * qt;
        attn_dense_unit<64, true>((const bf16*)(ws + WS_QDIFF) + m0 * 256 + 64 * h, 256, 32, 256, 0, ktile_ptr(ws, WS_KDIFF, 4, 64, b, h, 0), ktile_ptr(ws, WS_VDIFF, 4, 64, b, h, 0), NTILE,
                                  O + m0 * D + 512 + 64 * h, 0, lds, tid, lamp, gsub); }
    CTX_LOOP(c, 8, 8) { const int b = c >> 2, h = c & 3; const size_t m0 = (size_t)NLAT + b * CTXL;
        attn_dense_unit<64, true>((const bf16*)(ws + WS_QDIFF) + m0 * 256 + 64 * h, 256, 32, 256, 0, ktile_ptr(ws, WS_KDIFF, 4, 64, b, h, 0), ktile_ptr(ws, WS_VDIFF, 4, 64, b, h, 0), 4,
                                  O + m0 * D + 512 + 64 * h, 0, lds, tid, lamp, gsub); }
    for (int u = vcu; u < 256; u += G) { const int bk = u >> 6, b = bk >> 1, kh = bk & 1; const size_t m0 = (size_t)b * SEQ + 256 * (u & 63);
        attn_dense_unit<64, false>((const bf16*)(ws + WS_QGQA) + m0 * 256 + 128 * kh, 256, 32, 256, 64, ktile_ptr(ws, WS_KGQA, 2, 64, b, kh, 0), ktile_ptr(ws, WS_VGQA, 2, 64, b, kh, 0), NTILE,
                                   O + m0 * D + 768 + 128 * kh, 64, lds, tid, lamp, gsub); }
    CTX_LOOP(c, 16, 4) { const int b = c >> 1, kh = c & 1; const size_t m0 = (size_t)NLAT + b * CTXL;
        attn_dense_unit<64, false>((const bf16*)(ws + WS_QGQA) + m0 * 256 + 128 * kh, 256, 32, 256, 64, ktile_ptr(ws, WS_KGQA, 2, 64, b, kh, 0), ktile_ptr(ws, WS_VGQA, 2, 64, b, kh, 0), 4,
                                   O + m0 * D + 768 + 128 * kh, 64, lds, tid, lamp, gsub); }
    { LAS float* bl = (LAS float*)(lds + 65536); const float* rpb = a.in[I_RPB] + (size_t)l * 4 * 465;
      for (int i = tid; i < 4 * 480; i += 512) { const int h = i / 480, rem = i % 480, dy = rem >> 5, dx = rem & 31; bl[i] = dx < 31 ? rpb[h * 465 + dy * 31 + dx] * LOG2E : -3.0e38f; }
      __syncthreads();
      for (int u = vcu; u < 512; u += G) { const int bh = u >> 6, b = bh >> 2, h = bh & 3; attn_na_unit(a, b, h, u & 63, lds, bl + h * 480, tid); } }
    CTX_LOOP(c, 24, 8) { const int b = c >> 2, h = c & 3; const size_t m0 = (size_t)NLAT + b * CTXL;
        attn_dense_unit<64, false>((const bf16*)(ws + WS_QNA) + m0 * 256 + 64 * h, 256, 64, 256, (size_t)32 * 256, ktile_ptr(ws, WS_KNA, 4, 64, b, h, 0), ktile_ptr(ws, WS_VNA, 4, 64, b, h, 0), 4,
                                   O + m0 * D + 64 * h, (size_t)32 * D, lds, tid, lamp, gsub); }
#undef CTX_LOOP
}

__device__ __forceinline__ void up2_phase(const Args& a, int l, int lane_in, int wave, int vcu, int G) {
    const int gw = vcu * 8 + wave, NGW = G * 8;
    const bf16* A2 = (const bf16*)(a.ws + WS_A2); const bf16* W2 = w_2(a, l);
    for (int it = gw; it < NTT * NJ2; it += NGW) {
        int lane = lane_in; asm volatile("" : "+v"(lane));
        const int r = lane & 31, hi = lane >> 5, pr = pi32(r);
        const int T = it / NJ2, j = it % NJ2; const TokTile tt = tok_tile(T);
        if (j < 4) {
            const bf16* wrow0 = W2 + (size_t)(4 * j) * 24 * 512 + (hi * 32 + pr) * 8;
            const bf16* wrow2 = W2 + (size_t)(4 * j + 2) * 24 * 512 + (hi * 32 + r) * 8;
            const bf16* arow = A2 + (size_t)(tt.m0 >> 5) * 24 * 512 + (hi * 32 + r) * 8;
            f32x16 acc[3][2];
#pragma unroll
            for (int nb = 0; nb < 3; ++nb) { acc[nb][0] = (f32x16){}; acc[nb][1] = (f32x16){}; }
#pragma unroll 1
            for (int kg = 0; kg < 4; ++kg) {
                bf16x8 wf[4][3], af[4][2];
#pragma unroll
                for (int st = 0; st < 4; ++st) wf[st][0] = *(const bf16x8*)(wrow0 + (4 * kg + st) * 512);
#pragma unroll
                for (int st = 0; st < 4; ++st) wf[st][1] = *(const bf16x8*)(wrow0 + 24 * 512 + (4 * kg + st) * 512);
#pragma unroll
                for (int st = 0; st < 4; ++st) wf[st][2] = *(const bf16x8*)(wrow2 + (4 * kg + st) * 512);
#pragma unroll
                for (int st = 0; st < 4; ++st) af[st][0] = *(const bf16x8*)(arow + (4 * kg + st) * 512);
#pragma unroll
                for (int st = 0; st < 4; ++st) af[st][1] = *(const bf16x8*)(arow + 24 * 512 + (4 * kg + st) * 512);
                __builtin_amdgcn_sched_barrier(0);
#pragma unroll
                for (int st = 0; st < 4; ++st)
#pragma unroll
                    for (int nb = 0; nb < 3; ++nb) { acc[nb][0] = MFMA32(wf[st][nb], af[st][0], acc[nb][0]); acc[nb][1] = MFMA32(wf[st][nb], af[st][1], acc[nb][1]); }
            }
            const float* g = a.in[I_GMQ] + l * 96;
            f32x4 gv[12];
#pragma unroll
            for (int nb = 0; nb < 2; ++nb)
#pragma unroll
                for (int run = 0; run < 2; ++run) { const float* gp = g + 32 * nb + 16 * run + 8 * hi; gv[4 * nb + 2 * run] = *(const f32x4*)gp; gv[4 * nb + 2 * run + 1] = *(const f32x4*)(gp + 4); }
#pragma unroll
            for (int aa = 0; aa < 4; ++aa) gv[8 + aa] = *(const f32x4*)(g + 64 + 8 * aa + 4 * hi);
            __builtin_amdgcn_sched_barrier(0);
#pragma unroll
            for (int tb = 0; tb < 2; ++tb) {
                float ss = 0.f;
#pragma unroll
                for (int nb = 0; nb < 3; ++nb)
#pragma unroll
                    for (int i = 0; i < 16; ++i) ss += acc[nb][tb][i] * acc[nb][tb][i];
                ss += shx(ss, 32);
                const float rr = rsqrtf(ss * (1.f / 96.f) + EPS);
                bf16* dst = (bf16*)(a.ws + WS_QMLA) + (size_t)(tt.m0 + 32 * tb + r) * 384 + 96 * j;
#pragma unroll
                for (int nb = 0; nb < 2; ++nb)
#pragma unroll
                    for (int run = 0; run < 2; ++run) { const f32x4 g0 = gv[4 * nb + 2 * run], g1 = gv[4 * nb + 2 * run + 1]; const int b = 8 * run; const float sc = rr * C2_96;
                        u32x4 w; w.x = pk2(acc[nb][tb][b] * sc * g0.x, acc[nb][tb][b + 1] * sc * g0.y); w.y = pk2(acc[nb][tb][b + 2] * sc * g0.z, acc[nb][tb][b + 3] * sc * g0.w);
                        w.z = pk2(acc[nb][tb][b + 4] * sc * g1.x, acc[nb][tb][b + 5] * sc * g1.y); w.w = pk2(acc[nb][tb][b + 6] * sc * g1.z, acc[nb][tb][b + 7] * sc * g1.w);
                        *(u32x4*)(dst + 32 * nb + 16 * run + 8 * hi) = w; }
                float v[16];
#pragma unroll
                for (int aa = 0; aa < 4; ++aa) { v[4 * aa] = acc[2][tb][4 * aa] * rr * gv[8 + aa].x; v[4 * aa + 1] = acc[2][tb][4 * aa + 1] * rr * gv[8 + aa].y; v[4 * aa + 2] = acc[2][tb][4 * aa + 2] * rr * gv[8 + aa].z; v[4 * aa + 3] = acc[2][tb][4 * aa + 3] * rr * gv[8 + aa].w; }
                if (tt.lat) { const float tr = (float)tt.prow, tc = (float)(32 * tb + r);
#pragma unroll
                    for (int b = 0; b < 4; ++b) { const float inv = hi ? ROPE_INVR[2 * (4 + b)] : ROPE_INVR[2 * b];
                        { const float t = __builtin_amdgcn_fractf(tr * inv); const float c = __builtin_amdgcn_cosf(t), s = __builtin_amdgcn_sinf(t); const float x1 = v[b], x2 = v[4 + b]; v[b] = x1 * c - x2 * s; v[4 + b] = x1 * s + x2 * c; }
                        { const float t = __builtin_amdgcn_fractf(tc * inv); const float c = __builtin_amdgcn_cosf(t), s = __builtin_amdgcn_sinf(t); const float x1 = v[8 + b], x2 = v[12 + b]; v[8 + b] = x1 * c - x2 * s; v[12 + b] = x1 * s + x2 * c; } } }
#pragma unroll
                for (int aa = 0; aa < 4; ++aa) { u32x2 w; w.x = pk2(v[4 * aa] * C2_96, v[4 * aa + 1] * C2_96); w.y = pk2(v[4 * aa + 2] * C2_96, v[4 * aa + 3] * C2_96); *(u32x2*)(dst + 64 + 8 * aa + 4 * hi) = w; }
            }
        } else if (j < 8) {
            const int h = j - 4;
            const bf16* wrow = W2 + ((size_t)(16 + 4 * h) * 24 + 16) * 512 + (hi * 32 + pr) * 8;
            const bf16* arow = A2 + ((size_t)(tt.m0 >> 5) * 24 + 16) * 512 + (hi * 32 + r) * 8;
            f32x16 acc[2][2];
#pragma unroll
            for (int nb = 0; nb < 2; ++nb) { acc[nb][0] = (f32x16){}; acc[nb][1] = (f32x16){}; }
#pragma unroll 1
            for (int kg = 0; kg < 2; ++kg) {
                bf16x8 wf[4][2], af[4][2];
#pragma unroll
                for (int st = 0; st < 4; ++st) wf[st][0] = *(const bf16x8*)(wrow + (4 * kg + st) * 512);
#pragma unroll
                for (int st = 0; st < 4; ++st) wf[st][1] = *(const bf16x8*)(wrow + 24 * 512 + (4 * kg + st) * 512);
#pragma unroll
                for (int st = 0; st < 4; ++st) af[st][0] = *(const bf16x8*)(arow + (4 * kg + st) * 512);
#pragma unroll
                for (int st = 0; st < 4; ++st) af[st][1] = *(const bf16x8*)(arow + 24 * 512 + (4 * kg + st) * 512);
                __builtin_amdgcn_sched_barrier(0);
#pragma unroll
                for (int st = 0; st < 4; ++st)
#pragma unroll
                    for (int nb = 0; nb < 2; ++nb) { acc[nb][0] = MFMA32(wf[st][nb], af[st][0], acc[nb][0]); acc[nb][1] = MFMA32(wf[st][nb], af[st][1], acc[nb][1]); }
            }
            const float* g = a.in[I_GKN] + l * 64;
            f32x4 gv[8];
#pragma unroll
            for (int nb = 0; nb < 2; ++nb)
#pragma unroll
                for (int run = 0; run < 2; ++run) { const float* gp = g + 32 * nb + 16 * run + 8 * hi; gv[4 * nb + 2 * run] = *(const f32x4*)gp; gv[4 * nb + 2 * run + 1] = *(const f32x4*)(gp + 4); }
            __builtin_amdgcn_sched_barrier(0);
            bf16* kt = ktile_ptr(a.ws, WS_KMLA, 4, 96, tt.b, h, tt.ktile);
#pragma unroll
            for (int tb = 0; tb < 2; ++tb) {
                float ss = 0.f;
#pragma unroll
                for (int nb = 0; nb < 2; ++nb)
#pragma unroll
                    for (int i = 0; i < 16; ++i) ss += acc[nb][tb][i] * acc[nb][tb][i];
                ss += shx(ss, 32);
                const float rr = rsqrtf(ss * (1.f / 64.f) + EPS);
#pragma unroll
                for (int nb = 0; nb < 2; ++nb)
#pragma unroll
                    for (int run = 0; run < 2; ++run) { const f32x4 g0 = gv[4 * nb + 2 * run], g1 = gv[4 * nb + 2 * run + 1]; const int b = 8 * run;
                        u32x4 w; w.x = pk2(acc[nb][tb][b] * rr * g0.x, acc[nb][tb][b + 1] * rr * g0.y); w.y = pk2(acc[nb][tb][b + 2] * rr * g0.z, acc[nb][tb][b + 3] * rr * g0.w);
                        w.z = pk2(acc[nb][tb][b + 4] * rr * g1.x, acc[nb][tb][b + 5] * rr * g1.y); w.w = pk2(acc[nb][tb][b + 6] * rr * g1.z, acc[nb][tb][b + 7] * rr * g1.w);
                        *(u32x4*)(kt + (size_t)(4 * nb + 2 * run + hi) * 512 + (32 * tb + r) * 8) = w; }
            }
        } else {
            const int h = j - 8;
            const bf16* wrow = W2 + ((size_t)(16 + 4 * h + 2) * 24 + 16) * 512 + (hi * 32 + r) * 8;
            const bf16* arow = A2 + ((size_t)(tt.m0 >> 5) * 24 + 16) * 512 + (hi * 32 + pr) * 8;
            f32x16 acc[2][2];
#pragma unroll
            for (int tb = 0; tb < 2; ++tb) { acc[tb][0] = (f32x16){}; acc[tb][1] = (f32x16){}; }
#pragma unroll 1
            for (int kg = 0; kg < 2; ++kg) {
                bf16x8 wf[4][2], af[4][2];
#pragma unroll
                for (int st = 0; st < 4; ++st) wf[st][0] = *(const bf16x8*)(wrow + (4 * kg + st) * 512);
#pragma unroll
                for (int st = 0; st < 4; ++st) wf[st][1] = *(const bf16x8*)(wrow + 24 * 512 + (4 * kg + st) * 512);
#pragma unroll
                for (int st = 0; st < 4; ++st) af[st][0] = *(const bf16x8*)(arow + (4 * kg + st) * 512);
#pragma unroll
                for (int st = 0; st < 4; ++st) af[st][1] = *(const bf16x8*)(arow + 24 * 512 + (4 * kg + st) * 512);
                __builtin_amdgcn_sched_barrier(0);
#pragma unroll
                for (int st = 0; st < 4; ++st)
#pragma unroll
                    for (int tb = 0; tb < 2; ++tb) { acc[tb][0] = MFMA32(af[st][tb], wf[st][0], acc[tb][0]); acc[tb][1] = MFMA32(af[st][tb], wf[st][1], acc[tb][1]); }
            }
            bf16* vt = ktile_ptr(a.ws, WS_VMLA, 4, 64, tt.b, h, tt.ktile);
#pragma unroll
            for (int tb = 0; tb < 2; ++tb)
#pragma unroll
                for (int nb = 0; nb < 2; ++nb)
#pragma unroll
                    for (int run = 0; run < 2; ++run) { const int b = 8 * run;
                        u32x4 w; w.x = pk2(acc[tb][nb][b], acc[tb][nb][b + 1]); w.y = pk2(acc[tb][nb][b + 2], acc[tb][nb][b + 3]); w.z = pk2(acc[tb][nb][b + 4], acc[tb][nb][b + 5]); w.w = pk2(acc[tb][nb][b + 6], acc[tb][nb][b + 7]);
                        *(u32x4*)(vt + (size_t)(4 * tb + 2 * run + hi) * 512 + (32 * nb + r) * 8) = w; }
        }
    }
}

using pg8::Unit; using pg8::BM; using pg8::HALF;
struct EpiRes {
    static constexpr bool PERM = false, AFTER_DRAIN = false;
    const float* xlat; const float* xctx; float* out; const float* mod;
    __device__ __forceinline__ void operator()(const f32x4 (&acc)[2][2][4][2], const Unit& u, int wr, int wc, int fr, int fq) const {
        const int row0 = u.pm * BM + wr * 64 + fr, col0 = u.pn * BM + wc * 32 + 4 * fq;
        const int set = u.pm < 64 ? 0 : (u.pm < 128 ? 1 : 2);
        const float* base = u.pm < 128 ? xlat : xctx - (size_t)NLAT * D;
        const float* g1 = mod + set * 6144 + 2048 + col0;
        f32x4 gv[2][2];
#pragma unroll
        for (int bj = 0; bj < 2; ++bj)
#pragma unroll
            for (int n = 0; n < 2; ++n) gv[bj][n] = *(const f32x4*)(g1 + bj * HALF + n * 16);
#pragma unroll
        for (int ai = 0; ai < 2; ++ai) {
            f32x4 bv[4][2][2];
#pragma unroll
            for (int m = 0; m < 4; ++m) { const size_t ro = (size_t)(row0 + ai * HALF + m * 16) * D + col0;
#pragma unroll
                for (int bj = 0; bj < 2; ++bj)
#pragma unroll
                    for (int n = 0; n < 2; ++n) bv[m][bj][n] = *(const f32x4*)(base + ro + bj * HALF + n * 16); }
            __builtin_amdgcn_sched_barrier(0);
#pragma unroll
            for (int m = 0; m < 4; ++m) { const size_t ro = (size_t)(row0 + ai * HALF + m * 16) * D + col0;
#pragma unroll
                for (int bj = 0; bj < 2; ++bj)
#pragma unroll
                    for (int n = 0; n < 2; ++n) *(f32x4*)(out + ro + bj * HALF + n * 16) = bv[m][bj][n] + gv[bj][n] * acc[ai][bj][m][n]; }
        }
    }
};
struct EpiPTile {
    static constexpr bool PERM = true, AFTER_DRAIN = false;
    bf16* P;
    __device__ __forceinline__ void operator()(const f32x4 (&acc)[2][2][4][2], const Unit& u, int wr, int wc, int fr, int fq) const {
        const int row0 = u.pm * BM + wr * 64 + fr, col0 = u.pn * BM + wc * 32 + 8 * fq;
#pragma unroll
        for (int ai = 0; ai < 2; ++ai)
#pragma unroll
            for (int m = 0; m < 4; ++m) { const int row = row0 + ai * HALF + m * 16; bf16* tp = P + ((size_t)(row >> 6) * (NP / 8) * 64 + (row & 63)) * 8;
#pragma unroll
                for (int bj = 0; bj < 2; ++bj) { const f32x4 v0 = acc[ai][bj][m][0], v1 = acc[ai][bj][m][1];
                    u32x4 w; w.x = pk2(v0[0], v0[1]); w.y = pk2(v0[2], v0[3]); w.z = pk2(v1[0], v1[1]); w.w = pk2(v1[2], v1[3]);
                    *(u32x4*)(tp + (size_t)((col0 + bj * HALF) >> 3) * 512) = w; } }
    }
};
struct ExpertOrder {
    pg8::StaticOrder base; int ntn, pm_off, gap;
    __device__ __forceinline__ void init(int nrows, int N, int G, int c, int pm_off_ = 0, int gap_ = 0) { base.init(nrows, N, G, c); ntn = N / BM; pm_off = pm_off_; gap = gap_; }
    __device__ __forceinline__ bool next(int i, Unit& u) const { if (!base.next(i, u)) return false; u.pm += pm_off; const int e = u.pm < 256 ? ((u.pm >> 3) & 15) : (u.pm - 256); u.pn += e * ntn + (e >= GU_SPLIT_E ? gap : 0); return true; }
    __device__ __forceinline__ void a_ready(const Unit&) const {}
    __device__ __forceinline__ void done(const Unit&) const {}
};
struct ExpertGatherOrder : ExpertOrder {
    const int* srcrow;
    __device__ __forceinline__ int aoff(const Unit& u, int r) const { return srcrow[u.pm * BM + r]; }
};
}
namespace pg8 { template <> constexpr bool sched_gather_v<mk::ExpertGatherOrder> = true; }
namespace mk {
struct EpiSwiglu {
    static constexpr bool PERM = true, AFTER_DRAIN = false;
    bf16* act; bool half;
    __device__ __forceinline__ void operator()(const f32x4 (&acc)[2][2][4][2], const Unit& u, int wr, int wc, int fr, int fq) const {
        const int pnl = u.pn % 22; const int row0 = u.pm * BM + wr * 64 + fr, col0 = pnl * 128 + wc * 32 + 8 * fq;
#pragma unroll
        for (int ai = 0; ai < 2; ++ai) if (!(half && ai == 1))
#pragma unroll
            for (int m = 0; m < 4; ++m) { float r[8];
#pragma unroll
                for (int n = 0; n < 2; ++n)
#pragma unroll
                    for (int c = 0; c < 4; ++c) { const float g = acc[ai][0][m][n][c], up = acc[ai][1][m][n][c]; r[4 * n + c] = g * __builtin_amdgcn_rcpf(1.f + __builtin_amdgcn_exp2f(-g * LOG2E)) * up; }
                u32x4 w; w.x = pk2(r[0], r[1]); w.y = pk2(r[2], r[3]); w.z = pk2(r[4], r[5]); w.w = pk2(r[6], r[7]);
                { const int row = row0 + ai * HALF + m * 16;
                  *(u32x4*)(act + ((size_t)(row >> 5) * (DFF / 64) + (col0 >> 6)) * 2048 + (row & 31) * 64 + (col0 & 63)) = w; } }
    }
};
struct EpiDown {
    static constexpr bool PERM = true, AFTER_DRAIN = false;
    bf16* y; const float* gatev; bool half;
    __device__ __forceinline__ void operator()(const f32x4 (&acc)[2][2][4][2], const Unit& u, int wr, int wc, int fr, int fq) const {
        const int pnl = u.pn & 3; const int row0 = u.pm * BM + wr * 64 + fr, col0 = pnl * BM + wc * 32 + 8 * fq;
        float gtv[2][4];
#pragma unroll
        for (int ai = 0; ai < 2; ++ai)
#pragma unroll
            for (int m = 0; m < 4; ++m) gtv[ai][m] = gatev[row0 + ai * HALF + m * 16];
        __builtin_amdgcn_sched_barrier(0);
#pragma unroll
        for (int ai = 0; ai < 2; ++ai) if (!(half && ai == 1))
#pragma unroll
            for (int m = 0; m < 4; ++m) { const int row = row0 + ai * HALF + m * 16; const float gt = gtv[ai][m];
#pragma unroll
                for (int bj = 0; bj < 2; ++bj) { const f32x4 v0 = acc[ai][bj][m][0] * gt, v1 = acc[ai][bj][m][1] * gt;
                    u32x4 w; w.x = pk2(v0[0], v0[1]); w.y = pk2(v0[2], v0[3]); w.z = pk2(v1[0], v1[1]); w.w = pk2(v1[2], v1[3]);
                    *(u32x4*)(y + (size_t)row * D + col0 + bj * HALF) = w; } }
    }
};

__device__ __forceinline__ void router_phase(const Args& a, int l, LAS unsigned char* lds, int tid, int lane, int wave, int vcu, int G) {
    LAS float* Wl = (LAS float*)lds;
    LAS float* A1l = Wl + 16384;
    LAS float* biasl = A1l + 3072;
    LAS float* SHl = biasl + 64;
    const float* wr = a.in[I_WROUTER] + (size_t)l * 1024 * 16; const float* gff = a.in[I_GFFN] + l * D;
    const float* MODL = (const float*)(a.ws + WS_MOD) + (size_t)l * 3 * 6144;
    { float wv[32];
#pragma unroll
      for (int i = 0; i < 32; ++i) wv[i] = wr[tid + 512 * i];
      float ag[6], am[6], as_[6];
#pragma unroll
      for (int i = 0; i < 6; ++i) { const int idx = tid + 512 * i, set = idx >> 10, c = idx & 1023; ag[i] = gff[c]; am[i] = MODL[set * 6144 + 4096 + c]; as_[i] = MODL[set * 6144 + 3072 + c]; }
      __builtin_amdgcn_sched_barrier(0);
#pragma unroll
      for (int i = 0; i < 32; ++i) { const int idx = tid + 512 * i, c = idx >> 4, e = idx & 15; Wl[(((c >> 4) * 4 + ((c >> 2) & 3)) * 16 + e) * 4 + (c & 3)] = wv[i]; }
#pragma unroll
      for (int i = 0; i < 6; ++i) { const int idx = tid + 512 * i; A1l[idx] = ag[i] * (1.f + am[i]); SHl[idx] = as_[i]; } }
    __syncthreads();
    if (tid < 384) { const int se = tid >> 3, part = tid & 7, set = se >> 4, e = se & 15; float sacc = 0.f;
        for (int c = part * 128; c < part * 128 + 128; ++c) sacc += SHl[set * 1024 + c] * Wl[(((c >> 4) * 4 + ((c >> 2) & 3)) * 16 + e) * 4 + (c & 3)];
        sacc += shx(sacc, 1); sacc += shx(sacc, 2); sacc += shx(sacc, 4);
        if (part == 0) biasl[se] = sacc; }
    __syncthreads();
    const int ntile = ((l == 0) ? NROW : NLAT) / 16, nround = (ntile + 2 * G - 1) / (2 * G);
    const float* X1 = (const float*)(a.ws + WS_X1); bf16* H2 = (bf16*)(a.ws + WS_H2); float* AFF = (float*)(a.ws + WS_AFF);
    const int r = lane & 15, kq = lane >> 4, grp = wave >> 2, q = wave & 3;
    LAS float* PART = SHl + 3072;
    LAS float* SSP = PART + 2 * 2 * 4 * 256;
    const LAS float* wp = Wl + lane * 4 + 256 * 16 * q;
    f32x4 xa[16], xb[16];
#define RT_LOADT(dst, tI_) do { const float* xr_ = X1 + (size_t)((tI_) * 16 + r) * D + 256 * q + 4 * kq; _Pragma("unroll") for (int jj = 0; jj < 16; ++jj) dst[jj] = *(const f32x4*)(xr_ + 16 * jj); __builtin_amdgcn_sched_barrier(0); } while (0)
    int tI = vcu * 2 + grp;
    if (!PV(1)) {
    if (tI < ntile) RT_LOADT(xa, tI);
#pragma unroll 1
    for (int i = 0; i < nround; ++i) {
        const int par = i & 1; const bool act = tI < ntile; const int tN = ((i + 1) * G + vcu) * 2 + grp;
        if (i + 1 < nround && tN < ntile) RT_LOADT(xb, tN);
        const int m0 = tI * 16; const int set = act ? mset_of_row(m0) : 0;
        const LAS float* a1p = A1l + set * 1024 + 256 * q + 4 * kq;
        if (act) {
            f32x4 acc = {0.f, 0.f, 0.f, 0.f}; float ss = 0.f;
#pragma unroll
            for (int jj = 0; jj < 16; ++jj) { const f32x4 xv = xa[jj]; const f32x4 av = *(const LAS f32x4*)(a1p + 16 * jj); const f32x4 wv = *(const LAS f32x4*)(wp + 256 * jj);
                ss += (xv.x * xv.x + xv.y * xv.y) + (xv.z * xv.z + xv.w * xv.w);
                const f32x4 t = xv * av; xa[jj] = t;
                acc = __builtin_amdgcn_mfma_f32_16x16x4f32(t.x, wv.x, acc, 0, 0, 0); acc = __builtin_amdgcn_mfma_f32_16x16x4f32(t.y, wv.y, acc, 0, 0, 0);
                acc = __builtin_amdgcn_mfma_f32_16x16x4f32(t.z, wv.z, acc, 0, 0, 0); acc = __builtin_amdgcn_mfma_f32_16x16x4f32(t.w, wv.w, acc, 0, 0, 0); }
            ss += shx(ss, 16); ss += shx(ss, 32);
            *(LAS f32x4*)(PART + (((par * 2 + grp) * 4 + q) * 64 + lane) * 4) = acc;
            if (kq == 0) SSP[((par * 2 + grp) * 4 + q) * 16 + r] = ss;
        }
        __syncthreads();
        if (act) {
            const LAS float* sp = SSP + (par * 2 + grp) * 64 + r;
            const float rstd = rsqrtf(((sp[0] + sp[16]) + (sp[32] + sp[48])) * (1.f / D) + EPS);
            if (q == 0) {
                const LAS float* pp = PART + ((par * 2 + grp) * 4 * 64 + lane) * 4;
                const f32x4 acc = (*(const LAS f32x4*)(pp) + *(const LAS f32x4*)(pp + 256)) + (*(const LAS f32x4*)(pp + 512) + *(const LAS f32x4*)(pp + 768));
                const float be = biasl[set * 16 + r]; float lg[4], mx[4], se[4];
#pragma unroll
                for (int g = 0; g < 4; ++g) { lg[g] = acc[g] * shl(rstd, 4 * kq + g) + be; mx[g] = lg[g]; }
#pragma unroll
                for (int o = 1; o < 16; o <<= 1)
#pragma unroll
                    for (int g = 0; g < 4; ++g) mx[g] = fmaxf(mx[g], shx(mx[g], o));
#pragma unroll
                for (int g = 0; g < 4; ++g) { lg[g] = expf(lg[g] - mx[g]); se[g] = lg[g]; }
#pragma unroll
                for (int o = 1; o < 16; o <<= 1)
#pragma unroll
                    for (int g = 0; g < 4; ++g) se[g] += shx(se[g], o);
                f32x4 af; af.x = lg[0] / se[0]; af.y = lg[1] / se[1]; af.z = lg[2] / se[2]; af.w = lg[3] / se[3];
                size_t off;
                if (m0 < NLAT) off = ((size_t)((m0 >> 14) * 16 + r)) * SEQ + (m0 & (SEQ - 1)) + 4 * kq;
                else { const int c = m0 - NLAT; off = (size_t)2 * 16 * SEQ + ((size_t)((c >> 8) * 16 + r)) * CTXL + (c & 255) + 4 * kq; }
                *(f32x4*)(AFF + off) = af;
            }
            if (!PV(0)) {
            const LAS float* shp = SHl + set * 1024 + 256 * q + 4 * kq; bf16* hp = H2 + (size_t)(m0 + r) * D + 256 * q + 4 * kq;
#pragma unroll
            for (int jj = 0; jj < 16; ++jj) { const f32x4 h = xa[jj] * rstd + *(const LAS f32x4*)(shp + 16 * jj);
                u32x2 o; o.x = pk2(h.x, h.y); o.y = pk2(h.z, h.w); *(u32x2*)(hp + 16 * jj) = o; }
            }
        }
#pragma unroll
        for (int jj = 0; jj < 16; ++jj) xa[jj] = xb[jj];
        tI = tN;
    }
    }
#undef RT_LOADT
    __syncthreads();
}

__device__ __forceinline__ void topk_phase(const Args& a, int l, LAS unsigned char* lds, int tid, int lane, int wave, int bid, int G) {
    LAS unsigned* red = (LAS unsigned*)lds;
    LAS unsigned* cg = red + 64;
    LAS unsigned* ce = cg + 256;
    const int ngroups = (l == 0) ? 64 : 32;
    const float* AFF = (const float*)(a.ws + WS_AFF); int* SEL = (int*)(a.ws + WS_SEL); int* SRCROW = (int*)(a.ws + WS_SRCROW); float* GATEV = (float*)(a.ws + WS_GATEV);
    for (int g = bid; g < ngroups; g += G) {
        const int set4 = g >> 4, e = g & 15; const int n = set4 < 2 ? SEQ : CTXL, cap = n >> 3;
        const float* af = set4 < 2 ? AFF + (size_t)(set4 * 16 + e) * SEQ : AFF + (size_t)2 * 16 * SEQ + (size_t)((set4 - 2) * 16 + e) * CTXL;
        const int tokbase = set4 < 2 ? set4 * SEQ : NLAT + (set4 - 2) * CTXL; const int rowbase = xe_rowbase(set4, e);
        unsigned v[32];
#pragma unroll
        for (int j = 0; j < 32; ++j) { const int idx = tid + 512 * j; v[j] = idx < n ? __float_as_uint(af[idx]) : 0u; }
        unsigned T = 0u;
        for (int sft = 30; sft >= 0; sft -= 2) {
            const unsigned c1v = T | (1u << sft), c2v = T | (2u << sft), c3v = T | (3u << sft); unsigned c12 = 0, c3 = 0;
#pragma unroll
            for (int j = 0; j < 32; ++j) { c12 += (v[j] >= c1v ? 1u : 0u) + (v[j] >= c2v ? 0x10000u : 0u); c3 += (v[j] >= c3v) ? 1u : 0u; }
#pragma unroll
            for (int o = 1; o < 64; o <<= 1) { c12 += (unsigned)shx_i((int)c12, o); c3 += (unsigned)shx_i((int)c3, o); }
            LAS unsigned* rb = red + ((sft >> 1) & 1) * 16;
            if (lane == 0) { rb[wave] = c12; rb[8 + wave] = c3; }
            __syncthreads();
            unsigned t12 = 0, t3 = 0;
#pragma unroll
            for (int w = 0; w < 8; ++w) { t12 += rb[w]; t3 += rb[8 + w]; }
            const unsigned n1 = t12 & 0xffffu, n2 = t12 >> 16;
            if (t3 >= (unsigned)cap) T = c3v; else if (n2 >= (unsigned)cap) T = c2v; else if (n1 >= (unsigned)cap) T = c1v;
        }
#pragma unroll
        for (int j = 0; j < 32; ++j) { const unsigned long long mgj = __ballot(v[j] > T), mej = __ballot(v[j] == T && (tid + 512 * j) < n);
            if (lane == 0) { cg[j * 8 + wave] = (unsigned)__popcll(mgj); ce[j * 8 + wave] = (unsigned)__popcll(mej); } }
        __syncthreads();
        if (tid == 0) { unsigned sg = 0, se = 0; for (int i = 0; i < 256; ++i) { const unsigned x = cg[i], y = ce[i]; cg[i] = sg; ce[i] = se; sg += x; se += y; } red[32] = sg; }
        __syncthreads();
        const unsigned ngt = red[32]; const unsigned need_eq = (unsigned)cap - ngt;
        const unsigned long long lt = (lane == 0) ? 0ull : (~0ull >> (64 - lane));
#pragma unroll
        for (int j = 0; j < 32; ++j) { const int idx = tid + 512 * j;
            const unsigned long long mgj = __ballot(v[j] > T), mej = __ballot(v[j] == T && idx < n);
            if (idx < n) {
                const unsigned gb = cg[j * 8 + wave] + (unsigned)__popcll(mgj & lt), eb = ce[j * 8 + wave] + (unsigned)__popcll(mej & lt);
                const bool isg = v[j] > T, ise = v[j] == T; const bool selc = isg || (ise && eb < need_eq);
                const unsigned slot = gb + (eb < need_eq ? eb : need_eq);
                if (selc) { SRCROW[rowbase + slot] = tokbase + idx; GATEV[rowbase + slot] = __uint_as_float(v[j]); }
                SEL[(size_t)(tokbase + idx) * 16 + e] = selc ? (int)slot : -1;
            } }
        if (set4 == 2 && tid >= 64 && tid < 256) { SRCROW[XE_LAT + e * 256 + tid] = NLAT; GATEV[XE_LAT + e * 256 + tid] = 0.f; }
        __syncthreads();
    }
}


constexpr int NPH_LAYER = 11;
constexpr int NPHASES = 1 + 2 * NPH_LAYER + 1;
constexpr bool PER_PHASE_LAUNCH = (MK_N_LAUNCHES != 1);
#ifndef MK_PHASE_MASK
#define MK_PHASE_MASK 0xffffu
#endif
#define EN(k) (((MK_PHASE_MASK) >> (k)) & 1u)

#ifndef MK_CVS
#define MK_CVS 0, 0, 4000, 4000, 4000, 66400, 66400
#endif
__device__ __forceinline__ constexpr int CVS_AT(int s) { constexpr int t[7] = {MK_CVS}; return s <= 0 ? 0 : (s >= 8 ? CV_ALL : t[s - 1]); }
typedef const __attribute__((address_space(4))) Args* KArgPtr;
__device__ __forceinline__ Args load_args(KArgPtr p) { Args a;
#pragma unroll
    for (int i = 0; i < 30; ++i) a.in[i] = p->in[i];
    a.out = p->out; a.ws = p->ws; a.ph_lo = p->ph_lo; a.ph_hi = p->ph_hi; a.li = p->li;
#if defined(MK_PROBE_KIND) && MK_PROBE_KIND >= 0
    a.pad = p->pad;
#else
    a.pad = 0;
#endif
    return a; }
__global__ void __launch_bounds__(512, 2) mk_fwd(Args args) {
    extern __shared__ __attribute__((aligned(16))) unsigned char lds_raw[];
    LAS unsigned char* lds = (LAS unsigned char*)lds_raw;
    const int wave0 = __builtin_amdgcn_readfirstlane((int)threadIdx.x >> 6);
#define MK_TID() (wave0 * 64 + lane_now())
#define LAUNDER() KArgPtr ap_ = kap; asm volatile("" : "+s"(ap_)); const Args A = load_args(ap_); unsigned char* ws = A.ws; (void)ws; int tid = MK_TID(); const int lane = tid & 63, wave = __builtin_amdgcn_readfirstlane(tid >> 6); (void)lane; (void)wave
    const int G = gridDim.x, bid = blockIdx.x; const int vcu = (G % 8 == 0) ? (bid % 8) * (G / 8) + bid / 8 : bid;
    volatile LAS unsigned* MISC = (volatile LAS unsigned*)(lds + MISC_OFF);
    for (int u = MK_TID(); u < (LDS_BYTES - RING_BYTES) / 4; u += 512) ((LAS unsigned*)(lds + RING_BYTES))[u] = 0u;
    __syncthreads();
    KArgPtr kap = (KArgPtr)__builtin_amdgcn_kernarg_segment_ptr();
    unsigned* ctl = (unsigned*)(args.ws + WS_CTL);
    unsigned* barw = ctl + CW_BAR + args.li * XCD_BAR_WORDS;
    XcdBarrier bar; bar.bar = barw; bar.x = 0; bar.st = nullptr;
    if (!PER_PHASE_LAUNCH) bar = xcd_barrier_post(barw, MISC + 8, MK_TID() == 0);
    const int lo = args.ph_lo, hi = args.ph_hi;
#define IN(k) (lo <= (k) && (k) < hi)
#define SEAM(k) do { if (IN(k) && IN((k) + 1)) { if (PER_PHASE_LAUNCH) { if (MK_TID() == 0) __hip_atomic_store(ctl + CW_TMO, 0xBADBA0u, __ATOMIC_RELAXED, __HIP_MEMORY_SCOPE_AGENT); } else { xcd_barrier(bar, MK_TID() == 0); } } } while (0)

#define PH(kind, id, ...) do { if constexpr (EN(kind)) { if (IN(id)) { __VA_ARGS__ } } } while (0)
#define TAIL_CONV(busy_, s_) do { const int busy__ = (busy_) % G; if (bid >= busy__ && CVS_AT(s_) < CVS_AT((s_) + 1)) { __syncthreads(); conv_items(A, 1, CVS_AT(s_), CVS_AT((s_) + 1), lds, lane, wave, (bid - busy__) * 8 + wave, (G - busy__) * 8); } } while (0)
    PH(0, 0, LAUNDER(); pro_phase(A, lds, tid, bid, G); conv_items(A, 0, 0, CV_ALL, lds + 16384, lane, wave, vcu * 8 + wave, G * 8););
    SEAM(0);
#pragma unroll 1
    for (int l = 0; l < 2; ++l) {
        const int pb = 1 + NPH_LAYER * l;
        const int nrow_attn = (l == 0) ? NROW : NLAT;
        PH(1, pb + 0, LAUNDER(); modul_phase(A, l, lane, wave, vcu, G); if (l == 1) { TAIL_CONV(0, 5); });
        SEAM(pb + 0);
        PH(2, pb + 1, LAUNDER(); pg8::Gemm g{(const bf16*)(ws + WS_H), w_in(A, l), NROW, NP, D}; pg8::StaticOrder S; S.init(NROW, NP, G, bid);
            EpiPTile E{(bf16*)(ws + WS_P)};
            pg8::gemm_phase<EpiPTile, pg8::StaticOrder, true, true, false, true>(lds, g, S, E, tid);
            if (l == 0) { TAIL_CONV((NROW / 256) * (NP / 256), 0); } else { TAIL_CONV((NROW / 256) * (NP / 256), 6); });
        SEAM(pb + 1);
        PH(3, pb + 2, LAUNDER(); prep1_phase(A, l, lds, lane, wave, vcu, G););
        SEAM(pb + 2);
        PH(5, pb + 4, LAUNDER(); up2_phase(A, l, lane, wave, vcu, G););
        SEAM(pb + 4);
        PH(6, pb + 5, LAUNDER(); attn_phase(A, l, lds, tid, vcu, G););
        SEAM(pb + 5);
        PH(7, pb + 6, LAUNDER(); pg8::Gemm g{(const bf16*)(ws + WS_O), w_out(A, l), nrow_attn, D, D}; pg8::StaticOrder S; S.init(nrow_attn, D, G, bid);
            EpiRes E{l == 0 ? A.in[I_X] : (const float*)x2_of(A), l == 0 ? A.in[I_CTX] : (const float*)x2_of(A) + (size_t)NLAT * D, (float*)(ws + WS_X1), (const float*)(ws + WS_MOD) + (size_t)l * 3 * 6144};
            pg8::gemm_phase<EpiRes, pg8::StaticOrder, true, true, false, true>(lds, g, S, E, tid);
            if (l == 0) { TAIL_CONV((NROW / 256) * (D / 256), 1); });
        SEAM(pb + 6);
        PH(8, pb + 7, LAUNDER(); router_phase(A, l, lds, tid, lane, wave, vcu, G););
        SEAM(pb + 7);
        PH(9, pb + 8, LAUNDER(); topk_phase(A, l, lds, tid, lane, wave, bid, G); if (l == 0) { TAIL_CONV(64, 2); } else { TAIL_CONV(32, 7); });
        SEAM(pb + 8);
        PH(11, pb + 9, LAUNDER(); pg8::Gemm g{(const bf16*)(ws + WS_H2), w_gu(A, l), XE_LAT, 5632, D}; const int gap = l == 0 ? 0 : GU_GAP_TILES; EpiSwiglu E{(bf16*)(ws + WS_ACT), false}; EpiSwiglu Eh{(bf16*)(ws + WS_ACT), true};
            { ExpertGatherOrder S; S.init(XE_LAT, 5632, G, bid, 0, gap); S.srcrow = (const int*)(ws + WS_SRCROW);
              pg8::gemm_phase<EpiSwiglu, ExpertGatherOrder, true, true, false, true>(lds, g, S, E, tid); }
            if (l == 0) { __syncthreads(); ExpertGatherOrder S; S.init(XE_ALL - XE_LAT, 5632, G, bid, 256); S.srcrow = (const int*)(ws + WS_SRCROW);
              pg8::gemm_phase<EpiSwiglu, ExpertGatherOrder, true, true, true, true>(lds, g, S, Eh, tid);
              TAIL_CONV(((XE_ALL - XE_LAT) / 256) * 22, 3); });
        SEAM(pb + 9);
        PH(12, pb + 10, LAUNDER(); pg8::Gemm g{(const bf16*)(ws + WS_ACT), w_d(A, l), XE_LAT, D, DFF}; EpiDown E{(bf16*)(ws + WS_Y), (const float*)(ws + WS_GATEV), false}; EpiDown Eh{(bf16*)(ws + WS_Y), (const float*)(ws + WS_GATEV), true};
            { ExpertOrder S; S.init(XE_LAT, D, G, bid);
              pg8::gemm_phase<EpiDown, ExpertOrder, true, true, false, true, true>(lds, g, S, E, tid); }
            if (l == 0) { __syncthreads(); ExpertOrder S; S.init(XE_ALL - XE_LAT, D, G, bid, 256);
              pg8::gemm_phase<EpiDown, ExpertOrder, true, true, true, true, true>(lds, g, S, Eh, tid);
              TAIL_CONV(((XE_ALL - XE_LAT) / 256) * 4, 4); });
        SEAM(pb + 10);
    }
    PH(13, NPHASES - 1, LAUNDER(); final_phase(A, lane, wave, vcu, G););
#undef IN
#undef SEAM
}
}

extern "C" void kernel_launch(void* const* d_in, const int* in_sizes, int n_in, void* d_out, int out_size, void* d_ws, size_t ws_size, hipStream_t stream) {
    using namespace mk;
    static int grid = 0;
    if (grid == 0) {
        if (n_in != 30 || out_size != NLAT * D || ws_size < WS_NEED) { fprintf(stderr, "kernel_launch: unexpected shapes: n_in %d out %d ws %zu (need %zu)\n", n_in, out_size, ws_size, (size_t)WS_NEED); grid = -1; return; }
        int dev = 0, cus = 0, per_cu = 0;
        if (hipGetDevice(&dev) != hipSuccess || hipDeviceGetAttribute(&cus, hipDeviceAttributeMultiprocessorCount, dev) != hipSuccess) { grid = -1; return; }
        if (hipFuncSetAttribute((const void*)mk_fwd, hipFuncAttributeMaxDynamicSharedMemorySize, LDS_BYTES) != hipSuccess) { fprintf(stderr, "kernel_launch: hipFuncSetAttribute failed\n"); grid = -1; return; }
        if (hipOccupancyMaxActiveBlocksPerMultiprocessor(&per_cu, (const void*)mk_fwd, 512, LDS_BYTES) != hipSuccess || per_cu < 1) fprintf(stderr, "kernel_launch: occupancy query reports %d\n", per_cu);
        (void)hipGetLastError();
        grid = cus;
    }
    if (grid < 0) return;
    if (hipMemsetAsync((char*)d_ws + WS_CTL, 0, CTL_ZERO_BYTES, stream) != hipSuccess) return;
    Args a{};
    for (int i = 0; i < 30; ++i) a.in[i] = (const float*)d_in[i];
    a.out = (float*)d_out; a.ws = (unsigned char*)d_ws;
    if (PER_PHASE_LAUNCH) {
        for (int p = 0; p < NPHASES; ++p) { a.ph_lo = p; a.ph_hi = p + 1; a.li = 0; hipLaunchKernelGGL(mk_fwd, dim3(grid), dim3(512), LDS_BYTES, stream, a); }
    } else {
#if defined(MK_PROBE_KIND) && MK_PROBE_KIND >= 0
        int cuts[16]; int nc = 0; cuts[nc++] = 0;
        const int k0 = (MK_PROBE_KIND == 0) ? 0 : MK_PROBE_KIND, k1 = (MK_PROBE_KIND == 0 || MK_PROBE_KIND == 13) ? -1 : MK_PROBE_KIND + NPH_LAYER;
        const int kk0 = (MK_PROBE_KIND == 13) ? NPHASES - 1 : k0;
        int li = 0;
        auto launch = [&](int lo, int hi) { a.ph_lo = lo; a.ph_hi = hi; a.li = li++; a.pad = (hi == lo + 1 && li > 1) ? MK_PROBE_VAR : 0; hipLaunchKernelGGL(mk_fwd, dim3(grid), dim3(512), LDS_BYTES, stream, a); };
        launch(0, kk0 + 1); launch(kk0, kk0 + 1);
        if (k1 >= 0) { launch(kk0 + 1, k1 + 1); launch(k1, k1 + 1); if (k1 + 1 < NPHASES) launch(k1 + 1, NPHASES); }
        else if (kk0 + 1 < NPHASES) launch(kk0 + 1, NPHASES);
        (void)cuts; (void)nc;
#else
        a.ph_lo = 0; a.ph_hi = NPHASES; a.li = 0; hipLaunchKernelGGL(mk_fwd, dim3(grid), dim3(512), LDS_BYTES, stream, a);
#endif
    }
}
```

```cpp
#include <hip/hip_runtime.h>
#include <cstdio>
#include <cstdint>
#ifndef MK_N_LAUNCHES
#define MK_N_LAUNCHES 1
#endif
#define MK_PROBE_KIND -1
#define MK_XPROBE 0
#define MK_PROBE_VAR 0
namespace pg8 {
#define PG8_LAS __attribute__((address_space(3)))
typedef unsigned short bf16_t;
typedef short bf16x8 __attribute__((ext_vector_type(8)));
typedef float f32x4 __attribute__((ext_vector_type(4)));
typedef unsigned u32x4 __attribute__((ext_vector_type(4)));
constexpr int BM = 256, BK = 64, HALF = 128, HTB = HALF * BK * 2  , STAGE_BYTES = 8 * HTB, NXCD = 8, WGM = 8;

__host__ __device__ __forceinline__ int lds_byte(int r, int c) { const int st = (r >> 4) * 2 + (c >> 5), rr = r & 15, cc = c & 31, ob = rr * 64 + cc * 2; return st * 1024 + (ob ^ (((ob >> 9) & 1) << 5)); }
__host__ __device__ __forceinline__ void stage_rc(int b, int& R, int& C) { const int st = b / 1024, sb = b % 1024, swz = sb ^ (((sb >> 9) & 1) << 5); R = (st >> 1) * 16 + swz / 64; C = (st & 1) * 32 + (swz % 64) / 2; }
__host__ __device__ __forceinline__ int perm32(int rho) { const int n = rho >> 4, i = rho & 15; return 8 * (i >> 2) + 4 * n + (i & 3); }

struct Unit { int pm, pn; };
struct Gemm { const bf16_t* A; const bf16_t* Bt; int M, N, K; };

struct StaticOrder {
    int nM, nN, nwg, G, c;
    __host__ __device__ void init(int M, int N, int G_, int c_) { nM = M / BM; nN = N / BM; nwg = nM * nN; G = G_; c = c_; }
    __host__ __device__ bool next(int i, Unit& u) const {
        const long L = (long)i * G + c; if (L >= nwg) return false;
        int wgid = (int)L; { const int q = nwg / NXCD, r = nwg % NXCD, xcd = wgid % NXCD, off = wgid / NXCD; wgid = (xcd < r ? xcd * (q + 1) : r * (q + 1) + (xcd - r) * q) + off; }
        const int nig = WGM * nN, gid = wgid / nig, fm = gid * WGM, gsz = (nM - fm) < WGM ? (nM - fm) : WGM;
        u.pm = fm + ((wgid % nig) % gsz); u.pn = (wgid % nig) / gsz; return true;
    }
    __device__ __forceinline__ void a_ready(const Unit&) const {}
    __device__ __forceinline__ void done(const Unit&) const {}
};

__device__ __forceinline__ unsigned cvt_pk_bf16(float lo, float hi) { unsigned r; asm volatile("v_cvt_pk_bf16_f32 %0, %1, %2" : "=v"(r) : "v"(lo), "v"(hi)); return r; }
typedef float f32x2 __attribute__((ext_vector_type(2)));
__device__ __forceinline__ f32x2 gelu_pk(f32x2 v) {
    const f32x2 av = __builtin_elementwise_abs(v), d = av * 0.2316418882f + 1.0f;
    f32x2 t; t.x = __builtin_amdgcn_rcpf(d.x); t.y = __builtin_amdgcn_rcpf(d.y);
    f32x2 q = t * 0.5307027145f + (-0.7265760135f); q = q * t + 0.7107068705f; q = q * t + (-0.142248368f); q = q * t + 0.127414796f; q = q * t;
    const f32x2 s = (v * v) * (-0.72134752044f);
    f32x2 e; e.x = __builtin_amdgcn_exp2f(s.x); e.y = __builtin_amdgcn_exp2f(s.y);
    const f32x2 m = v * (q * e), r = v - m;
    f32x2 o; o.x = v.x < 0.f ? m.x : r.x; o.y = v.y < 0.f ? m.y : r.y; return o;
}

template <int ACT  > struct EpiBf16 {
    static constexpr bool PERM = true, AFTER_DRAIN = false; static_assert(ACT == 0 || ACT == 1, "EpiBf16: ACT is 0 (none) or 1 (gelu_pk)");
    bf16_t* O; int ldc; const float* bias; int split_cols; size_t split_stride; float scale0;
    __device__ __forceinline__ void operator()(const f32x4 (&acc)[2][2][4][2], const Unit& u, int wr, int wc, int fr, int fq) const {
        const int row0 = u.pm * BM + wr * 64 + fr; int colt = u.pn * BM; bf16_t* base = O;
        float sc = 1.f; if (split_cols) { const int t = colt / split_cols; base += (size_t)t * split_stride; colt -= t * split_cols; if (t == 0) sc = scale0; }
        const int col0 = colt + wc * 32 + 8 * fq, bcol0 = u.pn * BM + wc * 32 + 8 * fq;
        f32x4 bv[2][2];
#pragma unroll
        for (int bj = 0; bj < 2; ++bj)
#pragma unroll
            for (int n = 0; n < 2; ++n) bv[bj][n] = bias ? *(const f32x4*)(bias + bcol0 + bj * HALF + 4 * n) : (f32x4){0.f, 0.f, 0.f, 0.f};
#pragma unroll
        for (int ai = 0; ai < 2; ++ai)
#pragma unroll
            for (int m = 0; m < 4; ++m) { bf16_t* rowp = base + (size_t)(row0 + ai * HALF + m * 16) * ldc + col0;
#pragma unroll
                for (int bj = 0; bj < 2; ++bj) { f32x4 v0 = acc[ai][bj][m][0] + bv[bj][0], v1 = acc[ai][bj][m][1] + bv[bj][1];
                    if (ACT == 1) { f32x2 a = gelu_pk((f32x2){v0[0], v0[1]}), b = gelu_pk((f32x2){v0[2], v0[3]}), c = gelu_pk((f32x2){v1[0], v1[1]}), d = gelu_pk((f32x2){v1[2], v1[3]});
                        v0 = (f32x4){a.x, a.y, b.x, b.y}; v1 = (f32x4){c.x, c.y, d.x, d.y}; }
                    v0 = v0 * sc; v1 = v1 * sc; u32x4 w; w.x = cvt_pk_bf16(v0[0], v0[1]); w.y = cvt_pk_bf16(v0[2], v0[3]); w.z = cvt_pk_bf16(v1[0], v1[1]); w.w = cvt_pk_bf16(v1[2], v1[3]);
                    *(u32x4*)(rowp + bj * HALF) = w; } }
    }
};
template <class S> constexpr bool sched_gather_v = false;
template <class Epi, class Sched, bool ALIGN_EPI = false, bool SP2 = false, bool HALF_ROWS = false, bool BTILED = false, bool ATILED = false>
__device__ __forceinline__ void gemm_phase(PG8_LAS unsigned char* lds, const Gemm g, const Sched& S, const Epi& E, int tid_in) {
    int tid_l = tid_in; asm volatile("" : "+v"(tid_l));
    const int tid = tid_l, wid = __builtin_amdgcn_readfirstlane(tid >> 6), lane = tid & 63, wr = wid >> 2, wc = wid & 3, fr = lane & 15, fq = lane >> 4;
    const int K = g.K, nt = K / BK;
    unsigned voffA[2], voffB[2];
#pragma unroll
    for (int i = 0; i < 2; ++i) { int R, C; stage_rc(tid * 16 + i * 8192, R, C); const int Rb = Epi::PERM ? ((R & ~31) + perm32(R & 31)) : R;
        voffA[i] = ATILED ? (unsigned)((R >> 5) * (K / 64) * 2048 + (R & 31) * 64 + C) * 2u : (unsigned)(R * K + C) * 2u; voffB[i] = BTILED ? (unsigned)((Rb >> 5) * (K / 64) * 2048 + (Rb & 31) * 64 + C) * 2u : (unsigned)(Rb * K + C) * 2u; }
    const size_t kstep = (size_t)(BK * 2);
    const size_t kstepA = ATILED ? (size_t)4096 : kstep;
    const size_t kstepB = BTILED ? (size_t)4096 : kstep;
    const size_t hstep = (size_t)HALF * K * 2;
    const size_t tstep = 2 * hstep;
    constexpr bool GATHER = sched_gather_v<Sched>;
    const size_t hstepA = GATHER ? (size_t)0 : hstep;
    const unsigned ldsw = (unsigned)wid * 1024u;
    const int aoff = lds_byte(wr * 64 + fr, fq * 8), boff = lds_byte(wc * 32 + fr, fq * 8);
#define PG8_SA(b, h) (((b) * 2 + (h)) * HTB)
#define PG8_SB(b, h) ((4 + (b) * 2 + (h)) * HTB)
#define PG8_STAGE(bufoff, gbase, voff) do { _Pragma("unroll") for (int _i = 0; _i < 2; ++_i) \
        __builtin_amdgcn_global_load_lds((const unsigned*)((const char*)(gbase) + (voff)[_i]), (PG8_LAS unsigned*)(lds + (bufoff) + ldsw + _i * 8192), 16, 0, 0); } while (0)
#define PG8_LDA(dst, b, h) do { _Pragma("unroll") for (int m = 0; m < 4; ++m) _Pragma("unroll") for (int k = 0; k < 2; ++k) dst[m][k] = *(const PG8_LAS bf16x8*)(lds + PG8_SA(b, h) + aoff + m * 2048 + k * 1024); } while (0)
#define PG8_LDB(dst, b, h) do { _Pragma("unroll") for (int n = 0; n < 2; ++n) _Pragma("unroll") for (int k = 0; k < 2; ++k) dst[n][k] = *(const PG8_LAS bf16x8*)(lds + PG8_SB(b, h) + boff + n * 2048 + k * 1024); } while (0)
#define PG8_MMA(ai, bj, At, Bt) do { __builtin_amdgcn_s_setprio(1); _Pragma("unroll") for (int m = 0; m < 4; ++m) _Pragma("unroll") for (int n = 0; n < 2; ++n) _Pragma("unroll") for (int k = 0; k < 2; ++k) \
        acc[ai][bj][m][n] = __builtin_amdgcn_mfma_f32_16x16x32_bf16(Bt[n][k], At[m][k], acc[ai][bj][m][n], 0, 0, 0); __builtin_amdgcn_s_setprio(0); } while (0)
#define PG8_WAIT_V(n) asm volatile("s_waitcnt vmcnt(" #n ")" ::: "memory")
#define PG8_WAIT_L(n) asm volatile("s_waitcnt lgkmcnt(" #n ")" ::: "memory")
#define PG8_BAR __builtin_amdgcn_s_barrier()
#define PG8_SCHED __builtin_amdgcn_sched_barrier(0)
    Unit cur, nxt; int ui = 0;
    if (!S.next(0, cur)) return;
    f32x4 acc[2][2][4][2];
#pragma unroll
    for (int a = 0; a < 2; ++a)
#pragma unroll
        for (int b = 0; b < 2; ++b)
#pragma unroll
            for (int m = 0; m < 4; ++m)
#pragma unroll
                for (int n = 0; n < 2; ++n) acc[a][b][m][n] = (f32x4){0.f, 0.f, 0.f, 0.f};
    bf16x8 At[4][2], B0[2][2], B1[2][2];
    const char* cA = GATHER ? (const char*)g.A : (const char*)g.A + (size_t)cur.pm * tstep; const char* cB = (const char*)g.Bt + (size_t)cur.pn * tstep;
    unsigned vA[2][2], nvA[2][2];
#define PG8_AOFF(dst, u) do { _Pragma("unroll") for (int _h = 0; _h < 2; ++_h) _Pragma("unroll") for (int _i = 0; _i < 2; ++_i) { \
        if constexpr (GATHER) { int R_, C_; stage_rc(tid * 16 + _i * 8192, R_, C_); dst[_h][_i] = (unsigned)S.aoff(u, _h * HALF + R_) * (unsigned)(K * 2) + (unsigned)(C_ * 2); } else dst[_h][_i] = voffA[_i]; } } while (0)
    PG8_AOFF(vA, cur);
#pragma unroll
    for (int _h = 0; _h < 2; ++_h)
#pragma unroll
        for (int _i = 0; _i < 2; ++_i) nvA[_h][_i] = vA[_h][_i];
    S.a_ready(cur);
    if constexpr (SP2) {
        PG8_STAGE(PG8_SB(0, 0), cB, voffB); PG8_STAGE(PG8_SB(0, 1), cB + hstep, voffB); PG8_STAGE(PG8_SA(0, 0), cA, vA[0]); PG8_STAGE(PG8_SA(0, 1), cA + hstepA, vA[1]);
        if (wr == 1) PG8_BAR;
        PG8_WAIT_V(2); PG8_BAR;
        PG8_STAGE(PG8_SB(1, 0), cB + kstepB, voffB); PG8_STAGE(PG8_SA(1, 0), cA + kstepA, vA[0]); PG8_STAGE(PG8_SB(1, 1), cB + hstep + kstepB, voffB);
        PG8_WAIT_V(6); PG8_BAR;
    } else {
        PG8_STAGE(PG8_SB(0, 0), cB, voffB); PG8_STAGE(PG8_SA(0, 0), cA, vA[0]); PG8_STAGE(PG8_SB(0, 1), cB + hstep, voffB); PG8_STAGE(PG8_SA(0, 1), cA + hstepA, vA[1]);
        if (wr == 1) PG8_BAR;
        PG8_WAIT_V(4); PG8_BAR;
        PG8_STAGE(PG8_SB(1, 0), cB + kstepB, voffB); PG8_STAGE(PG8_SA(1, 0), cA + kstepA, vA[0]); PG8_STAGE(PG8_SB(1, 1), cB + hstep + kstepB, voffB);
        PG8_WAIT_V(6); PG8_BAR;
    }
    for (;;) {
        const bool has_next = S.next(ui + 1, nxt);
        const char* nA = (has_next && !GATHER) ? (const char*)g.A + (size_t)nxt.pm * tstep : cA;
        if constexpr (GATHER) { if (has_next) PG8_AOFF(nvA, nxt); } const char* nB = has_next ? (const char*)g.Bt + (size_t)nxt.pn * tstep : cB;
#pragma unroll 1
        for (int t = 0; t < nt; t += 2) {
            const bool last = (t == nt - 2);
            const char* a1 = cA + (size_t)(t + 1) * kstepA;
            const char* a2 = last ? nA : cA + (size_t)(t + 2) * kstepA; const char* b2 = last ? nB : cB + (size_t)(t + 2) * kstepB;
            const char* a3 = a2 + kstepA; const char* b3 = b2 + kstepB;
            unsigned sA0[2], sA1[2]; sA0[0] = last ? nvA[0][0] : vA[0][0]; sA0[1] = last ? nvA[0][1] : vA[0][1]; sA1[0] = last ? nvA[1][0] : vA[1][0]; sA1[1] = last ? nvA[1][1] : vA[1][1];
            if (last && has_next) S.a_ready(nxt);
            if constexpr (SP2) {
            PG8_LDB(B0, 0, 0); PG8_LDB(B1, 0, 1); PG8_SCHED; PG8_LDA(At, 0, 0); PG8_STAGE(PG8_SA(1, 1), a1 + hstepA, vA[1]);
            PG8_WAIT_V(8); PG8_WAIT_L(0); PG8_BAR; if (!HALF_ROWS || wr == 0) { PG8_MMA(0, 0, At, B0); PG8_MMA(0, 1, At, B1); } PG8_BAR; PG8_SCHED;
            PG8_LDA(At, 0, 1); PG8_STAGE(PG8_SB(0, 0), b2, voffB); PG8_STAGE(PG8_SB(0, 1), b2 + hstep, voffB); PG8_STAGE(PG8_SA(0, 0), a2, sA0);
            PG8_WAIT_V(8); PG8_WAIT_L(0); PG8_BAR; if constexpr (!HALF_ROWS) { PG8_MMA(1, 0, At, B0); PG8_MMA(1, 1, At, B1); } PG8_BAR; PG8_SCHED;
            PG8_LDB(B0, 1, 0); PG8_LDB(B1, 1, 1); PG8_SCHED; PG8_LDA(At, 1, 0); PG8_STAGE(PG8_SA(0, 1), a2 + hstepA, sA1);
            PG8_WAIT_V(8); PG8_WAIT_L(0); PG8_BAR; if (!HALF_ROWS || wr == 0) { PG8_MMA(0, 0, At, B0); PG8_MMA(0, 1, At, B1); } PG8_BAR; PG8_SCHED;
            PG8_LDA(At, 1, 1); PG8_STAGE(PG8_SB(1, 0), b3, voffB); PG8_STAGE(PG8_SB(1, 1), b3 + hstep, voffB); PG8_STAGE(PG8_SA(1, 0), a3, sA0);
            PG8_WAIT_V(8); PG8_WAIT_L(0); PG8_BAR; if constexpr (!HALF_ROWS) { PG8_MMA(1, 0, At, B0); PG8_MMA(1, 1, At, B1); } PG8_BAR; PG8_SCHED;
            } else {
            PG8_LDB(B0, 0, 0); PG8_SCHED; PG8_LDA(At, 0, 0); PG8_STAGE(PG8_SA(1, 1), a1 + hstepA, vA[1]);
            PG8_WAIT_L(8); PG8_BAR; PG8_WAIT_L(0); PG8_MMA(0, 0, At, B0); PG8_BAR; PG8_SCHED;
            PG8_LDB(B1, 0, 1); PG8_STAGE(PG8_SB(0, 0), b2, voffB);
            PG8_BAR; PG8_WAIT_L(0); PG8_MMA(0, 1, At, B1); PG8_BAR;
            PG8_LDA(At, 0, 1); PG8_STAGE(PG8_SA(0, 0), a2, sA0);
            PG8_BAR; PG8_WAIT_L(0); PG8_MMA(1, 0, At, B0); PG8_BAR; PG8_SCHED;
            PG8_STAGE(PG8_SB(0, 1), b2 + hstep, voffB);
            PG8_WAIT_V(6); PG8_BAR; PG8_MMA(1, 1, At, B1); PG8_BAR;
            PG8_LDB(B0, 1, 0); PG8_SCHED; PG8_LDA(At, 1, 0); PG8_STAGE(PG8_SA(0, 1), a2 + hstepA, sA1);
            PG8_WAIT_L(8); PG8_BAR; PG8_WAIT_L(0); PG8_MMA(0, 0, At, B0); PG8_BAR; PG8_SCHED;
            PG8_LDB(B1, 1, 1); PG8_STAGE(PG8_SB(1, 0), b3, voffB);
            PG8_BAR; PG8_WAIT_L(0); PG8_MMA(0, 1, At, B1); PG8_BAR;
            PG8_LDA(At, 1, 1); PG8_STAGE(PG8_SA(1, 0), a3, sA0);
            PG8_BAR; PG8_WAIT_L(0); PG8_MMA(1, 0, At, B0); PG8_BAR; PG8_SCHED;
            PG8_STAGE(PG8_SB(1, 1), b3 + hstep, voffB);
            PG8_WAIT_V(6); PG8_BAR; PG8_MMA(1, 1, At, B1); PG8_BAR;
            }
        }
        if constexpr (ALIGN_EPI) { if (wr == 0) PG8_BAR; }
        if constexpr (!Epi::AFTER_DRAIN) { E(acc, cur, wr, wc, fr, fq); S.done(cur); }
        if (!has_next) break;
#pragma unroll
        for (int a = 0; a < 2; ++a)
#pragma unroll
            for (int b = 0; b < 2; ++b)
#pragma unroll
                for (int m = 0; m < 4; ++m)
#pragma unroll
                    for (int n = 0; n < 2; ++n) acc[a][b][m][n] = (f32x4){0.f, 0.f, 0.f, 0.f};
        cur = nxt; cA = nA; cB = nB; ++ui;
#pragma unroll
        for (int _h = 0; _h < 2; ++_h) { vA[_h][0] = nvA[_h][0]; vA[_h][1] = nvA[_h][1]; }
        if constexpr (ALIGN_EPI) { if (wr == 1) PG8_BAR; }
    }
    PG8_WAIT_V(0);
    if constexpr (!ALIGN_EPI) { if (wr == 0) PG8_BAR; }
    PG8_BAR;
    if constexpr (Epi::AFTER_DRAIN) { E.fused(acc, cur, wr, wc, fr, fq, lds, wid, lane); S.done(cur); }
#undef PG8_AOFF
#undef PG8_SA
#undef PG8_SB
#undef PG8_STAGE
#undef PG8_LDA
#undef PG8_LDB
#undef PG8_MMA
#undef PG8_WAIT_V
#undef PG8_WAIT_L
#undef PG8_BAR
#undef PG8_SCHED
}
}

namespace mk {
typedef unsigned short bf16;
typedef short bf16x8 __attribute__((ext_vector_type(8)));
typedef float f32x4 __attribute__((ext_vector_type(4)));
typedef float f32x16 __attribute__((ext_vector_type(16)));
typedef unsigned u32x4 __attribute__((ext_vector_type(4)));
typedef unsigned u32x2 __attribute__((ext_vector_type(2)));
#define LAS __attribute__((address_space(3)))
#define GAS __attribute__((address_space(1)))

constexpr int D = 1024, NB = 2, SEQ = 16384, CTXL = 256;
constexpr int NLAT = NB * SEQ, NCTX = NB * CTXL, NROW = NLAT + NCTX;
constexpr int NP = 2560;
constexpr int NTILE = 260;
constexpr int DFF = 2816, NE = 16;
constexpr int XE_LAT = 65536, XE_ALL = 69632;
constexpr float EPS = 1e-6f;
constexpr float LOG2E = 1.4426950408889634f;

constexpr size_t MiB = (size_t)1 << 20;
constexpr size_t WS_CTL = 0, CTL_ZERO_BYTES = 1 * MiB;
constexpr size_t WS_MOD = 1 * MiB;
constexpr size_t WS_LAM = WS_MOD + 160 * 1024;
constexpr size_t WS_ROPE = WS_MOD + 256 * 1024;
constexpr size_t WS_WIN = 2 * MiB, WS_W2 = 7 * MiB, WS_WOUT = 8 * MiB, WS_WGU = 16 * MiB, WS_WD = 192 * MiB;
constexpr size_t WS_X1 = 280 * MiB, WS_X2 = 410 * MiB, WS_H2 = 540 * MiB, WS_Y = 605 * MiB;
constexpr size_t WS_AFF = 741 * MiB, WS_SEL = 744 * MiB, WS_SRCROW = 747 * MiB, WS_GATEV = 747 * MiB + 512 * 1024;
constexpr size_t WS_H = 748 * MiB, WS_P = 813 * MiB, WS_A2 = 976 * MiB, WS_U = 1001 * MiB;
constexpr size_t WS_QNA = 1066 * MiB, WS_QMLA = 1083 * MiB, WS_QDIFF = 1108 * MiB, WS_QGQA = 1125 * MiB;
constexpr size_t WS_KNA = 1142 * MiB, WS_KMLA = 1159 * MiB, WS_KDIFF = 1184 * MiB, WS_KGQA = 1201 * MiB;
constexpr size_t WS_VNA = 1210 * MiB, WS_VMLA = 1227 * MiB, WS_VDIFF = 1244 * MiB, WS_VGQA = 1261 * MiB;
constexpr size_t WS_O = 1270 * MiB;
constexpr size_t WS_XE = 748 * MiB, WS_ACT = 884 * MiB;
constexpr size_t WS_END = 1336 * MiB;
constexpr size_t WS_X2B = 16 * MiB, WS_WGU1 = 410 * MiB, WS_WGU1B = 1345 * MiB, WS_NEED = 1400 * MiB;
constexpr int GU_SPLIT_E = 11, GU_GAP_TILES = (int)((WS_WGU1B - WS_WGU1 - (size_t)GU_SPLIT_E * 11 * MiB) / (512 * 1024));
static_assert(GU_GAP_TILES % 22 == 0 && GU_GAP_TILES > 0, "gate/up split");
constexpr size_t OUT_WD1 = 0, OUT_WIN1 = 88 * MiB, OUT_W21 = 93 * MiB, OUT_WOUT1 = 94 * MiB;
static_assert(WS_ACT + (size_t)XE_ALL * DFF * 2 <= WS_O + (size_t)NROW * D * 2 && WS_O + (size_t)NROW * D * 2 <= WS_END, "ws map");
static_assert(WS_XE + (size_t)XE_ALL * D * 2 <= WS_ACT && WS_P + (size_t)NROW * NP * 2 <= WS_A2 && WS_Y + (size_t)XE_ALL * D * 2 <= WS_AFF, "ws map");

constexpr int CW_TMO = 0, CW_BAR = 4096;

constexpr int RING_BYTES = 131072;
constexpr int MISC_OFF = RING_BYTES + 320;
constexpr int LDS_BYTES = 147456;

struct Args { const float* in[30]; float* out; unsigned char* ws; int ph_lo, ph_hi, li, pad; };
enum { I_X = 0, I_C, I_CTX, I_CCTX, I_WMOD, I_BMOD, I_GATTN, I_GFFN, I_WIN, I_GNAQ, I_GNAK, I_RPB, I_GCQ, I_WUQ, I_GMQ, I_GCKV, I_WUKV, I_GKN, I_GKR,
       I_GDQ, I_GDK, I_DLAM, I_GDSUB, I_GGQ, I_GGK, I_WOUT, I_WROUTER, I_WGATE, I_WUP, I_WDOWN };

__device__ __forceinline__ bf16* w_in(const Args& a, int l) { return (bf16*)(l == 0 ? a.ws + WS_WIN : (unsigned char*)a.out + OUT_WIN1); }
__device__ __forceinline__ bf16* w_2(const Args& a, int l) { return (bf16*)(l == 0 ? a.ws + WS_W2 : (unsigned char*)a.out + OUT_W21); }
__device__ __forceinline__ bf16* w_out(const Args& a, int l) { return (bf16*)(l == 0 ? a.ws + WS_WOUT : (unsigned char*)a.out + OUT_WOUT1); }
__device__ __forceinline__ bf16* w_gu(const Args& a, int l) { return (bf16*)(a.ws + (l == 0 ? WS_WGU : WS_WGU1)); }
__device__ __forceinline__ bf16* w_d(const Args& a, int l) { return (bf16*)(l == 0 ? a.ws + WS_WD : (unsigned char*)a.out + OUT_WD1); }
__device__ __forceinline__ float* x2_of(const Args& a) { return (float*)(a.ws + WS_X2B); }
#if defined(MK_PROBE_KIND) && MK_PROBE_KIND >= 0
#define PV(bit) ((a.pad >> (bit)) & 1)
#else
#define PV(bit) 0
#endif
__device__ __forceinline__ float bf2f(unsigned short h) { return __uint_as_float((unsigned)h << 16); }
typedef float f32x2_t __attribute__((ext_vector_type(2))); typedef __bf16 bf16x2_t __attribute__((ext_vector_type(2)));
__device__ __forceinline__ unsigned pk2(float lo, float hi) { f32x2_t v = {lo, hi}; bf16x2_t b = __builtin_convertvector(v, bf16x2_t); return __builtin_bit_cast(unsigned, b); }
__device__ __forceinline__ int lane_now() { int l; asm volatile("v_mbcnt_lo_u32_b32 %0, -1, 0\n\tv_mbcnt_hi_u32_b32 %0, -1, %0" : "=v"(l)); return l; }
__device__ __forceinline__ int shx_i(int v, int m) { return __builtin_amdgcn_ds_bpermute((lane_now() ^ m) << 2, v); }
__device__ __forceinline__ float shx(float v, int m) { return __int_as_float(shx_i(__float_as_int(v), m)); }
__device__ __forceinline__ float shl(float v, int src_lane) { return __int_as_float(__builtin_amdgcn_ds_bpermute(src_lane << 2, __float_as_int(v))); }
__device__ __forceinline__ float wave_sum(float v) {
#pragma unroll
    for (int o = 1; o < 64; o <<= 1) v += shx(v, o);
    return v;
}
__device__ __forceinline__ int mset_of_row(int m) { return m < SEQ ? 0 : (m < NLAT ? 1 : 2); }
#define LDS_WAIT() asm volatile("s_waitcnt lgkmcnt(0)" ::: "memory")
#define VM_WAIT() asm volatile("s_waitcnt vmcnt(0)" ::: "memory")

__device__ __forceinline__ void pro_phase(const Args& a, LAS unsigned char* lds, int tid, int bid, int G) {
    LAS float* sc = (LAS float*)lds;
    LAS float* part = sc + 3 * 1024;
    float* MOD = (float*)(a.ws + WS_MOD);
    for (int u = bid; u < 96; u += G) {
        const int l = u / 48, cb = (u % 48) * 128;
        for (int i = tid; i < 3 * 1024; i += 512) { const int s = i >> 10, k = i & 1023; const float cv = s < 2 ? a.in[I_C][s * 1024 + k] : a.in[I_CCTX][k]; sc[i] = cv / (1.f + expf(-cv)); }
        __syncthreads();
        const int col = tid & 127, kq = tid >> 7;
        const float* w = a.in[I_WMOD] + (size_t)l * 1024 * 6144 + cb + col;
        float a0 = 0.f, a1 = 0.f, a2 = 0.f;
#pragma unroll 1
        for (int k0 = kq * 256; k0 < kq * 256 + 256; k0 += 32) {
            float wv[32];
#pragma unroll
            for (int i = 0; i < 32; ++i) wv[i] = w[(size_t)(k0 + i) * 6144];
            __builtin_amdgcn_sched_barrier(0);
#pragma unroll
            for (int i = 0; i < 32; ++i) { a0 += sc[k0 + i] * wv[i]; a1 += sc[1024 + k0 + i] * wv[i]; a2 += sc[2048 + k0 + i] * wv[i]; }
        }
        part[(kq * 3 + 0) * 128 + col] = a0; part[(kq * 3 + 1) * 128 + col] = a1; part[(kq * 3 + 2) * 128 + col] = a2;
        __syncthreads();
        if (tid < 384) { const int s = tid >> 7, c = tid & 127;
            const float r = ((part[(0 * 3 + s) * 128 + c] + part[(1 * 3 + s) * 128 + c]) + (part[(2 * 3 + s) * 128 + c] + part[(3 * 3 + s) * 128 + c])) + a.in[I_BMOD][l * 6144 + cb + c];
            MOD[(l * 3 + s) * 6144 + cb + c] = r; }
        __syncthreads();
    }
    if (bid == 0 && tid < 2) {
        const float* lp = a.in[I_DLAM] + tid * 128; float s0 = 0.f, s1 = 0.f;
        for (int i = 0; i < 32; ++i) { s0 += lp[i] * lp[32 + i]; s1 += lp[64 + i] * lp[96 + i]; }
        const float lam_init = 0.8f - 0.6f * expf(-0.3f * (float)tid);
        ((float*)(a.ws + WS_LAM))[2 * tid] = expf(s0) - expf(s1) + lam_init; ((float*)(a.ws + WS_LAM))[2 * tid + 1] = 1.f - lam_init;
    }
}

__device__ __forceinline__ void conv_item(const float* src, size_t sld, bf16* dst, size_t dld, bool zero, LAS float* scr, int lane) {
    const int c = lane & 7;
    if (zero) {
#pragma unroll
        for (int j = 0; j < 4; ++j) { const int n = (lane >> 3) + 8 * j; *(u32x4*)(dst + (size_t)n * dld + 8 * c) = (u32x4){0u, 0u, 0u, 0u}; }
        return;
    }
    f32x4 v[8];
#pragma unroll
    for (int i = 0; i < 8; ++i) { const int kk = 8 * i + (lane >> 3), c4 = 4 * (lane & 7); v[i] = *(const f32x4*)(src + (size_t)kk * sld + c4); }
    __builtin_amdgcn_sched_barrier(0);
#pragma unroll
    for (int i = 0; i < 8; ++i) { const int kk = 8 * i + (lane >> 3), c4 = 4 * (lane & 7); LAS float* d = scr + kk * 33 + c4; d[0] = v[i].x; d[1] = v[i].y; d[2] = v[i].z; d[3] = v[i].w; }
    LDS_WAIT(); asm volatile("" ::: "memory");
#pragma unroll
    for (int j = 0; j < 4; ++j) { const int n = (lane >> 3) + 8 * j; const LAS float* s = scr + (8 * c) * 33 + n;
        u32x4 o; o.x = pk2(s[0 * 33], s[1 * 33]); o.y = pk2(s[2 * 33], s[3 * 33]); o.z = pk2(s[4 * 33], s[5 * 33]); o.w = pk2(s[6 * 33], s[7 * 33]);
        *(u32x4*)(dst + (size_t)n * dld + 8 * c) = o; }
    LDS_WAIT(); asm volatile("" ::: "memory");
}
constexpr int CV_WIN = 1280, CV_WOUT = 512, CV_W2 = 1024, CV_GU = 16 * 2816, CV_D = 16 * 1408, CV_ALL = CV_WIN + CV_WOUT + CV_W2 + CV_GU + CV_D;
__device__ __forceinline__ void conv_items(const Args& a, int l, int lo, int hi, LAS unsigned char* lds, int lane, int wave, int gw, int NGW) {
    LAS float* scr = (LAS float*)(lds + wave * 8704);
    bf16* WIN = w_in(a, l); bf16* W2 = w_2(a, l); bf16* WOUT = w_out(a, l); bf16* WGU = w_gu(a, l); bf16* WD = w_d(a, l);
    for (int it0 = lo + gw; it0 < hi; it0 += NGW) {
        int it = it0;
        if (it < CV_WIN) { const int kb = it / 80, nb = it % 80, n0 = 32 * nb, k0 = 64 * kb; const bool zero = n0 >= 2464;
            const int sc = n0 < 1152 ? n0 : (n0 < 2432 ? n0 + 32 : n0 - 2432 + 1152);
            conv_item(a.in[I_WIN] + (size_t)l * 1024 * 2464 + (size_t)k0 * 2464 + (zero ? 0 : sc), 2464, WIN + ((size_t)(n0 >> 5) * 16 + kb) * 2048, 64, zero, scr, lane); continue; }
        it -= CV_WIN;
        if (it < CV_WOUT) { const int kb = it / 32, nb = it % 32, n0 = 32 * nb, k0 = 64 * kb;
            conv_item(a.in[I_WOUT] + (size_t)l * 1024 * 1024 + (size_t)k0 * 1024 + n0, 1024, WOUT + ((size_t)(n0 >> 5) * 16 + kb) * 2048, 64, false, scr, lane); continue; }
        it -= CV_WOUT;
        if (it < CV_W2) { const int n = it;
#pragma unroll
            for (int i = 0; i < 6; ++i) { const int k = lane + 64 * i; float v = 0.f;
                if (n < 512) { const int h = n >> 7, j = n & 127; if (j < 96 && k < 256) v = a.in[I_WUQ][(size_t)l * 256 * 384 + (size_t)k * 384 + 96 * h + j]; }
                else { if (k >= 256) v = a.in[I_WUKV][(size_t)l * 128 * 512 + (size_t)(k - 256) * 512 + (n - 512)]; }
                W2[((((size_t)(n >> 5) * 24 + (k >> 4)) * 64) + ((k >> 3) & 1) * 32 + (n & 31)) * 8 + (k & 7)] = (bf16)(pk2(v, 0.f) & 0xffffu); }
            continue; }
        it -= CV_W2;
        if (it < CV_GU) { const int e = it / 2816, r = it % 2816, kb = r / 176, nb = r % 176, n0 = 32 * nb, k0 = 64 * kb, pn = n0 >> 8, half = (n0 >> 7) & 1, j0 = n0 & 127;
            const float* src = (half ? a.in[I_WUP] : a.in[I_WGATE]) + ((size_t)(l * 16 + e) * 1024 + k0) * 2816 + 128 * pn + j0;
            const size_t gap = (l == 1 && e >= GU_SPLIT_E) ? (size_t)GU_GAP_TILES * 256 * 1024 : 0;
            conv_item(src, 2816, WGU + ((size_t)((e * 5632 + n0) >> 5) * 16 + kb) * 2048 + gap, 64, false, scr, lane); continue; }
        it -= CV_GU;
        { const int e = it / 1408, r = it % 1408, kb = r / 32, nb = r % 32, n0 = 32 * nb, k0 = 64 * kb;
            conv_item(a.in[I_WDOWN] + ((size_t)(l * 16 + e) * 2816 + k0) * 1024 + n0, 1024, WD + ((size_t)((e * 1024 + n0) >> 5) * 44 + kb) * 2048, 64, false, scr, lane); }
    }
}

__device__ __forceinline__ int xe_rowbase(int set4, int e) { return set4 < 2 ? (set4 * 16 + e) * 2048 : XE_LAT + e * 256 + (set4 - 2) * 32; }
__device__ __forceinline__ void combine_row(const Args& a, int l, int m, int lane, f32x4 (&v)[4], const f32x4 (&g2)[4], const f32x4 (&xr)[4], int myslot) {
    const bf16* Y = (const bf16*)(a.ws + WS_Y);
    const int set4 = m < SEQ ? 0 : (m < NLAT ? 1 : (m < NLAT + CTXL ? 2 : 3));
    f32x4 s[4];
#pragma unroll
    for (int j = 0; j < 4; ++j) s[j] = (f32x4){0.f, 0.f, 0.f, 0.f};
#define ACC_Y(w_) do { _Pragma("unroll") for (int j = 0; j < 4; ++j) { s[j].x += __uint_as_float(w_[j].x << 16); s[j].y += __uint_as_float(w_[j].x & 0xffff0000u); s[j].z += __uint_as_float(w_[j].y << 16); s[j].w += __uint_as_float(w_[j].y & 0xffff0000u); } } while (0)
    unsigned mask = (unsigned)__ballot(myslot >= 0);
    while (mask) {
        const int ea = __builtin_ctz(mask); mask &= mask - 1u;
        const bf16* ya = Y + (size_t)(xe_rowbase(set4, ea) + __builtin_amdgcn_readlane(myslot, ea)) * D + 4 * lane;
        u32x2 wa[4];
#pragma unroll
        for (int j = 0; j < 4; ++j) wa[j] = *(const u32x2*)(ya + 256 * j);
        if (mask) {
            const int eb = __builtin_ctz(mask); mask &= mask - 1u;
            const bf16* yb = Y + (size_t)(xe_rowbase(set4, eb) + __builtin_amdgcn_readlane(myslot, eb)) * D + 4 * lane;
            u32x2 wb[4];
#pragma unroll
            for (int j = 0; j < 4; ++j) wb[j] = *(const u32x2*)(yb + 256 * j);
            ACC_Y(wa); ACC_Y(wb);
        } else { ACC_Y(wa); }
    }
#undef ACC_Y
#pragma unroll
    for (int j = 0; j < 4; ++j) v[j] = xr[j] + g2[j] * s[j];
}
__device__ __forceinline__ void combine_req(const Args& a, int m, int lane, f32x4 (&xr)[4], int& myslot) {
    const float* X1 = (const float*)(a.ws + WS_X1); const int* SEL = (const int*)(a.ws + WS_SEL);
#pragma unroll
    for (int j = 0; j < 4; ++j) xr[j] = *(const f32x4*)(X1 + (size_t)m * D + 4 * lane + 256 * j);
    myslot = (lane < 16) ? SEL[(size_t)m * 16 + lane] : -1;
}
__device__ __forceinline__ void ld_gate2(const Args& a, int l, int set, int lane, f32x4 (&g2)[4]) {
    const float* MOD = (const float*)(a.ws + WS_MOD) + (size_t)(l * 3 + set) * 6144;
#pragma unroll
    for (int j = 0; j < 4; ++j) g2[j] = *(const f32x4*)(MOD + 5 * 1024 + 4 * lane + 256 * j);
}
__device__ __forceinline__ void modul_phase(const Args& a, int l, int lane, int wave, int vcu, int G) {
    const int gw = vcu * 8 + wave, NGW = G * 8;
    bf16* H = (bf16*)(a.ws + WS_H); float* X2 = x2_of(a);
    const float* gat = a.in[I_GATTN] + l * D;
    int cset = -1; f32x4 gg[4], sh[4], g2[4];
#pragma unroll
    for (int j = 0; j < 4; ++j) { gg[j] = (f32x4){0.f, 0.f, 0.f, 0.f}; sh[j] = gg[j]; g2[j] = gg[j]; }
    f32x4 vn[4];
#define MD_SRC(m_) ((m_) < NLAT ? a.in[I_X] + (size_t)(m_) * D : a.in[I_CTX] + (size_t)((m_) - NLAT) * D)
    int slotn = -1;
    if (l == 0 && gw < NROW) { const float* src = MD_SRC(gw);
#pragma unroll
        for (int j = 0; j < 4; ++j) vn[j] = *(const f32x4*)(src + 4 * lane + 256 * j); }
    if (l == 1 && gw < NROW) combine_req(a, gw, lane, vn, slotn);
    for (int m = gw; m < NROW; m += NGW) {
        const int set = mset_of_row(m);
        if (set != cset) { cset = set; const float* MOD = (const float*)(a.ws + WS_MOD) + (size_t)(l * 3 + set) * 6144;
#pragma unroll
            for (int j = 0; j < 4; ++j) { const int c = 4 * lane + 256 * j; const f32x4 g = *(const f32x4*)(gat + c), scl = *(const f32x4*)(MOD + 1024 + c); sh[j] = *(const f32x4*)(MOD + c); gg[j] = g * (scl + 1.f); }
            if (l == 1) ld_gate2(a, 0, set, lane, g2); }
        f32x4 v[4];
        if (l == 0) {
#pragma unroll
            for (int j = 0; j < 4; ++j) v[j] = vn[j];
            if (m + NGW < NROW) { const float* src = MD_SRC(m + NGW);
#pragma unroll
                for (int j = 0; j < 4; ++j) vn[j] = *(const f32x4*)(src + 4 * lane + 256 * j); }
            __builtin_amdgcn_sched_barrier(0); }
        else { f32x4 xr[4]; const int slot = slotn;
#pragma unroll
            for (int j = 0; j < 4; ++j) xr[j] = vn[j];
            if (m + NGW < NROW) combine_req(a, m + NGW, lane, vn, slotn);
            __builtin_amdgcn_sched_barrier(0);
            combine_row(a, 0, m, lane, v, g2, xr, slot);
#pragma unroll
            for (int j = 0; j < 4; ++j) *(f32x4*)(X2 + (size_t)m * D + 4 * lane + 256 * j) = v[j]; }
        float ss = 0.f;
#pragma unroll
        for (int j = 0; j < 4; ++j) ss += (v[j].x * v[j].x + v[j].y * v[j].y) + (v[j].z * v[j].z + v[j].w * v[j].w);
        const float rstd = rsqrtf(wave_sum(ss) * (1.f / D) + EPS);
#pragma unroll
        for (int j = 0; j < 4; ++j) { const int c = 4 * lane + 256 * j; const f32x4 h = v[j] * rstd * gg[j] + sh[j];
            u32x2 o; o.x = pk2(h.x, h.y); o.y = pk2(h.z, h.w); *(u32x2*)(H + (size_t)m * D + c) = o; }
    }
#undef MD_SRC
}
__device__ __forceinline__ void final_phase(const Args& a, int lane, int wave, int vcu, int G) {
    const int gw = vcu * 8 + wave, NGW = G * 8;
    int cset = -1; f32x4 g2[4];
#pragma unroll
    for (int j = 0; j < 4; ++j) g2[j] = (f32x4){0.f, 0.f, 0.f, 0.f};
    f32x4 vn[4]; int slotn = -1;
#pragma unroll
    for (int j = 0; j < 4; ++j) vn[j] = (f32x4){0.f, 0.f, 0.f, 0.f};
    if (gw < NLAT) combine_req(a, gw, lane, vn, slotn);
    for (int m = gw; m < NLAT; m += NGW) {
        const int set = mset_of_row(m);
        if (set != cset) { cset = set; ld_gate2(a, 1, set, lane, g2); }
        f32x4 xr[4]; const int slot = slotn;
#pragma unroll
        for (int j = 0; j < 4; ++j) xr[j] = vn[j];
        if (m + NGW < NLAT) combine_req(a, m + NGW, lane, vn, slotn);
        __builtin_amdgcn_sched_barrier(0);
        f32x4 v[4]; combine_row(a, 1, m, lane, v, g2, xr, slot);
#pragma unroll
        for (int j = 0; j < 4; ++j) *(f32x4*)(a.out + (size_t)m * D + 4 * lane + 256 * j) = v[j];
    }
}
#define XB_TMO      128
#define XB_XCNT(j)  (256  + 64 * (j))
#define XB_XSUB(j)  (1280 + 64 * (j))
#define XB_XGEN(j)  (2304 + 64 * (j))
#define XB_TOP      3328
#define XB_TOPGEN   3392
#define XCD_BAR_WORDS 3456
#define XB_SPIN_CAP (1u << 18)

__device__ __forceinline__ unsigned xb_ld(unsigned* p)              { return __hip_atomic_load(p, __ATOMIC_RELAXED, __HIP_MEMORY_SCOPE_AGENT); }
__device__ __forceinline__ unsigned xb_add(unsigned* p, unsigned v) { return __hip_atomic_fetch_add(p, v, __ATOMIC_RELAXED, __HIP_MEMORY_SCOPE_AGENT); }
__device__ __forceinline__ unsigned xb_xcc_id() { return (unsigned)__builtin_amdgcn_s_getreg((3 << 11) | 20) & 0xFu; }
#define XB_SPIN(cond, bar) do { unsigned _sp = 0; while (cond) { __builtin_amdgcn_s_sleep(1); \
    if ((++_sp & 255u) == 0u) { if (xb_ld(&(bar)[XB_TMO])) break; if (_sp > XB_SPIN_CAP) { atomicAdd(&(bar)[XB_TMO], 1u); break; } } } } while (0)

struct XcdBarrier {
    unsigned* bar; unsigned x;
    volatile LAS unsigned* st;
};

__device__ __forceinline__ XcdBarrier xcd_barrier_post(unsigned* bar, volatile LAS unsigned* st, bool t0  ) {
    XcdBarrier b; b.bar = bar; b.x = xb_xcc_id(); b.st = st;
    if (t0) (void)xb_add(&bar[XB_XCNT(b.x)], 1u);
    return b;
}
__device__ __forceinline__ void xcd_barrier_complete(unsigned* bar, unsigned x, unsigned& nloc, unsigned& nx) {
    const unsigned G = gridDim.x * gridDim.y * gridDim.z;
    unsigned sum, cnt, mine, sp = 0u;
    for (;;) {
        sum = 0u; cnt = 0u; mine = 0u;
#pragma unroll
        for (unsigned j = 0; j < 16; ++j) { const unsigned c = xb_ld(&bar[XB_XCNT(j)]); sum += c; cnt += (c > 0u) ? 1u : 0u; mine = (j == x) ? c : mine; }
        if (sum == G) break;
        __builtin_amdgcn_s_sleep(1);
        if ((++sp & 255u) == 0u) { if (xb_ld(&bar[XB_TMO])) break; if (sp > XB_SPIN_CAP) { atomicAdd(&bar[XB_TMO], 1u); break; } }
    }
    nloc = mine > 0u ? mine : 1u; nx = cnt > 0u ? cnt : 1u;
}

__device__ __forceinline__ void xcd_barrier(const XcdBarrier& b, bool t0  ) {
    asm volatile("s_waitcnt vmcnt(0)" ::: "memory");
    __syncthreads();
    if (t0) {
        unsigned* bar = b.bar;
        __builtin_amdgcn_s_waitcnt(0);
        unsigned nloc = b.st[0], nx = b.st[1];
        if (nloc == 0u) { xcd_barrier_complete(bar, b.x, nloc, nx); b.st[0] = nloc; b.st[1] = nx; }
        const unsigned old = xb_add(&bar[XB_XSUB(b.x)], 1u);
        const unsigned gen = old / nloc;
        if (old + 1u == (gen + 1u) * nloc) {
            __builtin_amdgcn_fence(__ATOMIC_RELEASE, "agent");
            asm volatile("s_waitcnt vmcnt(0)" ::: "memory");
            const unsigned og = xb_add(&bar[XB_TOP], 1u);
            const unsigned tg = og / nx;
            if (og + 1u == (tg + 1u) * nx) xb_add(&bar[XB_TOPGEN], 1u);
            else XB_SPIN(xb_ld(&bar[XB_TOPGEN]) == tg, bar);
            __builtin_amdgcn_fence(__ATOMIC_ACQUIRE, "agent");
            xb_add(&bar[XB_XGEN(b.x)], 1u);
            asm volatile("s_waitcnt vmcnt(0)" ::: "memory");
        } else {
            XB_SPIN(xb_ld(&bar[XB_XGEN(b.x)]) == gen, bar);
            __builtin_amdgcn_fence(__ATOMIC_ACQUIRE, "agent");
            asm volatile("s_waitcnt vmcnt(0)" ::: "memory");
        }
    }
    __syncthreads();
}

struct TokTile { int m0; int b; int ktile; int prow; bool lat; };
__device__ __forceinline__ TokTile tok_tile(int T) {
    TokTile t; t.m0 = 64 * T;
    if (T < 512) { t.b = T >> 8; t.prow = T & 255; t.ktile = 4 + t.prow; t.lat = true; }
    else { const int c = T - 512; t.b = c >> 2; t.ktile = c & 3; t.prow = 0; t.lat = false; }
    return t;
}
template <int N> __device__ __forceinline__ void ld_row(const bf16* p, float (&v)[N]) {
#pragma unroll
    for (int i = 0; i < N / 8; ++i) { const u32x4 w = *(const u32x4*)(p + 8 * i);
        v[8 * i + 0] = __uint_as_float(w.x << 16); v[8 * i + 1] = __uint_as_float(w.x & 0xffff0000u); v[8 * i + 2] = __uint_as_float(w.y << 16); v[8 * i + 3] = __uint_as_float(w.y & 0xffff0000u);
        v[8 * i + 4] = __uint_as_float(w.z << 16); v[8 * i + 5] = __uint_as_float(w.z & 0xffff0000u); v[8 * i + 6] = __uint_as_float(w.w << 16); v[8 * i + 7] = __uint_as_float(w.w & 0xffff0000u); }
}
template <int N> __device__ __forceinline__ void up_row(const u32x4 (&raw)[8], float (&v)[N]) {
#pragma unroll
    for (int i = 0; i < N / 8; ++i) { const u32x4 w = raw[i];
        v[8 * i + 0] = __uint_as_float(w.x << 16); v[8 * i + 1] = __uint_as_float(w.x & 0xffff0000u); v[8 * i + 2] = __uint_as_float(w.y << 16); v[8 * i + 3] = __uint_as_float(w.y & 0xffff0000u);
        v[8 * i + 4] = __uint_as_float(w.z << 16); v[8 * i + 5] = __uint_as_float(w.z & 0xffff0000u); v[8 * i + 6] = __uint_as_float(w.w << 16); v[8 * i + 7] = __uint_as_float(w.w & 0xffff0000u); }
}
template <int N> __device__ __forceinline__ void rms_gain(float (&v)[N], const float* g) {
    float ss = 0.f;
#pragma unroll
    for (int i = 0; i < N; ++i) ss += v[i] * v[i];
    const float r = rsqrtf(ss * (1.f / N) + EPS);
#pragma unroll
    for (int i = 0; i < N; ++i) v[i] = v[i] * r * g[i];
}
constexpr float ROPE_INVR[16] = {1.591549431e-01f, 8.949940161e-02f, 5.032921210e-02f, 2.830219583e-02f, 1.591549431e-02f, 8.949940161e-03f, 5.032921210e-03f, 2.830219583e-03f,
                                 1.591549431e-03f, 8.949940161e-04f, 5.032921210e-04f, 2.830219583e-04f, 1.591549431e-04f, 8.949940161e-05f, 5.032921210e-05f, 2.830219583e-05f};
template <int OFF, int NR, int N> __device__ __forceinline__ void rope2d(float (&v)[N], float tr, float tc) {
    constexpr int Q = NR / 4, FS = 64 / NR;
#pragma unroll
    for (int d = 0; d < Q; ++d) {
        { const float t = __builtin_amdgcn_fractf(tr * ROPE_INVR[FS * d]); const float c = __builtin_amdgcn_cosf(t), s = __builtin_amdgcn_sinf(t); const float x1 = v[OFF + d], x2 = v[OFF + Q + d]; v[OFF + d] = x1 * c - x2 * s; v[OFF + Q + d] = x1 * s + x2 * c; }
        { const float t = __builtin_amdgcn_fractf(tc * ROPE_INVR[FS * d]); const float c = __builtin_amdgcn_cosf(t), s = __builtin_amdgcn_sinf(t); const float x1 = v[OFF + 2 * Q + d], x2 = v[OFF + 3 * Q + d]; v[OFF + 2 * Q + d] = x1 * c - x2 * s; v[OFF + 3 * Q + d] = x1 * s + x2 * c; }
    }
}
template <int N> __device__ __forceinline__ void st_row(bf16* p, const float (&v)[N], float sc) {
#pragma unroll
    for (int i = 0; i < N / 8; ++i) { u32x4 w; w.x = pk2(v[8 * i] * sc, v[8 * i + 1] * sc); w.y = pk2(v[8 * i + 2] * sc, v[8 * i + 3] * sc); w.z = pk2(v[8 * i + 4] * sc, v[8 * i + 5] * sc); w.w = pk2(v[8 * i + 6] * sc, v[8 * i + 7] * sc);
        *(u32x4*)(p + 8 * i) = w; }
}
template <int N> __device__ __forceinline__ void st_ktile(bf16* tile, int chunk0, const float (&v)[N], int lane) {
#pragma unroll
    for (int i = 0; i < N / 8; ++i) { u32x4 w; w.x = pk2(v[8 * i], v[8 * i + 1]); w.y = pk2(v[8 * i + 2], v[8 * i + 3]); w.z = pk2(v[8 * i + 4], v[8 * i + 5]); w.w = pk2(v[8 * i + 6], v[8 * i + 7]);
        *(u32x4*)(tile + (size_t)(chunk0 + i) * 512 + lane * 8) = w; }
}
__device__ __forceinline__ void st_vtile(bf16* tile, const float (&v)[64], LAS bf16* scr, int lane) {
#pragma unroll
    for (int dv = 0; dv < 64; dv += 2) { const unsigned w = pk2(v[dv], v[dv + 1]); scr[dv * 72 + lane] = (bf16)(w & 0xffffu); scr[(dv + 1) * 72 + lane] = (bf16)(w >> 16); }
    LDS_WAIT(); asm volatile("" ::: "memory");
#pragma unroll
    for (int kc = 0; kc < 8; ++kc) { const u32x4 w = *(const LAS u32x4*)(scr + lane * 72 + kc * 8); *(u32x4*)(tile + (size_t)kc * 512 + lane * 8) = w; }
    LDS_WAIT(); asm volatile("" ::: "memory");
}
template <int N> __device__ __forceinline__ void ld_row_oct(const bf16* p, float (&v)[N]) {
#pragma unroll
    for (int i = 0; i < N / 8; ++i) { const u32x4 w = *(const u32x4*)(p + 512 * i);
        v[8 * i + 0] = __uint_as_float(w.x << 16); v[8 * i + 1] = __uint_as_float(w.x & 0xffff0000u); v[8 * i + 2] = __uint_as_float(w.y << 16); v[8 * i + 3] = __uint_as_float(w.y & 0xffff0000u);
        v[8 * i + 4] = __uint_as_float(w.z << 16); v[8 * i + 5] = __uint_as_float(w.z & 0xffff0000u); v[8 * i + 6] = __uint_as_float(w.w << 16); v[8 * i + 7] = __uint_as_float(w.w & 0xffff0000u); }
}
template <int NCH> __device__ __forceinline__ void norm_wide(const bf16* src, const float* g, bf16* a2f, int m, int k0) {
    float ss = 0.f;
#pragma unroll
    for (int c = 0; c < NCH; ++c) { asm volatile("" ::: "memory"); float v[64]; ld_row_oct<64>(src + 4096 * c, v);
#pragma unroll
        for (int i = 0; i < 64; ++i) ss += v[i] * v[i]; }
    const float r = rsqrtf(ss * (1.f / (64 * NCH)) + EPS);
    asm volatile("" ::: "memory");
#pragma unroll
    for (int c = 0; c < NCH; ++c) { asm volatile("" ::: "memory"); float v[64]; ld_row_oct<64>(src + 4096 * c, v);
#pragma unroll
        for (int i = 0; i < 64; ++i) v[i] = v[i] * r * g[64 * c + i];
#pragma unroll
        for (int i = 0; i < 8; ++i) { const int k = k0 + 64 * c + 8 * i; u32x4 w; w.x = pk2(v[8 * i], v[8 * i + 1]); w.y = pk2(v[8 * i + 2], v[8 * i + 3]); w.z = pk2(v[8 * i + 4], v[8 * i + 5]); w.w = pk2(v[8 * i + 6], v[8 * i + 7]);
            *(u32x4*)(a2f + ((((size_t)(m >> 5) * 24 + (k >> 4)) * 64) + ((k >> 3) & 1) * 32 + (m & 31)) * 8) = w; } }
}
constexpr int NJ1 = 43, NJ2 = 12, NTT = NROW / 64;
constexpr float C2_64 = 0.125f * LOG2E, C2_32 = 0.17677669529663687f * LOG2E, C2_96 = 0.10206207261596575f * LOG2E;
__device__ __forceinline__ bf16* ktile_ptr(unsigned char* ws, size_t off, int nheads, int dk, int b, int h, int kt) { return (bf16*)(ws + off) + ((size_t)(b * nheads + h) * NTILE + kt) * (size_t)(64 * dk); }

__device__ __forceinline__ int job1_col(int j) {
    if (j < 4) return 64 * j; if (j < 8) return 256 + 64 * (j - 4); if (j < 12) return 512 + 64 * (j - 8); if (j == 12) return 768; if (j == 13) return 1024; if (j == 14) return 2432;
    if (j < 23) return 1152 + 32 * (j - 15); if (j < 31) return 1408 + 32 * (j - 23); if (j < 35) return 1664 + 64 * (j - 31); if (j < 39) return 1920 + 64 * (j - 35); if (j < 41) return 2176 + 64 * (j - 39);
    return 2304 + 64 * (j - 41);
}
__device__ __forceinline__ void prep1_phase(const Args& a, int l, LAS unsigned char* lds, int lane_in, int wave, int vcu, int G) {
    LAS bf16* scr = (LAS bf16*)(lds + wave * 9216);
    const int gw = vcu * 8 + wave, NGW = G * 8;
    const bf16* P = (const bf16*)(a.ws + WS_P);
    u32x4 raw[8];
#define P1_LOAD(it_, lane_) do { const int T_ = (it_) / NJ1, j_ = (it_) % NJ1; const bf16* p_ = P + (((size_t)T_ * (NP / 8) + (job1_col(j_) >> 3)) * 64 + (lane_)) * 8; _Pragma("unroll") for (int i_ = 0; i_ < 8; ++i_) raw[i_] = *(const u32x4*)(p_ + 512 * i_); } while (0)
#define P1_NEXT() do { if (it + NGW < NTT * NJ1) P1_LOAD(it + NGW, lane); __builtin_amdgcn_sched_barrier(0); } while (0)
    if (gw < NTT * NJ1) P1_LOAD(gw, lane_in);
    for (int it = gw; it < NTT * NJ1; it += NGW) {
        int lane = lane_in; asm volatile("" : "+v"(lane));
        const int T = it / NJ1, j = it % NJ1; const TokTile tt = tok_tile(T); const int m = tt.m0 + lane;
        const float tr = (float)tt.prow, tc = (float)lane;
        if (j < 4) { float v[64]; up_row<64>(raw, v); P1_NEXT(); rms_gain<64>(v, a.in[I_GNAQ] + l * 64); st_row<64>((bf16*)(a.ws + WS_QNA) + (size_t)m * 256 + 64 * j, v, C2_64); }
        else if (j < 8) { const int h = j - 4; float v[64]; up_row<64>(raw, v); P1_NEXT(); rms_gain<64>(v, a.in[I_GNAK] + l * 64); st_ktile<64>(ktile_ptr(a.ws, WS_KNA, 4, 64, tt.b, h, tt.ktile), 0, v, lane); }
        else if (j < 12) { const int h = j - 8; float v[64]; up_row<64>(raw, v); P1_NEXT(); st_vtile(ktile_ptr(a.ws, WS_VNA, 4, 64, tt.b, h, tt.ktile), v, scr, lane); }
        else if (j == 12) { P1_NEXT(); norm_wide<4>(P + (((size_t)T * (NP / 8) + 96) * 64 + lane) * 8, a.in[I_GCQ] + l * 256, (bf16*)(a.ws + WS_A2), m, 0); }
        else if (j == 13) { P1_NEXT(); norm_wide<2>(P + (((size_t)T * (NP / 8) + 128) * 64 + lane) * 8, a.in[I_GCKV] + l * 128, (bf16*)(a.ws + WS_A2), m, 256); }
        else if (j == 14) { float v[32]; up_row<32>(raw, v); P1_NEXT(); rms_gain<32>(v, a.in[I_GKR] + l * 32); if (tt.lat) rope2d<0, 32, 32>(v, tr, tc);
#pragma unroll
            for (int h = 0; h < 4; ++h) st_ktile<32>(ktile_ptr(a.ws, WS_KMLA, 4, 96, tt.b, h, tt.ktile), 8, v, lane); }
        else if (j < 23) { const int h = (j - 15) >> 1, c = (j - 15) & 1; float v[32]; up_row<32>(raw, v); P1_NEXT(); rms_gain<32>(v, a.in[I_GDQ] + l * 64 + 32 * c); if (tt.lat) rope2d<0, 32, 32>(v, tr, tc);
            st_row<32>((bf16*)(a.ws + WS_QDIFF) + (size_t)m * 256 + 64 * h + 32 * c, v, C2_32); }
        else if (j < 31) { const int h = (j - 23) >> 1, c = (j - 23) & 1; float v[32]; up_row<32>(raw, v); P1_NEXT(); rms_gain<32>(v, a.in[I_GDK] + l * 64 + 32 * c); if (tt.lat) rope2d<0, 32, 32>(v, tr, tc);
            st_ktile<32>(ktile_ptr(a.ws, WS_KDIFF, 4, 64, tt.b, h, tt.ktile), 4 * c, v, lane); }
        else if (j < 35) { const int h = j - 31; float v[64]; up_row<64>(raw, v); P1_NEXT(); st_vtile(ktile_ptr(a.ws, WS_VDIFF, 4, 64, tt.b, h, tt.ktile), v, scr, lane); }
        else if (j < 39) { const int h = j - 35; float v[64]; up_row<64>(raw, v); P1_NEXT(); rms_gain<64>(v, a.in[I_GGQ] + l * 64); if (tt.lat) rope2d<0, 64, 64>(v, tr, tc);
            st_row<64>((bf16*)(a.ws + WS_QGQA) + (size_t)m * 256 + 64 * h, v, C2_64); }
        else if (j < 41) { const int h = j - 39; float v[64]; up_row<64>(raw, v); P1_NEXT(); rms_gain<64>(v, a.in[I_GGK] + l * 64); if (tt.lat) rope2d<0, 64, 64>(v, tr, tc);
            st_ktile<64>(ktile_ptr(a.ws, WS_KGQA, 2, 64, tt.b, h, tt.ktile), 0, v, lane); }
        else { const int h = j - 41; float v[64]; up_row<64>(raw, v); P1_NEXT(); st_vtile(ktile_ptr(a.ws, WS_VGQA, 2, 64, tt.b, h, tt.ktile), v, scr, lane); }
    }
#undef P1_LOAD
#undef P1_NEXT
}
__device__ __forceinline__ void prep2_phase(const Args& a, int l, LAS unsigned char* lds, int lane_in, int wave, int vcu, int G) {
    LAS bf16* scr = (LAS bf16*)(lds + wave * 9216);
    const int gw = vcu * 8 + wave, NGW = G * 8;
    const bf16* U = (const bf16*)(a.ws + WS_U);
    u32x4 raw[8];
#define P2_LOAD(it_, lane_) do { const int T_ = (it_) / NJ2, j_ = (it_) % NJ2; const bf16* p_ = U + (size_t)(64 * T_ + (lane_)) * D + (j_ < 4 ? 128 * j_ : (j_ < 8 ? 512 + 128 * (j_ - 4) : 512 + 128 * (j_ - 8) + 64)); \
        _Pragma("unroll") for (int i_ = 0; i_ < 8; ++i_) raw[i_] = *(const u32x4*)(p_ + 8 * i_); } while (0)
#define P2_NEXT() do { if (it + NGW < NTT * NJ2) P2_LOAD(it + NGW, lane); __builtin_amdgcn_sched_barrier(0); } while (0)
    if (gw < NTT * NJ2) P2_LOAD(gw, lane_in);
    for (int it = gw; it < NTT * NJ2; it += NGW) {
        int lane = lane_in; asm volatile("" : "+v"(lane));
        const int T = it / NJ2, j = it % NJ2; const TokTile tt = tok_tile(T); const int m = tt.m0 + lane;
        const bf16* urow = U + (size_t)m * D; const float tr = (float)tt.prow, tc = (float)lane;
        if (j < 4) { const bf16* src = urow + 128 * j; const float* g = a.in[I_GMQ] + l * 96; bf16* dst = (bf16*)(a.ws + WS_QMLA) + (size_t)m * 384 + 96 * j; float ss = 0.f;
            P2_NEXT();
#pragma unroll
            for (int c = 0; c < 3; ++c) { asm volatile("" ::: "memory"); float v[32]; ld_row<32>(src + 32 * c, v);
#pragma unroll
                for (int i = 0; i < 32; ++i) ss += v[i] * v[i]; }
            const float r = rsqrtf(ss * (1.f / 96.f) + EPS);
#pragma unroll
            for (int c = 0; c < 3; ++c) { asm volatile("" ::: "memory"); float v[32]; ld_row<32>(src + 32 * c, v);
#pragma unroll
                for (int i = 0; i < 32; ++i) v[i] = v[i] * r * g[32 * c + i];
                if (c == 2 && tt.lat) rope2d<0, 32, 32>(v, tr, tc);
                st_row<32>(dst + 32 * c, v, C2_96); } }
        else if (j < 8) { const int h = j - 4; float v[64]; up_row<64>(raw, v); P2_NEXT(); rms_gain<64>(v, a.in[I_GKN] + l * 64); st_ktile<64>(ktile_ptr(a.ws, WS_KMLA, 4, 96, tt.b, h, tt.ktile), 0, v, lane); }
        else { const int h = j - 8; float v[64]; up_row<64>(raw, v); P2_NEXT(); st_vtile(ktile_ptr(a.ws, WS_VMLA, 4, 64, tt.b, h, tt.ktile), v, scr, lane); }
    }
#undef P2_LOAD
#undef P2_NEXT
}

__device__ __forceinline__ int pi32(int r) { return (r & 0x13) | ((r & 4) << 1) | ((r & 8) >> 1); }
__device__ __forceinline__ bf16x8 pack8(const f32x16& p, int base) {
    u32x4 w; w.x = pk2(p[base], p[base + 1]); w.y = pk2(p[base + 2], p[base + 3]); w.z = pk2(p[base + 4], p[base + 5]); w.w = pk2(p[base + 6], p[base + 7]);
    return __builtin_bit_cast(bf16x8, w);
}
#define MFMA32(A, B, C) __builtin_amdgcn_mfma_f32_32x32x16_bf16((A), (B), (C), 0, 0, 0)
__device__ __forceinline__ void store_ot(bf16* orow, const f32x16& o0, const f32x16& o1, int hi) {
#pragma unroll
    for (int g = 0; g < 4; ++g) {
        u32x2 w0, w1; w0.x = pk2(o0[4 * g], o0[4 * g + 1]); w0.y = pk2(o0[4 * g + 2], o0[4 * g + 3]); w1.x = pk2(o1[4 * g], o1[4 * g + 1]); w1.y = pk2(o1[4 * g + 2], o1[4 * g + 3]);
        *(u32x2*)(orow + 8 * g + 4 * hi) = w0; *(u32x2*)(orow + 32 + 8 * g + 4 * hi) = w1;
    }
}
#define SBAR() __builtin_amdgcn_sched_barrier(0)
#define EX2(x) __builtin_amdgcn_exp2f(x)
#define ZERO16 ((f32x16){})
__device__ __forceinline__ float fadd_s(float a, float b) { float r; asm("v_add_f32_e32 %0, %1, %2" : "=v"(r) : "v"(a), "v"(b)); return r; }
#define FADD(a, b) fadd_s((a), (b))
#if defined(MK_XPROBE) && MK_XPROBE == 2
#define XPROBE(x) do { float d0_, d1_; asm volatile("v_exp_f32 %0, %2\n\tv_exp_f32 %1, %2" : "=&v"(d0_), "=&v"(d1_) : "v"(x)); } while (0)
#else
#define XPROBE(x) do { } while (0)
#endif
#define ATT_GQA_PRE(KCUR1) do { \
        kf0 = *(const LAS bf16x8*)(KCUR1 + 0); \
        kf1 = *(const LAS bf16x8*)(KCUR1 + 2048); \
    } while (0)
#define ATT_GQA_ITER(KCUR1, KNEXT0, KNEXT1, VPREV1, VCUR0) do { \
        kf2 = *(const LAS bf16x8*)(KCUR1 + 4096); \
        SB_a = MFMA32(kf0, qa[0], ZERO16); \
        SA_a[0] = EX2(SA_a[0]); SA_a[1] = EX2(SA_a[1]); \
        SBAR(); \
        SB_b = MFMA32(kf0, qb[0], ZERO16); \
        la += SA_a[0]; la += SA_a[1]; PA_a_lo[0] = pk2(SA_a[0], SA_a[1]); XPROBE(SA_a[0]); \
        SA_a[2] = EX2(SA_a[2]); SA_a[3] = EX2(SA_a[3]); \
        SBAR(); \
        kf3 = *(const LAS bf16x8*)(KCUR1 + 6144); \
        SB_a = MFMA32(kf1, qa[1], SB_a); \
        la += SA_a[2]; la += SA_a[3]; PA_a_lo[1] = pk2(SA_a[2], SA_a[3]); XPROBE(SA_a[2]); \
        SA_a[4] = EX2(SA_a[4]); SA_a[5] = EX2(SA_a[5]); \
        SBAR(); \
        SB_b = MFMA32(kf1, qb[1], SB_b); \
        la += SA_a[4]; la += SA_a[5]; PA_a_lo[2] = pk2(SA_a[4], SA_a[5]); XPROBE(SA_a[4]); \
        SA_a[6] = EX2(SA_a[6]); SA_a[7] = EX2(SA_a[7]); \
        SBAR(); \
        vf0 = *(const LAS bf16x8*)(VPREV1 + 0); \
        SB_a = MFMA32(kf2, qa[2], SB_a); \
        la += SA_a[6]; la += SA_a[7]; PA_a_lo[3] = pk2(SA_a[6], SA_a[7]); XPROBE(SA_a[6]); \
        SA_a[8] = EX2(SA_a[8]); SA_a[9] = EX2(SA_a[9]); \
        SBAR(); \
        vf1 = *(const LAS bf16x8*)(VPREV1 + 512); \
        SB_b = MFMA32(kf2, qb[2], SB_b); \
        la += SA_a[8]; la += SA_a[9]; PA_a_hi[0] = pk2(SA_a[8], SA_a[9]); XPROBE(SA_a[8]); \
        SA_a[10] = EX2(SA_a[10]); SA_a[11] = EX2(SA_a[11]); \
        SBAR(); \
        SB_a = MFMA32(kf3, qa[3], SB_a); \
        la += SA_a[10]; la += SA_a[11]; PA_a_hi[1] = pk2(SA_a[10], SA_a[11]); XPROBE(SA_a[10]); \
        SA_a[12] = EX2(SA_a[12]); SA_a[13] = EX2(SA_a[13]); \
        SBAR(); \
        SB_b = MFMA32(kf3, qb[3], SB_b); \
        la += SA_a[12]; la += SA_a[13]; PA_a_hi[2] = pk2(SA_a[12], SA_a[13]); XPROBE(SA_a[12]); \
        SA_a[14] = EX2(SA_a[14]); SA_a[15] = EX2(SA_a[15]); \
        SBAR(); \
        vf2 = *(const LAS bf16x8*)(VPREV1 + 2048); \
        oa0 = MFMA32(vf0, PB_a_lo, oa0); \
        la += SA_a[14]; la += SA_a[15]; PA_a_hi[3] = pk2(SA_a[14], SA_a[15]); XPROBE(SA_a[14]); \
        SA_b[0] = EX2(SA_b[0]); SA_b[1] = EX2(SA_b[1]); \
        SBAR(); \
        vf3 = *(const LAS bf16x8*)(VPREV1 + 2560); \
        oa1 = MFMA32(vf1, PB_a_lo, oa1); \
        lb += SA_b[0]; lb += SA_b[1]; PA_b_lo[0] = pk2(SA_b[0], SA_b[1]); XPROBE(SA_b[0]); \
        SA_b[2] = EX2(SA_b[2]); SA_b[3] = EX2(SA_b[3]); \
        SBAR(); \
        ob0 = MFMA32(vf0, PB_b_lo, ob0); \
        lb += SA_b[2]; lb += SA_b[3]; PA_b_lo[1] = pk2(SA_b[2], SA_b[3]); XPROBE(SA_b[2]); \
        SA_b[4] = EX2(SA_b[4]); SA_b[5] = EX2(SA_b[5]); \
        SBAR(); \
        ob1 = MFMA32(vf1, PB_b_lo, ob1); \
        lb += SA_b[4]; lb += SA_b[5]; PA_b_lo[2] = pk2(SA_b[4], SA_b[5]); XPROBE(SA_b[4]); \
        SA_b[6] = EX2(SA_b[6]); SA_b[7] = EX2(SA_b[7]); \
        SBAR(); \
        kf0 = *(const LAS bf16x8*)(KNEXT0 + 0); \
        oa0 = MFMA32(vf2, PB_a_hi, oa0); \
        lb += SA_b[6]; lb += SA_b[7]; PA_b_lo[3] = pk2(SA_b[6], SA_b[7]); XPROBE(SA_b[6]); \
        SA_b[8] = EX2(SA_b[8]); SA_b[9] = EX2(SA_b[9]); \
        SBAR(); \
        oa1 = MFMA32(vf3, PB_a_hi, oa1); \
        lb += SA_b[8]; lb += SA_b[9]; PA_b_hi[0] = pk2(SA_b[8], SA_b[9]); XPROBE(SA_b[8]); \
        SA_b[10] = EX2(SA_b[10]); SA_b[11] = EX2(SA_b[11]); \
        SBAR(); \
        kf1 = *(const LAS bf16x8*)(KNEXT0 + 2048); \
        ob0 = MFMA32(vf2, PB_b_hi, ob0); \
        lb += SA_b[10]; lb += SA_b[11]; PA_b_hi[1] = pk2(SA_b[10], SA_b[11]); XPROBE(SA_b[10]); \
        SA_b[12] = EX2(SA_b[12]); SA_b[13] = EX2(SA_b[13]); \
        SBAR(); \
        ob1 = MFMA32(vf3, PB_b_hi, ob1); \
        lb += SA_b[12]; lb += SA_b[13]; PA_b_hi[2] = pk2(SA_b[12], SA_b[13]); XPROBE(SA_b[12]); \
        SA_b[14] = EX2(SA_b[14]); SA_b[15] = EX2(SA_b[15]); \
        lb += SA_b[14]; lb += SA_b[15]; PA_b_hi[3] = pk2(SA_b[14], SA_b[15]); XPROBE(SA_b[14]); \
        SBAR(); \
        kf2 = *(const LAS bf16x8*)(KNEXT0 + 4096); \
        SA_a = MFMA32(kf0, qa[0], ZERO16); \
        SB_a[0] = EX2(SB_a[0]); SB_a[1] = EX2(SB_a[1]); \
        SBAR(); \
        SA_b = MFMA32(kf0, qb[0], ZERO16); \
        la += SB_a[0]; la += SB_a[1]; PB_a_lo[0] = pk2(SB_a[0], SB_a[1]); XPROBE(SB_a[0]); \
        SB_a[2] = EX2(SB_a[2]); SB_a[3] = EX2(SB_a[3]); \
        SBAR(); \
        kf3 = *(const LAS bf16x8*)(KNEXT0 + 6144); \
        SA_a = MFMA32(kf1, qa[1], SA_a); \
        la += SB_a[2]; la += SB_a[3]; PB_a_lo[1] = pk2(SB_a[2], SB_a[3]); XPROBE(SB_a[2]); \
        SB_a[4] = EX2(SB_a[4]); SB_a[5] = EX2(SB_a[5]); \
        SBAR(); \
        SA_b = MFMA32(kf1, qb[1], SA_b); \
        la += SB_a[4]; la += SB_a[5]; PB_a_lo[2] = pk2(SB_a[4], SB_a[5]); XPROBE(SB_a[4]); \
        SB_a[6] = EX2(SB_a[6]); SB_a[7] = EX2(SB_a[7]); \
        SBAR(); \
        vf0 = *(const LAS bf16x8*)(VCUR0 + 0); \
        SA_a = MFMA32(kf2, qa[2], SA_a); \
        la += SB_a[6]; la += SB_a[7]; PB_a_lo[3] = pk2(SB_a[6], SB_a[7]); XPROBE(SB_a[6]); \
        SB_a[8] = EX2(SB_a[8]); SB_a[9] = EX2(SB_a[9]); \
        SBAR(); \
        vf1 = *(const LAS bf16x8*)(VCUR0 + 512); \
        SA_b = MFMA32(kf2, qb[2], SA_b); \
        la += SB_a[8]; la += SB_a[9]; PB_a_hi[0] = pk2(SB_a[8], SB_a[9]); XPROBE(SB_a[8]); \
        SB_a[10] = EX2(SB_a[10]); SB_a[11] = EX2(SB_a[11]); \
        SBAR(); \
        SA_a = MFMA32(kf3, qa[3], SA_a); \
        la += SB_a[10]; la += SB_a[11]; PB_a_hi[1] = pk2(SB_a[10], SB_a[11]); XPROBE(SB_a[10]); \
        SB_a[12] = EX2(SB_a[12]); SB_a[13] = EX2(SB_a[13]); \
        SBAR(); \
        SA_b = MFMA32(kf3, qb[3], SA_b); \
        la += SB_a[12]; la += SB_a[13]; PB_a_hi[2] = pk2(SB_a[12], SB_a[13]); XPROBE(SB_a[12]); \
        SB_a[14] = EX2(SB_a[14]); SB_a[15] = EX2(SB_a[15]); \
        SBAR(); \
        vf2 = *(const LAS bf16x8*)(VCUR0 + 2048); \
        oa0 = MFMA32(vf0, PA_a_lo, oa0); \
        la += SB_a[14]; la += SB_a[15]; PB_a_hi[3] = pk2(SB_a[14], SB_a[15]); XPROBE(SB_a[14]); \
        SB_b[0] = EX2(SB_b[0]); SB_b[1] = EX2(SB_b[1]); \
        SBAR(); \
        vf3 = *(const LAS bf16x8*)(VCUR0 + 2560); \
        oa1 = MFMA32(vf1, PA_a_lo, oa1); \
        lb += SB_b[0]; lb += SB_b[1]; PB_b_lo[0] = pk2(SB_b[0], SB_b[1]); XPROBE(SB_b[0]); \
        SB_b[2] = EX2(SB_b[2]); SB_b[3] = EX2(SB_b[3]); \
        SBAR(); \
        ob0 = MFMA32(vf0, PA_b_lo, ob0); \
        lb += SB_b[2]; lb += SB_b[3]; PB_b_lo[1] = pk2(SB_b[2], SB_b[3]); XPROBE(SB_b[2]); \
        SB_b[4] = EX2(SB_b[4]); SB_b[5] = EX2(SB_b[5]); \
        SBAR(); \
        ob1 = MFMA32(vf1, PA_b_lo, ob1); \
        lb += SB_b[4]; lb += SB_b[5]; PB_b_lo[2] = pk2(SB_b[4], SB_b[5]); XPROBE(SB_b[4]); \
        SB_b[6] = EX2(SB_b[6]); SB_b[7] = EX2(SB_b[7]); \
        SBAR(); \
        kf0 = *(const LAS bf16x8*)(KNEXT1 + 0); \
        oa0 = MFMA32(vf2, PA_a_hi, oa0); \
        lb += SB_b[6]; lb += SB_b[7]; PB_b_lo[3] = pk2(SB_b[6], SB_b[7]); XPROBE(SB_b[6]); \
        SB_b[8] = EX2(SB_b[8]); SB_b[9] = EX2(SB_b[9]); \
        SBAR(); \
        oa1 = MFMA32(vf3, PA_a_hi, oa1); \
        lb += SB_b[8]; lb += SB_b[9]; PB_b_hi[0] = pk2(SB_b[8], SB_b[9]); XPROBE(SB_b[8]); \
        SB_b[10] = EX2(SB_b[10]); SB_b[11] = EX2(SB_b[11]); \
        SBAR(); \
        kf1 = *(const LAS bf16x8*)(KNEXT1 + 2048); \
        ob0 = MFMA32(vf2, PA_b_hi, ob0); \
        lb += SB_b[10]; lb += SB_b[11]; PB_b_hi[1] = pk2(SB_b[10], SB_b[11]); XPROBE(SB_b[10]); \
        SB_b[12] = EX2(SB_b[12]); SB_b[13] = EX2(SB_b[13]); \
        SBAR(); \
        ob1 = MFMA32(vf3, PA_b_hi, ob1); \
        lb += SB_b[12]; lb += SB_b[13]; PB_b_hi[2] = pk2(SB_b[12], SB_b[13]); XPROBE(SB_b[12]); \
        SB_b[14] = EX2(SB_b[14]); SB_b[15] = EX2(SB_b[15]); \
        lb += SB_b[14]; lb += SB_b[15]; PB_b_hi[3] = pk2(SB_b[14], SB_b[15]); XPROBE(SB_b[14]); \
        SBAR(); \
    } while (0)

#define ATT_MLA_PRE(KCUR1) do { \
        kf0 = *(const LAS bf16x8*)(KCUR1 + 0); \
        kf1 = *(const LAS bf16x8*)(KCUR1 + 2048); \
    } while (0)
#define ATT_MLA_ITER(KCUR1, KNEXT0, KNEXT1, VPREV1, VCUR0) do { \
        kf2 = *(const LAS bf16x8*)(KCUR1 + 4096); \
        SB_a = MFMA32(kf0, qa[0], ZERO16); \
        SA_a[0] = EX2(SA_a[0]); SA_a[1] = EX2(SA_a[1]); \
        SBAR(); \
        SB_b = MFMA32(kf0, qb[0], ZERO16); \
        la += SA_a[0]; la += SA_a[1]; PA_a_lo[0] = pk2(SA_a[0], SA_a[1]); XPROBE(SA_a[0]); \
        SA_a[2] = EX2(SA_a[2]); SA_a[3] = EX2(SA_a[3]); \
        SBAR(); \
        kf3 = *(const LAS bf16x8*)(KCUR1 + 6144); \
        SB_a = MFMA32(kf1, qa[1], SB_a); \
        la += SA_a[2]; la += SA_a[3]; PA_a_lo[1] = pk2(SA_a[2], SA_a[3]); XPROBE(SA_a[2]); \
        SA_a[4] = EX2(SA_a[4]); SA_a[5] = EX2(SA_a[5]); \
        SBAR(); \
        SB_b = MFMA32(kf1, qb[1], SB_b); \
        la += SA_a[4]; la += SA_a[5]; PA_a_lo[2] = pk2(SA_a[4], SA_a[5]); XPROBE(SA_a[4]); \
        SA_a[6] = EX2(SA_a[6]); SA_a[7] = EX2(SA_a[7]); \
        SBAR(); \
        kf0 = *(const LAS bf16x8*)(KCUR1 + 8192); \
        SB_a = MFMA32(kf2, qa[2], SB_a); \
        la += SA_a[6]; la += SA_a[7]; PA_a_lo[3] = pk2(SA_a[6], SA_a[7]); XPROBE(SA_a[6]); \
        SBAR(); \
        SB_b = MFMA32(kf2, qb[2], SB_b); \
        SA_a[8] = EX2(SA_a[8]); SA_a[9] = EX2(SA_a[9]); \
        SBAR(); \
        kf1 = *(const LAS bf16x8*)(KCUR1 + 10240); \
        SB_a = MFMA32(kf3, qa[3], SB_a); \
        la += SA_a[8]; la += SA_a[9]; PA_a_hi[0] = pk2(SA_a[8], SA_a[9]); XPROBE(SA_a[8]); \
        SA_a[10] = EX2(SA_a[10]); SA_a[11] = EX2(SA_a[11]); \
        SBAR(); \
        SB_b = MFMA32(kf3, qb[3], SB_b); \
        la += SA_a[10]; la += SA_a[11]; PA_a_hi[1] = pk2(SA_a[10], SA_a[11]); XPROBE(SA_a[10]); \
        SA_a[12] = EX2(SA_a[12]); SA_a[13] = EX2(SA_a[13]); \
        SBAR(); \
        vf0 = *(const LAS bf16x8*)(VPREV1 + 0); \
        SB_a = MFMA32(kf0, qa[4], SB_a); \
        la += SA_a[12]; la += SA_a[13]; PA_a_hi[2] = pk2(SA_a[12], SA_a[13]); XPROBE(SA_a[12]); \
        SA_a[14] = EX2(SA_a[14]); SA_a[15] = EX2(SA_a[15]); \
        SBAR(); \
        vf1 = *(const LAS bf16x8*)(VPREV1 + 512); \
        SB_b = MFMA32(kf0, qb[4], SB_b); \
        la += SA_a[14]; la += SA_a[15]; PA_a_hi[3] = pk2(SA_a[14], SA_a[15]); XPROBE(SA_a[14]); \
        SBAR(); \
        SB_a = MFMA32(kf1, qa[5], SB_a); \
        SA_b[0] = EX2(SA_b[0]); SA_b[1] = EX2(SA_b[1]); \
        SBAR(); \
        SB_b = MFMA32(kf1, qb[5], SB_b); \
        lb += SA_b[0]; lb += SA_b[1]; PA_b_lo[0] = pk2(SA_b[0], SA_b[1]); XPROBE(SA_b[0]); \
        SA_b[2] = EX2(SA_b[2]); SA_b[3] = EX2(SA_b[3]); \
        SBAR(); \
        vf2 = *(const LAS bf16x8*)(VPREV1 + 2048); \
        oa0 = MFMA32(vf0, PB_a_lo, oa0); \
        lb += SA_b[2]; lb += SA_b[3]; PA_b_lo[1] = pk2(SA_b[2], SA_b[3]); XPROBE(SA_b[2]); \
        SA_b[4] = EX2(SA_b[4]); SA_b[5] = EX2(SA_b[5]); \
        SBAR(); \
        vf3 = *(const LAS bf16x8*)(VPREV1 + 2560); \
        oa1 = MFMA32(vf1, PB_a_lo, oa1); \
        lb += SA_b[4]; lb += SA_b[5]; PA_b_lo[2] = pk2(SA_b[4], SA_b[5]); XPROBE(SA_b[4]); \
        SA_b[6] = EX2(SA_b[6]); SA_b[7] = EX2(SA_b[7]); \
        SBAR(); \
        ob0 = MFMA32(vf0, PB_b_lo, ob0); \
        lb += SA_b[6]; lb += SA_b[7]; PA_b_lo[3] = pk2(SA_b[6], SA_b[7]); XPROBE(SA_b[6]); \
        SBAR(); \
        ob1 = MFMA32(vf1, PB_b_lo, ob1); \
        SA_b[8] = EX2(SA_b[8]); SA_b[9] = EX2(SA_b[9]); \
        SBAR(); \
        kf0 = *(const LAS bf16x8*)(KNEXT0 + 0); \
        oa0 = MFMA32(vf2, PB_a_hi, oa0); \
        lb += SA_b[8]; lb += SA_b[9]; PA_b_hi[0] = pk2(SA_b[8], SA_b[9]); XPROBE(SA_b[8]); \
        SA_b[10] = EX2(SA_b[10]); SA_b[11] = EX2(SA_b[11]); \
        SBAR(); \
        oa1 = MFMA32(vf3, PB_a_hi, oa1); \
        lb += SA_b[10]; lb += SA_b[11]; PA_b_hi[1] = pk2(SA_b[10], SA_b[11]); XPROBE(SA_b[10]); \
        SA_b[12] = EX2(SA_b[12]); SA_b[13] = EX2(SA_b[13]); \
        SBAR(); \
        kf1 = *(const LAS bf16x8*)(KNEXT0 + 2048); \
        ob0 = MFMA32(vf2, PB_b_hi, ob0); \
        lb += SA_b[12]; lb += SA_b[13]; PA_b_hi[2] = pk2(SA_b[12], SA_b[13]); XPROBE(SA_b[12]); \
        SA_b[14] = EX2(SA_b[14]); SA_b[15] = EX2(SA_b[15]); \
        SBAR(); \
        ob1 = MFMA32(vf3, PB_b_hi, ob1); \
        lb += SA_b[14]; lb += SA_b[15]; PA_b_hi[3] = pk2(SA_b[14], SA_b[15]); XPROBE(SA_b[14]); \
        SBAR(); \
        kf2 = *(const LAS bf16x8*)(KNEXT0 + 4096); \
        SA_a = MFMA32(kf0, qa[0], ZERO16); \
        SB_a[0] = EX2(SB_a[0]); SB_a[1] = EX2(SB_a[1]); \
        SBAR(); \
        SA_b = MFMA32(kf0, qb[0], ZERO16); \
        la += SB_a[0]; la += SB_a[1]; PB_a_lo[0] = pk2(SB_a[0], SB_a[1]); XPROBE(SB_a[0]); \
        SB_a[2] = EX2(SB_a[2]); SB_a[3] = EX2(SB_a[3]); \
        SBAR(); \
        kf3 = *(const LAS bf16x8*)(KNEXT0 + 6144); \
        SA_a = MFMA32(kf1, qa[1], SA_a); \
        la += SB_a[2]; la += SB_a[3]; PB_a_lo[1] = pk2(SB_a[2], SB_a[3]); XPROBE(SB_a[2]); \
        SB_a[4] = EX2(SB_a[4]); SB_a[5] = EX2(SB_a[5]); \
        SBAR(); \
        SA_b = MFMA32(kf1, qb[1], SA_b); \
        la += SB_a[4]; la += SB_a[5]; PB_a_lo[2] = pk2(SB_a[4], SB_a[5]); XPROBE(SB_a[4]); \
        SB_a[6] = EX2(SB_a[6]); SB_a[7] = EX2(SB_a[7]); \
        SBAR(); \
        kf0 = *(const LAS bf16x8*)(KNEXT0 + 8192); \
        SA_a = MFMA32(kf2, qa[2], SA_a); \
        la += SB_a[6]; la += SB_a[7]; PB_a_lo[3] = pk2(SB_a[6], SB_a[7]); XPROBE(SB_a[6]); \
        SBAR(); \
        SA_b = MFMA32(kf2, qb[2], SA_b); \
        SB_a[8] = EX2(SB_a[8]); SB_a[9] = EX2(SB_a[9]); \
        SBAR(); \
        kf1 = *(const LAS bf16x8*)(KNEXT0 + 10240); \
        SA_a = MFMA32(kf3, qa[3], SA_a); \
        la += SB_a[8]; la += SB_a[9]; PB_a_hi[0] = pk2(SB_a[8], SB_a[9]); XPROBE(SB_a[8]); \
        SB_a[10] = EX2(SB_a[10]); SB_a[11] = EX2(SB_a[11]); \
        SBAR(); \
        SA_b = MFMA32(kf3, qb[3], SA_b); \
        la += SB_a[10]; la += SB_a[11]; PB_a_hi[1] = pk2(SB_a[10], SB_a[11]); XPROBE(SB_a[10]); \
        SB_a[12] = EX2(SB_a[12]); SB_a[13] = EX2(SB_a[13]); \
        SBAR(); \
        vf0 = *(const LAS bf16x8*)(VCUR0 + 0); \
        SA_a = MFMA32(kf0, qa[4], SA_a); \
        la += SB_a[12]; la += SB_a[13]; PB_a_hi[2] = pk2(SB_a[12], SB_a[13]); XPROBE(SB_a[12]); \
        SB_a[14] = EX2(SB_a[14]); SB_a[15] = EX2(SB_a[15]); \
        SBAR(); \
        vf1 = *(const LAS bf16x8*)(VCUR0 + 512); \
        SA_b = MFMA32(kf0, qb[4], SA_b); \
        la += SB_a[14]; la += SB_a[15]; PB_a_hi[3] = pk2(SB_a[14], SB_a[15]); XPROBE(SB_a[14]); \
        SBAR(); \
        SA_a = MFMA32(kf1, qa[5], SA_a); \
        SB_b[0] = EX2(SB_b[0]); SB_b[1] = EX2(SB_b[1]); \
        SBAR(); \
        SA_b = MFMA32(kf1, qb[5], SA_b); \
        lb += SB_b[0]; lb += SB_b[1]; PB_b_lo[0] = pk2(SB_b[0], SB_b[1]); XPROBE(SB_b[0]); \
        SB_b[2] = EX2(SB_b[2]); SB_b[3] = EX2(SB_b[3]); \
        SBAR(); \
        vf2 = *(const LAS bf16x8*)(VCUR0 + 2048); \
        oa0 = MFMA32(vf0, PA_a_lo, oa0); \
        lb += SB_b[2]; lb += SB_b[3]; PB_b_lo[1] = pk2(SB_b[2], SB_b[3]); XPROBE(SB_b[2]); \
        SB_b[4] = EX2(SB_b[4]); SB_b[5] = EX2(SB_b[5]); \
        SBAR(); \
        vf3 = *(const LAS bf16x8*)(VCUR0 + 2560); \
        oa1 = MFMA32(vf1, PA_a_lo, oa1); \
        lb += SB_b[4]; lb += SB_b[5]; PB_b_lo[2] = pk2(SB_b[4], SB_b[5]); XPROBE(SB_b[4]); \
        SB_b[6] = EX2(SB_b[6]); SB_b[7] = EX2(SB_b[7]); \
        SBAR(); \
        ob0 = MFMA32(vf0, PA_b_lo, ob0); \
        lb += SB_b[6]; lb += SB_b[7]; PB_b_lo[3] = pk2(SB_b[6], SB_b[7]); XPROBE(SB_b[6]); \
        SBAR(); \
        ob1 = MFMA32(vf1, PA_b_lo, ob1); \
        SB_b[8] = EX2(SB_b[8]); SB_b[9] = EX2(SB_b[9]); \
        SBAR(); \
        kf0 = *(const LAS bf16x8*)(KNEXT1 + 0); \
        oa0 = MFMA32(vf2, PA_a_hi, oa0); \
        lb += SB_b[8]; lb += SB_b[9]; PB_b_hi[0] = pk2(SB_b[8], SB_b[9]); XPROBE(SB_b[8]); \
        SB_b[10] = EX2(SB_b[10]); SB_b[11] = EX2(SB_b[11]); \
        SBAR(); \
        oa1 = MFMA32(vf3, PA_a_hi, oa1); \
        lb += SB_b[10]; lb += SB_b[11]; PB_b_hi[1] = pk2(SB_b[10], SB_b[11]); XPROBE(SB_b[10]); \
        SB_b[12] = EX2(SB_b[12]); SB_b[13] = EX2(SB_b[13]); \
        SBAR(); \
        kf1 = *(const LAS bf16x8*)(KNEXT1 + 2048); \
        ob0 = MFMA32(vf2, PA_b_hi, ob0); \
        lb += SB_b[12]; lb += SB_b[13]; PB_b_hi[2] = pk2(SB_b[12], SB_b[13]); XPROBE(SB_b[12]); \
        SB_b[14] = EX2(SB_b[14]); SB_b[15] = EX2(SB_b[15]); \
        SBAR(); \
        ob1 = MFMA32(vf3, PA_b_hi, ob1); \
        lb += SB_b[14]; lb += SB_b[15]; PB_b_hi[3] = pk2(SB_b[14], SB_b[15]); XPROBE(SB_b[14]); \
        SBAR(); \
    } while (0)

#define ATT_DIFF_PRE(KCUR1) do { \
        kf0 = *(const LAS bf16x8*)(KCUR1 + 0); \
        kf1 = *(const LAS bf16x8*)(KCUR1 + 4096); \
        kf2 = *(const LAS bf16x8*)(KCUR1 + 2048); \
        kf3 = *(const LAS bf16x8*)(KCUR1 + 6144); \
    } while (0)
#define ATT_DIFF_ITER(KCUR1, KNEXT0, KNEXT1, VPREV1, VCUR0) do { \
        vf0 = *(const LAS bf16x8*)(VPREV1 + 0); \
        SB_a = MFMA32(kf0, qa[0], ZERO16); \
        SA_a[0] = EX2(SA_a[0]); SA_a[1] = EX2(SA_a[1]); \
        SA_a[2] = EX2(SA_a[2]); SA_a[3] = EX2(SA_a[3]); \
        SBAR(); \
        vf1 = *(const LAS bf16x8*)(VPREV1 + 512); \
        SB_b = MFMA32(kf1, qb[0], ZERO16); \
        la += SA_a[0]; la += SA_a[1]; PA_a_lo[0] = pk2(SA_a[0], SA_a[1]); XPROBE(SA_a[0]); \
        la += SA_a[2]; la += SA_a[3]; PA_a_lo[1] = pk2(SA_a[2], SA_a[3]); XPROBE(SA_a[2]); \
        SA_a[4] = EX2(SA_a[4]); SA_a[5] = EX2(SA_a[5]); \
        SBAR(); \
        SB_a = MFMA32(kf2, qa[1], SB_a); \
        la += SA_a[4]; la += SA_a[5]; PA_a_lo[2] = pk2(SA_a[4], SA_a[5]); XPROBE(SA_a[4]); \
        SA_a[6] = EX2(SA_a[6]); SA_a[7] = EX2(SA_a[7]); \
        SBAR(); \
        SB_b = MFMA32(kf3, qb[1], SB_b); \
        la += SA_a[6]; la += SA_a[7]; PA_a_lo[3] = pk2(SA_a[6], SA_a[7]); XPROBE(SA_a[6]); \
        SA_a[8] = EX2(SA_a[8]); SA_a[9] = EX2(SA_a[9]); \
        SA_a[10] = EX2(SA_a[10]); SA_a[11] = EX2(SA_a[11]); \
        SBAR(); \
        vf2 = *(const LAS bf16x8*)(VPREV1 + 2048); \
        oa0 = MFMA32(vf0, PB_a_lo, oa0); \
        la += SA_a[8]; la += SA_a[9]; PA_a_hi[0] = pk2(SA_a[8], SA_a[9]); XPROBE(SA_a[8]); \
        la += SA_a[10]; la += SA_a[11]; PA_a_hi[1] = pk2(SA_a[10], SA_a[11]); XPROBE(SA_a[10]); \
        SA_a[12] = EX2(SA_a[12]); SA_a[13] = EX2(SA_a[13]); \
        SBAR(); \
        vf3 = *(const LAS bf16x8*)(VPREV1 + 2560); \
        oa1 = MFMA32(vf1, PB_a_lo, oa1); \
        la += SA_a[12]; la += SA_a[13]; PA_a_hi[2] = pk2(SA_a[12], SA_a[13]); XPROBE(SA_a[12]); \
        SA_a[14] = EX2(SA_a[14]); SA_a[15] = EX2(SA_a[15]); \
        SBAR(); \
        ob0 = MFMA32(vf0, PB_b_lo, ob0); \
        la += SA_a[14]; la += SA_a[15]; PA_a_hi[3] = pk2(SA_a[14], SA_a[15]); XPROBE(SA_a[14]); \
        SA_b[0] = EX2(SA_b[0]); SA_b[1] = EX2(SA_b[1]); \
        SA_b[2] = EX2(SA_b[2]); SA_b[3] = EX2(SA_b[3]); \
        SBAR(); \
        ob1 = MFMA32(vf1, PB_b_lo, ob1); \
        lb += SA_b[0]; lb += SA_b[1]; PA_b_lo[0] = pk2(SA_b[0], SA_b[1]); XPROBE(SA_b[0]); \
        lb += SA_b[2]; lb += SA_b[3]; PA_b_lo[1] = pk2(SA_b[2], SA_b[3]); XPROBE(SA_b[2]); \
        SA_b[4] = EX2(SA_b[4]); SA_b[5] = EX2(SA_b[5]); \
        SBAR(); \
        kf0 = *(const LAS bf16x8*)(KNEXT0 + 0); \
        oa0 = MFMA32(vf2, PB_a_hi, oa0); \
        lb += SA_b[4]; lb += SA_b[5]; PA_b_lo[2] = pk2(SA_b[4], SA_b[5]); XPROBE(SA_b[4]); \
        SA_b[6] = EX2(SA_b[6]); SA_b[7] = EX2(SA_b[7]); \
        SBAR(); \
        kf1 = *(const LAS bf16x8*)(KNEXT0 + 4096); \
        oa1 = MFMA32(vf3, PB_a_hi, oa1); \
        lb += SA_b[6]; lb += SA_b[7]; PA_b_lo[3] = pk2(SA_b[6], SA_b[7]); XPROBE(SA_b[6]); \
        SA_b[8] = EX2(SA_b[8]); SA_b[9] = EX2(SA_b[9]); \
        SA_b[10] = EX2(SA_b[10]); SA_b[11] = EX2(SA_b[11]); \
        SBAR(); \
        kf2 = *(const LAS bf16x8*)(KNEXT0 + 2048); \
        ob0 = MFMA32(vf2, PB_b_hi, ob0); \
        lb += SA_b[8]; lb += SA_b[9]; PA_b_hi[0] = pk2(SA_b[8], SA_b[9]); XPROBE(SA_b[8]); \
        lb += SA_b[10]; lb += SA_b[11]; PA_b_hi[1] = pk2(SA_b[10], SA_b[11]); XPROBE(SA_b[10]); \
        SA_b[12] = EX2(SA_b[12]); SA_b[13] = EX2(SA_b[13]); \
        SBAR(); \
        kf3 = *(const LAS bf16x8*)(KNEXT0 + 6144); \
        ob1 = MFMA32(vf3, PB_b_hi, ob1); \
        lb += SA_b[12]; lb += SA_b[13]; PA_b_hi[2] = pk2(SA_b[12], SA_b[13]); XPROBE(SA_b[12]); \
        SA_b[14] = EX2(SA_b[14]); SA_b[15] = EX2(SA_b[15]); \
        lb += SA_b[14]; lb += SA_b[15]; PA_b_hi[3] = pk2(SA_b[14], SA_b[15]); XPROBE(SA_b[14]); \
        SBAR(); \
        vf0 = *(const LAS bf16x8*)(VCUR0 + 0); \
        SA_a = MFMA32(kf0, qa[0], ZERO16); \
        SB_a[0] = EX2(SB_a[0]); SB_a[1] = EX2(SB_a[1]); \
        SB_a[2] = EX2(SB_a[2]); SB_a[3] = EX2(SB_a[3]); \
        SBAR(); \
        vf1 = *(const LAS bf16x8*)(VCUR0 + 512); \
        SA_b = MFMA32(kf1, qb[0], ZERO16); \
        la += SB_a[0]; la += SB_a[1]; PB_a_lo[0] = pk2(SB_a[0], SB_a[1]); XPROBE(SB_a[0]); \
        la += SB_a[2]; la += SB_a[3]; PB_a_lo[1] = pk2(SB_a[2], SB_a[3]); XPROBE(SB_a[2]); \
        SB_a[4] = EX2(SB_a[4]); SB_a[5] = EX2(SB_a[5]); \
        SBAR(); \
        SA_a = MFMA32(kf2, qa[1], SA_a); \
        la += SB_a[4]; la += SB_a[5]; PB_a_lo[2] = pk2(SB_a[4], SB_a[5]); XPROBE(SB_a[4]); \
        SB_a[6] = EX2(SB_a[6]); SB_a[7] = EX2(SB_a[7]); \
        SBAR(); \
        SA_b = MFMA32(kf3, qb[1], SA_b); \
        la += SB_a[6]; la += SB_a[7]; PB_a_lo[3] = pk2(SB_a[6], SB_a[7]); XPROBE(SB_a[6]); \
        SB_a[8] = EX2(SB_a[8]); SB_a[9] = EX2(SB_a[9]); \
        SB_a[10] = EX2(SB_a[10]); SB_a[11] = EX2(SB_a[11]); \
        SBAR(); \
        vf2 = *(const LAS bf16x8*)(VCUR0 + 2048); \
        oa0 = MFMA32(vf0, PA_a_lo, oa0); \
        la += SB_a[8]; la += SB_a[9]; PB_a_hi[0] = pk2(SB_a[8], SB_a[9]); XPROBE(SB_a[8]); \
        la += SB_a[10]; la += SB_a[11]; PB_a_hi[1] = pk2(SB_a[10], SB_a[11]); XPROBE(SB_a[10]); \
        SB_a[12] = EX2(SB_a[12]); SB_a[13] = EX2(SB_a[13]); \
        SBAR(); \
        vf3 = *(const LAS bf16x8*)(VCUR0 + 2560); \
        oa1 = MFMA32(vf1, PA_a_lo, oa1); \
        la += SB_a[12]; la += SB_a[13]; PB_a_hi[2] = pk2(SB_a[12], SB_a[13]); XPROBE(SB_a[12]); \
        SB_a[14] = EX2(SB_a[14]); SB_a[15] = EX2(SB_a[15]); \
        SBAR(); \
        ob0 = MFMA32(vf0, PA_b_lo, ob0); \
        la += SB_a[14]; la += SB_a[15]; PB_a_hi[3] = pk2(SB_a[14], SB_a[15]); XPROBE(SB_a[14]); \
        SB_b[0] = EX2(SB_b[0]); SB_b[1] = EX2(SB_b[1]); \
        SB_b[2] = EX2(SB_b[2]); SB_b[3] = EX2(SB_b[3]); \
        SBAR(); \
        ob1 = MFMA32(vf1, PA_b_lo, ob1); \
        lb += SB_b[0]; lb += SB_b[1]; PB_b_lo[0] = pk2(SB_b[0], SB_b[1]); XPROBE(SB_b[0]); \
        lb += SB_b[2]; lb += SB_b[3]; PB_b_lo[1] = pk2(SB_b[2], SB_b[3]); XPROBE(SB_b[2]); \
        SB_b[4] = EX2(SB_b[4]); SB_b[5] = EX2(SB_b[5]); \
        SBAR(); \
        kf0 = *(const LAS bf16x8*)(KNEXT1 + 0); \
        oa0 = MFMA32(vf2, PA_a_hi, oa0); \
        lb += SB_b[4]; lb += SB_b[5]; PB_b_lo[2] = pk2(SB_b[4], SB_b[5]); XPROBE(SB_b[4]); \
        SB_b[6] = EX2(SB_b[6]); SB_b[7] = EX2(SB_b[7]); \
        SBAR(); \
        kf1 = *(const LAS bf16x8*)(KNEXT1 + 4096); \
        oa1 = MFMA32(vf3, PA_a_hi, oa1); \
        lb += SB_b[6]; lb += SB_b[7]; PB_b_lo[3] = pk2(SB_b[6], SB_b[7]); XPROBE(SB_b[6]); \
        SB_b[8] = EX2(SB_b[8]); SB_b[9] = EX2(SB_b[9]); \
        SB_b[10] = EX2(SB_b[10]); SB_b[11] = EX2(SB_b[11]); \
        SBAR(); \
        kf2 = *(const LAS bf16x8*)(KNEXT1 + 2048); \
        ob0 = MFMA32(vf2, PA_b_hi, ob0); \
        lb += SB_b[8]; lb += SB_b[9]; PB_b_hi[0] = pk2(SB_b[8], SB_b[9]); XPROBE(SB_b[8]); \
        lb += SB_b[10]; lb += SB_b[11]; PB_b_hi[1] = pk2(SB_b[10], SB_b[11]); XPROBE(SB_b[10]); \
        SB_b[12] = EX2(SB_b[12]); SB_b[13] = EX2(SB_b[13]); \
        SBAR(); \
        kf3 = *(const LAS bf16x8*)(KNEXT1 + 6144); \
        ob1 = MFMA32(vf3, PA_b_hi, ob1); \
        lb += SB_b[12]; lb += SB_b[13]; PB_b_hi[2] = pk2(SB_b[12], SB_b[13]); XPROBE(SB_b[12]); \
        SB_b[14] = EX2(SB_b[14]); SB_b[15] = EX2(SB_b[15]); \
        lb += SB_b[14]; lb += SB_b[15]; PB_b_hi[3] = pk2(SB_b[14], SB_b[15]); XPROBE(SB_b[14]); \
        SBAR(); \
    } while (0)

template <int DK, bool DIFF>
__device__ __forceinline__ void attn_dense_unit(const bf16* Q, int qp, int wave_rows, int nrows, size_t q_off1, const bf16* Kt, const bf16* Vt, int ntiles, bf16* O, size_t o_off1,
                                                LAS unsigned char* lds, int tid_in, const float* lamp, const float* gsub) {
    int tid = tid_in; asm volatile("" : "+v"(tid));
    constexpr int KB = 128 * DK;
    constexpr int KPIECES = DK / 8;
    constexpr int BUF = KB + 8192;
    constexpr int NS = DIFF ? 2 : DK / 16;
    const int lane = tid & 63, r = lane & 31, hi = lane >> 5; const int wid = __builtin_amdgcn_readfirstlane(tid >> 6);
    const bool valid = wave_rows * wid < nrows;
    const size_t wrow = valid ? (size_t)(wave_rows * wid + r) : (size_t)r;
    const bf16* qrow = Q + wrow * qp;
    bf16x8 qa[NS], qb[NS];
#pragma unroll
    for (int s = 0; s < NS; ++s) { qa[s] = *(const bf16x8*)(qrow + 16 * s + 8 * hi); qb[s] = *(const bf16x8*)(qrow + (DIFF ? 32 : q_off1) + 16 * s + 8 * hi); }
    f32x16 oa0 = {}, oa1 = {}, ob0 = {}, ob1 = {}; float la = 0.f, lb = 0.f;
    const int koff = hi * 1024 + pi32(r) * 16, voff = hi * 1024 + r * 16;
#define ATT_STAGE(t, slot) do { \
        const char* kg = (const char*)Kt + (size_t)(t) * KB; const char* vg = (const char*)Vt + (size_t)(t) * 8192; \
        __builtin_amdgcn_global_load_lds((const unsigned*)(kg + wid * 1024 + lane * 16), (LAS unsigned*)(lds + (slot) * BUF + wid * 1024), 16, 0, 0); \
        if (KPIECES > 8 && wid < KPIECES - 8) __builtin_amdgcn_global_load_lds((const unsigned*)(kg + (wid + 8) * 1024 + lane * 16), (LAS unsigned*)(lds + (slot) * BUF + (wid + 8) * 1024), 16, 0, 0); \
        __builtin_amdgcn_global_load_lds((const unsigned*)(vg + wid * 1024 + lane * 16), (LAS unsigned*)(lds + (slot) * BUF + KB + wid * 1024), 16, 0, 0); } while (0)
    ATT_STAGE(0, 0); ATT_STAGE(1, 1);
    VM_WAIT(); __syncthreads();
    f32x16 SA_a = {}, SA_b = {}, SB_a, SB_b;
    u32x4 PA_a_lo_, PA_a_hi_, PA_b_lo_, PA_b_hi_, PB_a_lo_, PB_a_hi_, PB_b_lo_, PB_b_hi_;
    { unsigned z = 0u; asm volatile("" : "+v"(z)); PB_a_lo_ = (u32x4){z, z, z, z}; PB_a_hi_ = PB_a_lo_; PB_b_lo_ = PB_a_lo_; PB_b_hi_ = PB_a_lo_; }
    bf16x8 kf0, kf1, kf2, kf3, vf0, vf1, vf2, vf3;
#define PA_a_lo PA_a_lo_
#define PA_a_hi PA_a_hi_
#define PA_b_lo PA_b_lo_
#define PA_b_hi PA_b_hi_
#define PB_a_lo PB_a_lo_
#define PB_a_hi PB_a_hi_
#define PB_b_lo PB_b_lo_
#define PB_b_hi PB_b_hi_
#undef MFMA32
#define MFMA32(A, B, C) __builtin_amdgcn_mfma_f32_32x32x16_bf16(__builtin_bit_cast(bf16x8, (A)), __builtin_bit_cast(bf16x8, (B)), (C), 0, 0, 0)
    {
        const LAS unsigned char* kp_ = lds + koff;
#pragma unroll
        for (int st = 0; st < NS; ++st) {
            if constexpr (!DIFF) { const bf16x8 kf = *(const LAS bf16x8*)(kp_ + st * 2048); SA_a = MFMA32(kf, qa[st], SA_a); SA_b = MFMA32(kf, qb[st], SA_b); }
            else { const bf16x8 k1 = *(const LAS bf16x8*)(kp_ + st * 2048), k2 = *(const LAS bf16x8*)(kp_ + (st + 2) * 2048); SA_a = MFMA32(k1, qa[st], SA_a); SA_b = MFMA32(k2, qb[st], SA_b); } }
    }
    if constexpr (DIFF) { ATT_DIFF_PRE(lds + 512 + koff); } else if constexpr (DK == 96) { ATT_MLA_PRE(lds + 512 + koff); } else { ATT_GQA_PRE(lds + 512 + koff); }
    int sp = 0, s0 = 0, s1 = 1, s2 = 2;
#pragma unroll 1
    for (int t = 0; t < ntiles; ++t) {
        { const int tn = min(t + 2, ntiles - 1); ATT_STAGE(tn, s2); }
        const LAS unsigned char* kcur1 = lds + s0 * BUF + 512 + koff; const LAS unsigned char* knext0 = lds + s1 * BUF + koff; const LAS unsigned char* knext1 = knext0 + 512;
        const LAS unsigned char* vprev1 = lds + sp * BUF + KB + 4096 + voff; const LAS unsigned char* vcur0 = lds + s0 * BUF + KB + voff;
        if constexpr (DIFF) { ATT_DIFF_ITER(kcur1, knext0, knext1, vprev1, vcur0); }
        else if constexpr (DK == 96) { ATT_MLA_ITER(kcur1, knext0, knext1, vprev1, vcur0); }
        else { ATT_GQA_ITER(kcur1, knext0, knext1, vprev1, vcur0); }
        sp = s0; s0 = s1; s1 = s2; s2 = (s2 + 1) & 3;
        VM_WAIT(); __syncthreads();
    }
    {
        const LAS unsigned char* vp_ = lds + sp * BUF + KB + 4096 + voff;
        const bf16x8 v00 = *(const LAS bf16x8*)(vp_), v01 = *(const LAS bf16x8*)(vp_ + 512), v10 = *(const LAS bf16x8*)(vp_ + 2048), v11 = *(const LAS bf16x8*)(vp_ + 2560);
        oa0 = MFMA32(v00, PB_a_lo, oa0); oa1 = MFMA32(v01, PB_a_lo, oa1); ob0 = MFMA32(v00, PB_b_lo, ob0); ob1 = MFMA32(v01, PB_b_lo, ob1);
        oa0 = MFMA32(v10, PB_a_hi, oa0); oa1 = MFMA32(v11, PB_a_hi, oa1); ob0 = MFMA32(v10, PB_b_hi, ob0); ob1 = MFMA32(v11, PB_b_hi, ob1);
    }
#undef MFMA32
#define MFMA32(A, B, C) __builtin_amdgcn_mfma_f32_32x32x16_bf16((A), (B), (C), 0, 0, 0)
#undef PA_a_lo
#undef PA_a_hi
#undef PA_b_lo
#undef PA_b_hi
#undef PB_a_lo
#undef PB_a_hi
#undef PB_b_lo
#undef PB_b_hi
#undef ATT_STAGE
    int tid2 = tid_in; asm volatile("" : "+v"(tid2));
    const int lane2 = tid2 & 63, r2 = lane2 & 31, hi2 = lane2 >> 5; const int wid2 = __builtin_amdgcn_readfirstlane(tid2 >> 6);
    const bool valid2 = wave_rows * wid2 < nrows;
    bf16* orow = O + (valid2 ? (size_t)(wave_rows * wid2 + r2) : (size_t)r2) * D;
    la += shx(la, 32); lb += shx(lb, 32);
    if constexpr (!DIFF) {
        const float ia = __builtin_amdgcn_rcpf(la), ib = __builtin_amdgcn_rcpf(lb);
#pragma unroll
        for (int i = 0; i < 16; ++i) { oa0[i] *= ia; oa1[i] *= ia; ob0[i] *= ib; ob1[i] *= ib; }
        if (valid2) { store_ot(orow, oa0, oa1, hi2); store_ot(orow + o_off1, ob0, ob1, hi2); }
    } else {
        const float lam = lamp[0], lam_scale = lamp[1]; const float ia = __builtin_amdgcn_rcpf(la), ib = lam * __builtin_amdgcn_rcpf(lb); float ss = 0.f;
#pragma unroll
        for (int i = 0; i < 16; ++i) { oa0[i] = oa0[i] * ia - ob0[i] * ib; oa1[i] = oa1[i] * ia - ob1[i] * ib; ss += oa0[i] * oa0[i] + oa1[i] * oa1[i]; }
        ss += shx(ss, 32);
        const float rr = rsqrtf(ss * (1.f / 64.f) + EPS) * lam_scale;
#pragma unroll
        for (int i = 0; i < 16; ++i) { const int dv = 8 * (i >> 2) + 4 * hi2 + (i & 3); oa0[i] *= rr * gsub[dv]; oa1[i] *= rr * gsub[32 + dv]; }
        if (valid2) store_ot(orow, oa0, oa1, hi2);
    }
    __syncthreads();
}
__device__ __forceinline__ void attn_na_unit(const Args& a, int b, int h, int g, LAS unsigned char* lds, const LAS float* bias_l, int tid_in) {
    int tid = tid_in; asm volatile("" : "+v"(tid));
    const int lane = tid & 63, r = lane & 31, hi = lane >> 5; const int wid = __builtin_amdgcn_readfirstlane(tid >> 6);
    const int wr = wid >> 1, qb = wid & 1, gr = 4 * g + wr;
    const int m = b * SEQ + gr * 64 + 32 * qb + r;
    const bf16* qrow = (const bf16*)(a.ws + WS_QNA) + (size_t)m * 256 + 64 * h;
    bf16x8 qf[4];
#pragma unroll
    for (int s = 0; s < 4; ++s) qf[s] = *(const bf16x8*)(qrow + 16 * s + 8 * hi);
    const int c = 32 * qb + r, c0 = min(max(c - 8, 0), 48), r0 = min(max(gr - 4, 0), 248);
    const int lo = min(max(4 * g - 4, 0), 248), hiw = min(max(4 * g - 1, 0), 248) + 7, ntile = 4 + (hiw - lo + 1);
    const bf16* Kt = ktile_ptr(a.ws, WS_KNA, 4, 64, b, h, 0); const bf16* Vt = ktile_ptr(a.ws, WS_VNA, 4, 64, b, h, 0);
    f32x16 o0 = {}, o1 = {}; float l0 = 0.f;
    const int koff = hi * 1024 + pi32(r) * 16, voff = hi * 1024 + r * 16;
    int boff[2][16];
#pragma unroll
    for (int kb = 0; kb < 2; ++kb)
#pragma unroll
        for (int i = 0; i < 16; ++i) { const int kc = 32 * kb + 16 * (i >> 3) + 8 * hi + (i & 7); const bool ok = (kc >= c0) && (kc < c0 + 16);
            boff[kb][i] = 4 * (ok ? min(max(kc - c + 15, 0), 30) : 31); }
#define NA_STAGE(t, buf) do { const int kt_ = (t) < 4 ? (t) : 4 + lo + ((t) - 4); \
        const char* kg = (const char*)Kt + (size_t)kt_ * 8192; const char* vg = (const char*)Vt + (size_t)kt_ * 8192; \
        __builtin_amdgcn_global_load_lds((const unsigned*)(kg + wid * 1024 + lane * 16), (LAS unsigned*)(lds + (buf) * 16384 + wid * 1024), 16, 0, 0); \
        __builtin_amdgcn_global_load_lds((const unsigned*)(vg + wid * 1024 + lane * 16), (LAS unsigned*)(lds + (buf) * 16384 + 8192 + wid * 1024), 16, 0, 0); } while (0)
    NA_STAGE(0, 0); NA_STAGE(1, 1); NA_STAGE(2, 2);
#pragma unroll 1
    for (int t = 0; t < ntile; ++t) {
        if (t + 2 < ntile) asm volatile("s_waitcnt vmcnt(4)" ::: "memory"); else if (t + 1 < ntile) asm volatile("s_waitcnt vmcnt(2)" ::: "memory"); else VM_WAIT();
        __syncthreads();
        if (t + 3 < ntile) NA_STAGE(t + 3, (t + 3) & 3);
        const int wrow = lo + (t - 4);
        const bool win = t >= 4; const bool rel = !win || (wrow >= r0 && wrow < r0 + 8);
        if (rel) {
            const LAS unsigned char* kb_ = lds + (t & 3) * 16384; const LAS unsigned char* vb_ = kb_ + 8192;
            const LAS unsigned char* brow = (const LAS unsigned char*)bias_l + (win ? (wrow - gr + 7) * 128 : 0);
#pragma unroll
            for (int kb = 0; kb < 2; ++kb) {
                f32x16 s = {};
#pragma unroll
                for (int st = 0; st < 4; ++st) { const bf16x8 kf = *(const LAS bf16x8*)(kb_ + st * 2048 + kb * 512 + koff); s = MFMA32(kf, qf[st], s); }
                const bool dead0 = win && kb == 0 && qb == 1, dead1 = win && kb == 1 && qb == 0;
                if (win) {
#pragma unroll
                    for (int hf = 0; hf < 2; ++hf) {
                        if (hf == 0 ? dead0 : dead1) {
#pragma unroll
                            for (int i = 8 * hf; i < 8 * hf + 8; ++i) s[i] = 0.f;
                        } else {
#pragma unroll
                            for (int i = 8 * hf; i < 8 * hf + 8; ++i) { const float bias = *(const LAS float*)(brow + boff[kb][i]); s[i] = __builtin_amdgcn_exp2f(s[i] + bias); l0 += s[i]; }
                        }
                    }
                } else {
#pragma unroll
                    for (int i = 0; i < 16; ++i) { s[i] = __builtin_amdgcn_exp2f(s[i]); l0 += s[i]; }
                }
                const bf16x8 p0 = pack8(s, 0), p1 = pack8(s, 8);
                const bf16x8 v00 = *(const LAS bf16x8*)(vb_ + (4 * kb + 0) * 1024 + voff), v01 = *(const LAS bf16x8*)(vb_ + (4 * kb + 0) * 1024 + 512 + voff);
                const bf16x8 v10 = *(const LAS bf16x8*)(vb_ + (4 * kb + 2) * 1024 + voff), v11 = *(const LAS bf16x8*)(vb_ + (4 * kb + 2) * 1024 + 512 + voff);
                if (!dead0) { o0 = MFMA32(v00, p0, o0); o1 = MFMA32(v01, p0, o1); }
                if (!dead1) { o0 = MFMA32(v10, p1, o0); o1 = MFMA32(v11, p1, o1); }
            }
        }
    }
#undef NA_STAGE
    l0 += shx(l0, 32);
    const float i0 = __builtin_amdgcn_rcpf(l0);
#pragma unroll
    for (int i = 0; i < 16; ++i) { o0[i] *= i0; o1[i] *= i0; }
    store_ot((bf16*)(a.ws + WS_O) + (size_t)m * D + 64 * h, o0, o1, hi);
    __syncthreads();
}
__device__ __forceinline__ void attn_phase(const Args& a, int l, LAS unsigned char* lds, int tid, int vcu, int G) {
    unsigned char* ws = a.ws; bf16* O = (bf16*)(ws + WS_O);
    const float* lamp = (const float*)(ws + WS_LAM) + 2 * l; const float* gsub = a.in[I_GDSUB] + l * 64;
    const bool ctxq = (l == 0);
#define CTX_LOOP(c, coff, n) for (int c = (((vcu - (coff)) % G) + G) % G; c < (ctxq ? (n) : 0); c += G)
    for (int u = vcu; u < 256; u += G) { const int bh = u >> 5, b = bh >> 2, h = bh & 3; const size_t m0 = (size_t)b * SEQ + 512 * (u & 31);
        attn_dense_unit<96, false>((const bf16*)(ws + WS_QMLA) + m0 * 384 + 96 * h, 384, 64, 512, (size_t)32 * 384, ktile_ptr(ws, WS_KMLA, 4, 96, b, h, 0), ktile_ptr(ws, WS_VMLA, 4, 64, b, h, 0), NTILE,
                                   O + m0 * D + 256 + 64 * h, (size_t)32 * D, lds, tid, lamp, gsub); }
    CTX_LOOP(c, 0, 8) { const int b = c >> 2, h = c & 3; const size_t m0 = (size_t)NLAT + b * CTXL;
        attn_dense_unit<96, false>((const bf16*)(ws + WS_QMLA) + m0 * 384 + 96 * h, 384, 64, 256, (size_t)32 * 384, ktile_ptr(ws, WS_KMLA, 4, 96, b, h, 0), ktile_ptr(ws, WS_VMLA, 4, 64, b, h, 0), 4,
                                   O + m0 * D + 256 + 64 * h, (size_t)32 * D, lds, tid, lamp, gsub); }
    for (int u = vcu; u < 512; u += G) { const int bh = (u & 255) >> 5, qt = (u & 31) + 32 * (u >> 8), b = bh >> 2, h = bh & 3; const size_t m0 = (size_t)b * SEQ + 256 * qt;
        attn_dense_unit<64, true>((const bf16*)(ws + WS_QDIFF) + m0 * 256 + 64 * h, 256, 32, 256, 0, ktile_ptr(ws, WS_KDIFF, 4, 64, b, h, 0), ktile_ptr(ws, WS_VDIFF, 4, 64, b, h, 0), NTILE,
                                  O + m0 * D + 512 + 64 * h, 0, lds, tid, lamp, gsub); }
    CTX_LOOP(c, 8, 8) { const int b = c >> 2, h = c & 3; const size_t m0 = (size_t)NLAT + b * CTXL;
        attn_dense_unit<64, true>((const bf16*)(ws + WS_QDIFF) + m0 * 256 + 64 * h, 256, 32, 256, 0, ktile_ptr(ws, WS_KDIFF, 4, 64, b, h, 0), ktile_ptr(ws, WS_VDIFF, 4, 64, b, h, 0), 4,
                                  O + m0 * D + 512 + 64 * h, 0, lds, tid, lamp, gsub); }
    for (int u = vcu; u < 256; u += G) { const int bk = u >> 6, b = bk >> 1, kh = bk & 1; const size_t m0 = (size_t)b * SEQ + 256 * (u & 63);
        attn_dense_unit<64, false>((const bf16*)(ws + WS_QGQA) + m0 * 256 + 128 * kh, 256, 32, 256, 64, ktile_ptr(ws, WS_KGQA, 2, 64, b, kh, 0), ktile_ptr(ws, WS_VGQA, 2, 64, b, kh, 0), NTILE,
                                   O + m0 * D + 768 + 128 * kh, 64, lds, tid, lamp, gsub); }
    CTX_LOOP(c, 16, 4) { const int b = c >> 1, kh = c & 1; const size_t m0 = (size_t)NLAT + b * CTXL;
        attn_dense_unit<64, false>((const bf16*)(ws + WS_QGQA) + m0 * 256 + 128 * kh, 256, 32, 256, 64, ktile_ptr(ws, WS_KGQA, 2, 64, b, kh, 0), ktile_ptr(ws, WS_VGQA, 2, 64, b, kh, 0), 4,
                                   O + m0 * D + 768 + 128 * kh, 64, lds, tid, lamp, gsub); }
    { LAS float* bl = (LAS float*)(lds + 65536); const float* rpb = a.in[I_RPB] + (size_t)l * 4 * 465;
      for (int i = tid; i < 4 * 480; i += 512) { const int h = i / 480, rem = i % 480, dy = rem >> 5, dx = rem & 31; bl[i] = dx < 31 ? rpb[h * 465 + dy * 31 + dx] * LOG2E : -3.0e38f; }
      __syncthreads();
      for (int u = vcu; u < 512; u += G) { const int bh = u >> 6, b = bh >> 2, h = bh & 3; attn_na_unit(a, b, h, u & 63, lds, bl + h * 480, tid); } }
    CTX_LOOP(c, 24, 8) { const int b = c >> 2, h = c & 3; const size_t m0 = (size_t)NLAT + b * CTXL;
        attn_dense_unit<64, false>((const bf16*)(ws + WS_QNA) + m0 * 256 + 64 * h, 256, 64, 256, (size_t)32 * 256, ktile_ptr(ws, WS_KNA, 4, 64, b, h, 0), ktile_ptr(ws, WS_VNA, 4, 64, b, h, 0), 4,
                                   O + m0 * D + 64 * h, (size_t)32 * D, lds, tid, lamp, gsub); }
#undef CTX_LOOP
}

__device__ __forceinline__ void up2_phase(const Args& a, int l, int lane_in, int wave, int vcu, int G) {
    const int gw = vcu * 8 + wave, NGW = G * 8;
    const bf16* A2 = (const bf16*)(a.ws + WS_A2); const bf16* W2 = w_2(a, l);
    for (int it = gw; it < NTT * NJ2; it += NGW) {
        int lane = lane_in; asm volatile("" : "+v"(lane));
        const int r = lane & 31, hi = lane >> 5, pr = pi32(r);
        const int T = it / NJ2, j = it % NJ2; const TokTile tt = tok_tile(T);
        if (j < 4) {
            const bf16* wrow0 = W2 + (size_t)(4 * j) * 24 * 512 + (hi * 32 + pr) * 8;
            const bf16* wrow2 = W2 + (size_t)(4 * j + 2) * 24 * 512 + (hi * 32 + r) * 8;
            const bf16* arow = A2 + (size_t)(tt.m0 >> 5) * 24 * 512 + (hi * 32 + r) * 8;
            f32x16 acc[3][2];
#pragma unroll
            for (int nb = 0; nb < 3; ++nb) { acc[nb][0] = (f32x16){}; acc[nb][1] = (f32x16){}; }
#pragma unroll 1
            for (int kg = 0; kg < 4; ++kg) {
                bf16x8 wf[4][3], af[4][2];
#pragma unroll
                for (int st = 0; st < 4; ++st) wf[st][0] = *(const bf16x8*)(wrow0 + (4 * kg + st) * 512);
#pragma unroll
                for (int st = 0; st < 4; ++st) wf[st][1] = *(const bf16x8*)(wrow0 + 24 * 512 + (4 * kg + st) * 512);
#pragma unroll
                for (int st = 0; st < 4; ++st) wf[st][2] = *(const bf16x8*)(wrow2 + (4 * kg + st) * 512);
#pragma unroll
                for (int st = 0; st < 4; ++st) af[st][0] = *(const bf16x8*)(arow + (4 * kg + st) * 512);
#pragma unroll
                for (int st = 0; st < 4; ++st) af[st][1] = *(const bf16x8*)(arow + 24 * 512 + (4 * kg + st) * 512);
                __builtin_amdgcn_sched_barrier(0);
#pragma unroll
                for (int st = 0; st < 4; ++st)
#pragma unroll
                    for (int nb = 0; nb < 3; ++nb) { acc[nb][0] = MFMA32(wf[st][nb], af[st][0], acc[nb][0]); acc[nb][1] = MFMA32(wf[st][nb], af[st][1], acc[nb][1]); }
            }
            const float* g = a.in[I_GMQ] + l * 96;
            f32x4 gv[12];
#pragma unroll
            for (int nb = 0; nb < 2; ++nb)
#pragma unroll
                for (int run = 0; run < 2; ++run) { const float* gp = g + 32 * nb + 16 * run + 8 * hi; gv[4 * nb + 2 * run] = *(const f32x4*)gp; gv[4 * nb + 2 * run + 1] = *(const f32x4*)(gp + 4); }
#pragma unroll
            for (int aa = 0; aa < 4; ++aa) gv[8 + aa] = *(const f32x4*)(g + 64 + 8 * aa + 4 * hi);
            __builtin_amdgcn_sched_barrier(0);
#pragma unroll
            for (int tb = 0; tb < 2; ++tb) {
                float ss = 0.f;
#pragma unroll
                for (int nb = 0; nb < 3; ++nb)
#pragma unroll
                    for (int i = 0; i < 16; ++i) ss += acc[nb][tb][i] * acc[nb][tb][i];
                ss += shx(ss, 32);
                const float rr = rsqrtf(ss * (1.f / 96.f) + EPS);
                bf16* dst = (bf16*)(a.ws + WS_QMLA) + (size_t)(tt.m0 + 32 * tb + r) * 384 + 96 * j;
#pragma unroll
                for (int nb = 0; nb < 2; ++nb)
#pragma unroll
                    for (int run = 0; run < 2; ++run) { const f32x4 g0 = gv[4 * nb + 2 * run], g1 = gv[4 * nb + 2 * run + 1]; const int b = 8 * run; const float sc = rr * C2_96;
                        u32x4 w; w.x = pk2(acc[nb][tb][b] * sc * g0.x, acc[nb][tb][b + 1] * sc * g0.y); w.y = pk2(acc[nb][tb][b + 2] * sc * g0.z, acc[nb][tb][b + 3] * sc * g0.w);
                        w.z = pk2(acc[nb][tb][b + 4] * sc * g1.x, acc[nb][tb][b + 5] * sc * g1.y); w.w = pk2(acc[nb][tb][b + 6] * sc * g1.z, acc[nb][tb][b + 7] * sc * g1.w);
                        *(u32x4*)(dst + 32 * nb + 16 * run + 8 * hi) = w; }
                float v[16];
#pragma unroll
                for (int aa = 0; aa < 4; ++aa) { v[4 * aa] = acc[2][tb][4 * aa] * rr * gv[8 + aa].x; v[4 * aa + 1] = acc[2][tb][4 * aa + 1] * rr * gv[8 + aa].y; v[4 * aa + 2] = acc[2][tb][4 * aa + 2] * rr * gv[8 + aa].z; v[4 * aa + 3] = acc[2][tb][4 * aa + 3] * rr * gv[8 + aa].w; }
                if (tt.lat) { const float tr = (float)tt.prow, tc = (float)(32 * tb + r);
#pragma unroll
                    for (int b = 0; b < 4; ++b) { const float inv = hi ? ROPE_INVR[2 * (4 + b)] : ROPE_INVR[2 * b];
                        { const float t = __builtin_amdgcn_fractf(tr * inv); const float c = __builtin_amdgcn_cosf(t), s = __builtin_amdgcn_sinf(t); const float x1 = v[b], x2 = v[4 + b]; v[b] = x1 * c - x2 * s; v[4 + b] = x1 * s + x2 * c; }
                        { const float t = __builtin_amdgcn_fractf(tc * inv); const float c = __builtin_amdgcn_cosf(t), s = __builtin_amdgcn_sinf(t); const float x1 = v[8 + b], x2 = v[12 + b]; v[8 + b] = x1 * c - x2 * s; v[12 + b] = x1 * s + x2 * c; } } }
#pragma unroll
                for (int aa = 0; aa < 4; ++aa) { u32x2 w; w.x = pk2(v[4 * aa] * C2_96, v[4 * aa + 1] * C2_96); w.y = pk2(v[4 * aa + 2] * C2_96, v[4 * aa + 3] * C2_96); *(u32x2*)(dst + 64 + 8 * aa + 4 * hi) = w; }
            }
        } else if (j < 8) {
            const int h = j - 4;
            const bf16* wrow = W2 + ((size_t)(16 + 4 * h) * 24 + 16) * 512 + (hi * 32 + pr) * 8;
            const bf16* arow = A2 + ((size_t)(tt.m0 >> 5) * 24 + 16) * 512 + (hi * 32 + r) * 8;
            f32x16 acc[2][2];
#pragma unroll
            for (int nb = 0; nb < 2; ++nb) { acc[nb][0] = (f32x16){}; acc[nb][1] = (f32x16){}; }
#pragma unroll 1
            for (int kg = 0; kg < 2; ++kg) {
                bf16x8 wf[4][2], af[4][2];
#pragma unroll
                for (int st = 0; st < 4; ++st) wf[st][0] = *(const bf16x8*)(wrow + (4 * kg + st) * 512);
#pragma unroll
                for (int st = 0; st < 4; ++st) wf[st][1] = *(const bf16x8*)(wrow + 24 * 512 + (4 * kg + st) * 512);
#pragma unroll
                for (int st = 0; st < 4; ++st) af[st][0] = *(const bf16x8*)(arow + (4 * kg + st) * 512);
#pragma unroll
                for (int st = 0; st < 4; ++st) af[st][1] = *(const bf16x8*)(arow + 24 * 512 + (4 * kg + st) * 512);
                __builtin_amdgcn_sched_barrier(0);
#pragma unroll
                for (int st = 0; st < 4; ++st)
#pragma unroll
                    for (int nb = 0; nb < 2; ++nb) { acc[nb][0] = MFMA32(wf[st][nb], af[st][0], acc[nb][0]); acc[nb][1] = MFMA32(wf[st][nb], af[st][1], acc[nb][1]); }
            }
            const float* g = a.in[I_GKN] + l * 64;
            f32x4 gv[8];
#pragma unroll
            for (int nb = 0; nb < 2; ++nb)
#pragma unroll
                for (int run = 0; run < 2; ++run) { const float* gp = g + 32 * nb + 16 * run + 8 * hi; gv[4 * nb + 2 * run] = *(const f32x4*)gp; gv[4 * nb + 2 * run + 1] = *(const f32x4*)(gp + 4); }
            __builtin_amdgcn_sched_barrier(0);
            bf16* kt = ktile_ptr(a.ws, WS_KMLA, 4, 96, tt.b, h, tt.ktile);
#pragma unroll
            for (int tb = 0; tb < 2; ++tb) {
                float ss = 0.f;
#pragma unroll
                for (int nb = 0; nb < 2; ++nb)
#pragma unroll
                    for (int i = 0; i < 16; ++i) ss += acc[nb][tb][i] * acc[nb][tb][i];
                ss += shx(ss, 32);
                const float rr = rsqrtf(ss * (1.f / 64.f) + EPS);
#pragma unroll
                for (int nb = 0; nb < 2; ++nb)
#pragma unroll
                    for (int run = 0; run < 2; ++run) { const f32x4 g0 = gv[4 * nb + 2 * run], g1 = gv[4 * nb + 2 * run + 1]; const int b = 8 * run;
                        u32x4 w; w.x = pk2(acc[nb][tb][b] * rr * g0.x, acc[nb][tb][b + 1] * rr * g0.y); w.y = pk2(acc[nb][tb][b + 2] * rr * g0.z, acc[nb][tb][b + 3] * rr * g0.w);
                        w.z = pk2(acc[nb][tb][b + 4] * rr * g1.x, acc[nb][tb][b + 5] * rr * g1.y); w.w = pk2(acc[nb][tb][b + 6] * rr * g1.z, acc[nb][tb][b + 7] * rr * g1.w);
                        *(u32x4*)(kt + (size_t)(4 * nb + 2 * run + hi) * 512 + (32 * tb + r) * 8) = w; }
            }
        } else {
            const int h = j - 8;
            const bf16* wrow = W2 + ((size_t)(16 + 4 * h + 2) * 24 + 16) * 512 + (hi * 32 + r) * 8;
            const bf16* arow = A2 + ((size_t)(tt.m0 >> 5) * 24 + 16) * 512 + (hi * 32 + pr) * 8;
            f32x16 acc[2][2];
#pragma unroll
            for (int tb = 0; tb < 2; ++tb) { acc[tb][0] = (f32x16){}; acc[tb][1] = (f32x16){}; }
#pragma unroll 1
            for (int kg = 0; kg < 2; ++kg) {
                bf16x8 wf[4][2], af[4][2];
#pragma unroll
                for (int st = 0; st < 4; ++st) wf[st][0] = *(const bf16x8*)(wrow + (4 * kg + st) * 512);
#pragma unroll
                for (int st = 0; st < 4; ++st) wf[st][1] = *(const bf16x8*)(wrow + 24 * 512 + (4 * kg + st) * 512);
#pragma unroll
                for (int st = 0; st < 4; ++st) af[st][0] = *(const bf16x8*)(arow + (4 * kg + st) * 512);
#pragma unroll
                for (int st = 0; st < 4; ++st) af[st][1] = *(const bf16x8*)(arow + 24 * 512 + (4 * kg + st) * 512);
                __builtin_amdgcn_sched_barrier(0);
#pragma unroll
                for (int st = 0; st < 4; ++st)
#pragma unroll
                    for (int tb = 0; tb < 2; ++tb) { acc[tb][0] = MFMA32(af[st][tb], wf[st][0], acc[tb][0]); acc[tb][1] = MFMA32(af[st][tb], wf[st][1], acc[tb][1]); }
            }
            bf16* vt = ktile_ptr(a.ws, WS_VMLA, 4, 64, tt.b, h, tt.ktile);
#pragma unroll
            for (int tb = 0; tb < 2; ++tb)
#pragma unroll
                for (int nb = 0; nb < 2; ++nb)
#pragma unroll
                    for (int run = 0; run < 2; ++run) { const int b = 8 * run;
                        u32x4 w; w.x = pk2(acc[tb][nb][b], acc[tb][nb][b + 1]); w.y = pk2(acc[tb][nb][b + 2], acc[tb][nb][b + 3]); w.z = pk2(acc[tb][nb][b + 4], acc[tb][nb][b + 5]); w.w = pk2(acc[tb][nb][b + 6], acc[tb][nb][b + 7]);
                        *(u32x4*)(vt + (size_t)(4 * tb + 2 * run + hi) * 512 + (32 * nb + r) * 8) = w; }
        }
    }
}

using pg8::Unit; using pg8::BM; using pg8::HALF;
struct EpiRes {
    static constexpr bool PERM = false, AFTER_DRAIN = false;
    const float* xlat; const float* xctx; float* out; const float* mod;
    __device__ __forceinline__ void operator()(const f32x4 (&acc)[2][2][4][2], const Unit& u, int wr, int wc, int fr, int fq) const {
        const int row0 = u.pm * BM + wr * 64 + fr, col0 = u.pn * BM + wc * 32 + 4 * fq;
        const int set = u.pm < 64 ? 0 : (u.pm < 128 ? 1 : 2);
        const float* base = u.pm < 128 ? xlat : xctx - (size_t)NLAT * D;
        const float* g1 = mod + set * 6144 + 2048 + col0;
        f32x4 gv[2][2];
#pragma unroll
        for (int bj = 0; bj < 2; ++bj)
#pragma unroll
            for (int n = 0; n < 2; ++n) gv[bj][n] = *(const f32x4*)(g1 + bj * HALF + n * 16);
#pragma unroll
        for (int ai = 0; ai < 2; ++ai) {
            f32x4 bv[4][2][2];
#pragma unroll
            for (int m = 0; m < 4; ++m) { const size_t ro = (size_t)(row0 + ai * HALF + m * 16) * D + col0;
#pragma unroll
                for (int bj = 0; bj < 2; ++bj)
#pragma unroll
                    for (int n = 0; n < 2; ++n) bv[m][bj][n] = *(const f32x4*)(base + ro + bj * HALF + n * 16); }
            __builtin_amdgcn_sched_barrier(0);
#pragma unroll
            for (int m = 0; m < 4; ++m) { const size_t ro = (size_t)(row0 + ai * HALF + m * 16) * D + col0;
#pragma unroll
                for (int bj = 0; bj < 2; ++bj)
#pragma unroll
                    for (int n = 0; n < 2; ++n) *(f32x4*)(out + ro + bj * HALF + n * 16) = bv[m][bj][n] + gv[bj][n] * acc[ai][bj][m][n]; }
        }
    }
};
struct EpiPTile {
    static constexpr bool PERM = true, AFTER_DRAIN = false;
    bf16* P;
    __device__ __forceinline__ void operator()(const f32x4 (&acc)[2][2][4][2], const Unit& u, int wr, int wc, int fr, int fq) const {
        const int row0 = u.pm * BM + wr * 64 + fr, col0 = u.pn * BM + wc * 32 + 8 * fq;
#pragma unroll
        for (int ai = 0; ai < 2; ++ai)
#pragma unroll
            for (int m = 0; m < 4; ++m) { const int row = row0 + ai * HALF + m * 16; bf16* tp = P + ((size_t)(row >> 6) * (NP / 8) * 64 + (row & 63)) * 8;
#pragma unroll
                for (int bj = 0; bj < 2; ++bj) { const f32x4 v0 = acc[ai][bj][m][0], v1 = acc[ai][bj][m][1];
                    u32x4 w; w.x = pk2(v0[0], v0[1]); w.y = pk2(v0[2], v0[3]); w.z = pk2(v1[0], v1[1]); w.w = pk2(v1[2], v1[3]);
                    *(u32x4*)(tp + (size_t)((col0 + bj * HALF) >> 3) * 512) = w; } }
    }
};
struct ExpertOrder {
    pg8::StaticOrder base; int ntn, pm_off, gap;
    __device__ __forceinline__ void init(int nrows, int N, int G, int c, int pm_off_ = 0, int gap_ = 0) { base.init(nrows, N, G, c); ntn = N / BM; pm_off = pm_off_; gap = gap_; }
    __device__ __forceinline__ bool next(int i, Unit& u) const { if (!base.next(i, u)) return false; u.pm += pm_off; const int e = u.pm < 256 ? ((u.pm >> 3) & 15) : (u.pm - 256); u.pn += e * ntn + (e >= GU_SPLIT_E ? gap : 0); return true; }
    __device__ __forceinline__ void a_ready(const Unit&) const {}
    __device__ __forceinline__ void done(const Unit&) const {}
};
struct ExpertGatherOrder : ExpertOrder {
    const int* srcrow;
    __device__ __forceinline__ int aoff(const Unit& u, int r) const { return srcrow[u.pm * BM + r]; }
};
}
namespace pg8 { template <> constexpr bool sched_gather_v<mk::ExpertGatherOrder> = true; }
namespace mk {
struct EpiSwiglu {
    static constexpr bool PERM = true, AFTER_DRAIN = false;
    bf16* act; bool half;
    __device__ __forceinline__ void operator()(const f32x4 (&acc)[2][2][4][2], const Unit& u, int wr, int wc, int fr, int fq) const {
        const int pnl = u.pn % 22; const int row0 = u.pm * BM + wr * 64 + fr, col0 = pnl * 128 + wc * 32 + 8 * fq;
#pragma unroll
        for (int ai = 0; ai < 2; ++ai) if (!(half && ai == 1))
#pragma unroll
            for (int m = 0; m < 4; ++m) { float r[8];
#pragma unroll
                for (int n = 0; n < 2; ++n)
#pragma unroll
                    for (int c = 0; c < 4; ++c) { const float g = acc[ai][0][m][n][c], up = acc[ai][1][m][n][c]; r[4 * n + c] = g * __builtin_amdgcn_rcpf(1.f + __builtin_amdgcn_exp2f(-g * LOG2E)) * up; }
                u32x4 w; w.x = pk2(r[0], r[1]); w.y = pk2(r[2], r[3]); w.z = pk2(r[4], r[5]); w.w = pk2(r[6], r[7]);
                { const int row = row0 + ai * HALF + m * 16;
                  *(u32x4*)(act + ((size_t)(row >> 5) * (DFF / 64) + (col0 >> 6)) * 2048 + (row & 31) * 64 + (col0 & 63)) = w; } }
    }
};
struct EpiDown {
    static constexpr bool PERM = true, AFTER_DRAIN = false;
    bf16* y; const float* gatev; bool half;
    __device__ __forceinline__ void operator()(const f32x4 (&acc)[2][2][4][2], const Unit& u, int wr, int wc, int fr, int fq) const {
        const int pnl = u.pn & 3; const int row0 = u.pm * BM + wr * 64 + fr, col0 = pnl * BM + wc * 32 + 8 * fq;
        float gtv[2][4];
#pragma unroll
        for (int ai = 0; ai < 2; ++ai)
#pragma unroll
            for (int m = 0; m < 4; ++m) gtv[ai][m] = gatev[row0 + ai * HALF + m * 16];
        __builtin_amdgcn_sched_barrier(0);
#pragma unroll
        for (int ai = 0; ai < 2; ++ai) if (!(half && ai == 1))
#pragma unroll
            for (int m = 0; m < 4; ++m) { const int row = row0 + ai * HALF + m * 16; const float gt = gtv[ai][m];
#pragma unroll
                for (int bj = 0; bj < 2; ++bj) { const f32x4 v0 = acc[ai][bj][m][0] * gt, v1 = acc[ai][bj][m][1] * gt;
                    u32x4 w; w.x = pk2(v0[0], v0[1]); w.y = pk2(v0[2], v0[3]); w.z = pk2(v1[0], v1[1]); w.w = pk2(v1[2], v1[3]);
                    *(u32x4*)(y + (size_t)row * D + col0 + bj * HALF) = w; } }
    }
};

__device__ __forceinline__ void router_phase(const Args& a, int l, LAS unsigned char* lds, int tid, int lane, int wave, int vcu, int G) {
    LAS float* Wl = (LAS float*)lds;
    LAS float* A1l = Wl + 16384;
    LAS float* biasl = A1l + 3072;
    LAS float* SHl = biasl + 64;
    const float* wr = a.in[I_WROUTER] + (size_t)l * 1024 * 16; const float* gff = a.in[I_GFFN] + l * D;
    const float* MODL = (const float*)(a.ws + WS_MOD) + (size_t)l * 3 * 6144;
    { float wv[32];
#pragma unroll
      for (int i = 0; i < 32; ++i) wv[i] = wr[tid + 512 * i];
      float ag[6], am[6], as_[6];
#pragma unroll
      for (int i = 0; i < 6; ++i) { const int idx = tid + 512 * i, set = idx >> 10, c = idx & 1023; ag[i] = gff[c]; am[i] = MODL[set * 6144 + 4096 + c]; as_[i] = MODL[set * 6144 + 3072 + c]; }
      __builtin_amdgcn_sched_barrier(0);
#pragma unroll
      for (int i = 0; i < 32; ++i) { const int idx = tid + 512 * i, c = idx >> 4, e = idx & 15; Wl[(((c >> 4) * 4 + ((c >> 2) & 3)) * 16 + e) * 4 + (c & 3)] = wv[i]; }
#pragma unroll
      for (int i = 0; i < 6; ++i) { const int idx = tid + 512 * i; A1l[idx] = ag[i] * (1.f + am[i]); SHl[idx] = as_[i]; } }
    __syncthreads();
    if (tid < 384) { const int se = tid >> 3, part = tid & 7, set = se >> 4, e = se & 15; float sacc = 0.f;
        for (int c = part * 128; c < part * 128 + 128; ++c) sacc += SHl[set * 1024 + c] * Wl[(((c >> 4) * 4 + ((c >> 2) & 3)) * 16 + e) * 4 + (c & 3)];
        sacc += shx(sacc, 1); sacc += shx(sacc, 2); sacc += shx(sacc, 4);
        if (part == 0) biasl[se] = sacc; }
    __syncthreads();
    const int ntile = ((l == 0) ? NROW : NLAT) / 16, nround = (ntile + 2 * G - 1) / (2 * G);
    const float* X1 = (const float*)(a.ws + WS_X1); bf16* H2 = (bf16*)(a.ws + WS_H2); float* AFF = (float*)(a.ws + WS_AFF);
    const int r = lane & 15, kq = lane >> 4, grp = wave >> 2, q = wave & 3;
    LAS float* PART = SHl + 3072;
    LAS float* SSP = PART + 2 * 2 * 4 * 256;
    const LAS float* wp = Wl + lane * 4 + 256 * 16 * q;
    f32x4 xa[16], xb[16];
#define RT_LOADT(dst, tI_) do { const float* xr_ = X1 + (size_t)((tI_) * 16 + r) * D + 256 * q + 4 * kq; _Pragma("unroll") for (int jj = 0; jj < 16; ++jj) dst[jj] = *(const f32x4*)(xr_ + 16 * jj); __builtin_amdgcn_sched_barrier(0); } while (0)
    int tI = vcu * 2 + grp;
    if (!PV(1)) {
    if (tI < ntile) RT_LOADT(xa, tI);
#pragma unroll 1
    for (int i = 0; i < nround; ++i) {
        const int par = i & 1; const bool act = tI < ntile; const int tN = ((i + 1) * G + vcu) * 2 + grp;
        if (i + 1 < nround && tN < ntile) RT_LOADT(xb, tN);
        const int m0 = tI * 16; const int set = act ? mset_of_row(m0) : 0;
        const LAS float* a1p = A1l + set * 1024 + 256 * q + 4 * kq;
        if (act) {
            f32x4 acc = {0.f, 0.f, 0.f, 0.f}; float ss = 0.f;
#pragma unroll
            for (int jj = 0; jj < 16; ++jj) { const f32x4 xv = xa[jj]; const f32x4 av = *(const LAS f32x4*)(a1p + 16 * jj); const f32x4 wv = *(const LAS f32x4*)(wp + 256 * jj);
                ss += (xv.x * xv.x + xv.y * xv.y) + (xv.z * xv.z + xv.w * xv.w);
                const f32x4 t = xv * av; xa[jj] = t;
                acc = __builtin_amdgcn_mfma_f32_16x16x4f32(t.x, wv.x, acc, 0, 0, 0); acc = __builtin_amdgcn_mfma_f32_16x16x4f32(t.y, wv.y, acc, 0, 0, 0);
                acc = __builtin_amdgcn_mfma_f32_16x16x4f32(t.z, wv.z, acc, 0, 0, 0); acc = __builtin_amdgcn_mfma_f32_16x16x4f32(t.w, wv.w, acc, 0, 0, 0); }
            ss += shx(ss, 16); ss += shx(ss, 32);
            *(LAS f32x4*)(PART + (((par * 2 + grp) * 4 + q) * 64 + lane) * 4) = acc;
            if (kq == 0) SSP[((par * 2 + grp) * 4 + q) * 16 + r] = ss;
        }
        __syncthreads();
        if (act) {
            const LAS float* sp = SSP + (par * 2 + grp) * 64 + r;
            const float rstd = rsqrtf(((sp[0] + sp[16]) + (sp[32] + sp[48])) * (1.f / D) + EPS);
            if (q == 0) {
                const LAS float* pp = PART + ((par * 2 + grp) * 4 * 64 + lane) * 4;
                const f32x4 acc = (*(const LAS f32x4*)(pp) + *(const LAS f32x4*)(pp + 256)) + (*(const LAS f32x4*)(pp + 512) + *(const LAS f32x4*)(pp + 768));
                const float be = biasl[set * 16 + r]; float lg[4], mx[4], se[4];
#pragma unroll
                for (int g = 0; g < 4; ++g) { lg[g] = acc[g] * shl(rstd, 4 * kq + g) + be; mx[g] = lg[g]; }
#pragma unroll
                for (int o = 1; o < 16; o <<= 1)
#pragma unroll
                    for (int g = 0; g < 4; ++g) mx[g] = fmaxf(mx[g], shx(mx[g], o));
#pragma unroll
                for (int g = 0; g < 4; ++g) { lg[g] = expf(lg[g] - mx[g]); se[g] = lg[g]; }
#pragma unroll
                for (int o = 1; o < 16; o <<= 1)
#pragma unroll
                    for (int g = 0; g < 4; ++g) se[g] += shx(se[g], o);
                f32x4 af; af.x = lg[0] / se[0]; af.y = lg[1] / se[1]; af.z = lg[2] / se[2]; af.w = lg[3] / se[3];
                size_t off;
                if (m0 < NLAT) off = ((size_t)((m0 >> 14) * 16 + r)) * SEQ + (m0 & (SEQ - 1)) + 4 * kq;
                else { const int c = m0 - NLAT; off = (size_t)2 * 16 * SEQ + ((size_t)((c >> 8) * 16 + r)) * CTXL + (c & 255) + 4 * kq; }
                *(f32x4*)(AFF + off) = af;
            }
            if (!PV(0)) {
            const LAS float* shp = SHl + set * 1024 + 256 * q + 4 * kq; bf16* hp = H2 + (size_t)(m0 + r) * D + 256 * q + 4 * kq;
#pragma unroll
            for (int jj = 0; jj < 16; ++jj) { const f32x4 h = xa[jj] * rstd + *(const LAS f32x4*)(shp + 16 * jj);
                u32x2 o; o.x = pk2(h.x, h.y); o.y = pk2(h.z, h.w); *(u32x2*)(hp + 16 * jj) = o; }
            }
        }
#pragma unroll
        for (int jj = 0; jj < 16; ++jj) xa[jj] = xb[jj];
        tI = tN;
    }
    }
#undef RT_LOADT
    __syncthreads();
}

__device__ __forceinline__ void topk_phase(const Args& a, int l, LAS unsigned char* lds, int tid, int lane, int wave, int bid, int G) {
    LAS unsigned* red = (LAS unsigned*)lds;
    LAS unsigned* cg = red + 64;
    LAS unsigned* ce = cg + 256;
    const int ngroups = (l == 0) ? 64 : 32;
    const float* AFF = (const float*)(a.ws + WS_AFF); int* SEL = (int*)(a.ws + WS_SEL); int* SRCROW = (int*)(a.ws + WS_SRCROW); float* GATEV = (float*)(a.ws + WS_GATEV);
    for (int g = bid; g < ngroups; g += G) {
        const int set4 = g >> 4, e = g & 15; const int n = set4 < 2 ? SEQ : CTXL, cap = n >> 3;
        const float* af = set4 < 2 ? AFF + (size_t)(set4 * 16 + e) * SEQ : AFF + (size_t)2 * 16 * SEQ + (size_t)((set4 - 2) * 16 + e) * CTXL;
        const int tokbase = set4 < 2 ? set4 * SEQ : NLAT + (set4 - 2) * CTXL; const int rowbase = xe_rowbase(set4, e);
        unsigned v[32];
#pragma unroll
        for (int j = 0; j < 32; ++j) { const int idx = tid + 512 * j; v[j] = idx < n ? __float_as_uint(af[idx]) : 0u; }
        unsigned T = 0u;
        for (int sft = 30; sft >= 0; sft -= 2) {
            const unsigned c1v = T | (1u << sft), c2v = T | (2u << sft), c3v = T | (3u << sft); unsigned c12 = 0, c3 = 0;
#pragma unroll
            for (int j = 0; j < 32; ++j) { c12 += (v[j] >= c1v ? 1u : 0u) + (v[j] >= c2v ? 0x10000u : 0u); c3 += (v[j] >= c3v) ? 1u : 0u; }
#pragma unroll
            for (int o = 1; o < 64; o <<= 1) { c12 += (unsigned)shx_i((int)c12, o); c3 += (unsigned)shx_i((int)c3, o); }
            LAS unsigned* rb = red + ((sft >> 1) & 1) * 16;
            if (lane == 0) { rb[wave] = c12; rb[8 + wave] = c3; }
            __syncthreads();
            unsigned t12 = 0, t3 = 0;
#pragma unroll
            for (int w = 0; w < 8; ++w) { t12 += rb[w]; t3 += rb[8 + w]; }
            const unsigned n1 = t12 & 0xffffu, n2 = t12 >> 16;
            if (t3 >= (unsigned)cap) T = c3v; else if (n2 >= (unsigned)cap) T = c2v; else if (n1 >= (unsigned)cap) T = c1v;
        }
#pragma unroll
        for (int j = 0; j < 32; ++j) { const unsigned long long mgj = __ballot(v[j] > T), mej = __ballot(v[j] == T && (tid + 512 * j) < n);
            if (lane == 0) { cg[j * 8 + wave] = (unsigned)__popcll(mgj); ce[j * 8 + wave] = (unsigned)__popcll(mej); } }
        __syncthreads();
        if (tid == 0) { unsigned sg = 0, se = 0; for (int i = 0; i < 256; ++i) { const unsigned x = cg[i], y = ce[i]; cg[i] = sg; ce[i] = se; sg += x; se += y; } red[32] = sg; }
        __syncthreads();
        const unsigned ngt = red[32]; const unsigned need_eq = (unsigned)cap - ngt;
        const unsigned long long lt = (lane == 0) ? 0ull : (~0ull >> (64 - lane));
#pragma unroll
        for (int j = 0; j < 32; ++j) { const int idx = tid + 512 * j;
            const unsigned long long mgj = __ballot(v[j] > T), mej = __ballot(v[j] == T && idx < n);
            if (idx < n) {
                const unsigned gb = cg[j * 8 + wave] + (unsigned)__popcll(mgj & lt), eb = ce[j * 8 + wave] + (unsigned)__popcll(mej & lt);
                const bool isg = v[j] > T, ise = v[j] == T; const bool selc = isg || (ise && eb < need_eq);
                const unsigned slot = gb + (eb < need_eq ? eb : need_eq);
                if (selc) { SRCROW[rowbase + slot] = tokbase + idx; GATEV[rowbase + slot] = __uint_as_float(v[j]); }
                SEL[(size_t)(tokbase + idx) * 16 + e] = selc ? (int)slot : -1;
            } }
        if (set4 == 2 && tid >= 64 && tid < 256) { SRCROW[XE_LAT + e * 256 + tid] = NLAT; GATEV[XE_LAT + e * 256 + tid] = 0.f; }
        __syncthreads();
    }
}


constexpr int NPH_LAYER = 11;
constexpr int NPHASES = 1 + 2 * NPH_LAYER + 1;
constexpr bool PER_PHASE_LAUNCH = (MK_N_LAUNCHES != 1);
#ifndef MK_PHASE_MASK
#define MK_PHASE_MASK 0xffffu
#endif
#define EN(k) (((MK_PHASE_MASK) >> (k)) & 1u)

#ifndef MK_CVS
#define MK_CVS 0, 0, 4000, 4000, 4000, 66400, 66400
#endif
__device__ __forceinline__ constexpr int CVS_AT(int s) { constexpr int t[7] = {MK_CVS}; return s <= 0 ? 0 : (s >= 8 ? CV_ALL : t[s - 1]); }
typedef const __attribute__((address_space(4))) Args* KArgPtr;
__device__ __forceinline__ Args load_args(KArgPtr p) { Args a;
#pragma unroll
    for (int i = 0; i < 30; ++i) a.in[i] = p->in[i];
    a.out = p->out; a.ws = p->ws; a.ph_lo = p->ph_lo; a.ph_hi = p->ph_hi; a.li = p->li;
#if defined(MK_PROBE_KIND) && MK_PROBE_KIND >= 0
    a.pad = p->pad;
#else
    a.pad = 0;
#endif
    return a; }
__global__ void __launch_bounds__(512, 2) mk_fwd(Args args) {
    extern __shared__ __attribute__((aligned(16))) unsigned char lds_raw[];
    LAS unsigned char* lds = (LAS unsigned char*)lds_raw;
    const int wave0 = __builtin_amdgcn_readfirstlane((int)threadIdx.x >> 6);
#define MK_TID() (wave0 * 64 + lane_now())
#define LAUNDER() KArgPtr ap_ = kap; asm volatile("" : "+s"(ap_)); const Args A = load_args(ap_); unsigned char* ws = A.ws; (void)ws; int tid = MK_TID(); const int lane = tid & 63, wave = __builtin_amdgcn_readfirstlane(tid >> 6); (void)lane; (void)wave
    const int G = gridDim.x, bid = blockIdx.x; const int vcu = (G % 8 == 0) ? (bid % 8) * (G / 8) + bid / 8 : bid;
    volatile LAS unsigned* MISC = (volatile LAS unsigned*)(lds + MISC_OFF);
    for (int u = MK_TID(); u < (LDS_BYTES - RING_BYTES) / 4; u += 512) ((LAS unsigned*)(lds + RING_BYTES))[u] = 0u;
    __syncthreads();
    KArgPtr kap = (KArgPtr)__builtin_amdgcn_kernarg_segment_ptr();
    unsigned* ctl = (unsigned*)(args.ws + WS_CTL);
    unsigned* barw = ctl + CW_BAR + args.li * XCD_BAR_WORDS;
    XcdBarrier bar; bar.bar = barw; bar.x = 0; bar.st = nullptr;
    if (!PER_PHASE_LAUNCH) bar = xcd_barrier_post(barw, MISC + 8, MK_TID() == 0);
    const int lo = args.ph_lo, hi = args.ph_hi;
#define IN(k) (lo <= (k) && (k) < hi)
#define SEAM(k) do { if (IN(k) && IN((k) + 1)) { if (PER_PHASE_LAUNCH) { if (MK_TID() == 0) __hip_atomic_store(ctl + CW_TMO, 0xBADBA0u, __ATOMIC_RELAXED, __HIP_MEMORY_SCOPE_AGENT); } else { xcd_barrier(bar, MK_TID() == 0); } } } while (0)

#define PH(kind, id, ...) do { if constexpr (EN(kind)) { if (IN(id)) { __VA_ARGS__ } } } while (0)
#define TAIL_CONV(busy_, s_) do { const int busy__ = (busy_) % G; if (bid >= busy__ && CVS_AT(s_) < CVS_AT((s_) + 1)) { __syncthreads(); conv_items(A, 1, CVS_AT(s_), CVS_AT((s_) + 1), lds, lane, wave, (bid - busy__) * 8 + wave, (G - busy__) * 8); } } while (0)
    PH(0, 0, LAUNDER(); pro_phase(A, lds, tid, bid, G); conv_items(A, 0, 0, CV_ALL, lds + 16384, lane, wave, vcu * 8 + wave, G * 8););
    SEAM(0);
#pragma unroll 1
    for (int l = 0; l < 2; ++l) {
        const int pb = 1 + NPH_LAYER * l;
        const int nrow_attn = (l == 0) ? NROW : NLAT;
        PH(1, pb + 0, LAUNDER(); modul_phase(A, l, lane, wave, vcu, G); if (l == 1) { TAIL_CONV(0, 5); });
        SEAM(pb + 0);
        PH(2, pb + 1, LAUNDER(); pg8::Gemm g{(const bf16*)(ws + WS_H), w_in(A, l), NROW, NP, D}; pg8::StaticOrder S; S.init(NROW, NP, G, bid);
            EpiPTile E{(bf16*)(ws + WS_P)};
            pg8::gemm_phase<EpiPTile, pg8::StaticOrder, true, true, false, true>(lds, g, S, E, tid);
            if (l == 0) { TAIL_CONV((NROW / 256) * (NP / 256), 0); } else { TAIL_CONV((NROW / 256) * (NP / 256), 6); });
        SEAM(pb + 1);
        PH(3, pb + 2, LAUNDER(); prep1_phase(A, l, lds, lane, wave, vcu, G););
        SEAM(pb + 2);
        PH(5, pb + 4, LAUNDER(); up2_phase(A, l, lane, wave, vcu, G););
        SEAM(pb + 4);
        PH(6, pb + 5, LAUNDER(); attn_phase(A, l, lds, tid, vcu, G););
        SEAM(pb + 5);
        PH(7, pb + 6, LAUNDER(); pg8::Gemm g{(const bf16*)(ws + WS_O), w_out(A, l), nrow_attn, D, D}; pg8::StaticOrder S; S.init(nrow_attn, D, G, bid);
            EpiRes E{l == 0 ? A.in[I_X] : (const float*)x2_of(A), l == 0 ? A.in[I_CTX] : (const float*)x2_of(A) + (size_t)NLAT * D, (float*)(ws + WS_X1), (const float*)(ws + WS_MOD) + (size_t)l * 3 * 6144};
            pg8::gemm_phase<EpiRes, pg8::StaticOrder, true, true, false, true>(lds, g, S, E, tid);
            if (l == 0) { TAIL_CONV((NROW / 256) * (D / 256), 1); });
        SEAM(pb + 6);
        PH(8, pb + 7, LAUNDER(); router_phase(A, l, lds, tid, lane, wave, vcu, G););
        SEAM(pb + 7);
        PH(9, pb + 8, LAUNDER(); topk_phase(A, l, lds, tid, lane, wave, bid, G); if (l == 0) { TAIL_CONV(64, 2); } else { TAIL_CONV(32, 7); });
        SEAM(pb + 8);
        PH(11, pb + 9, LAUNDER(); pg8::Gemm g{(const bf16*)(ws + WS_H2), w_gu(A, l), XE_LAT, 5632, D}; const int gap = l == 0 ? 0 : GU_GAP_TILES; EpiSwiglu E{(bf16*)(ws + WS_ACT), false}; EpiSwiglu Eh{(bf16*)(ws + WS_ACT), true};
            { ExpertGatherOrder S; S.init(XE_LAT, 5632, G, bid, 0, gap); S.srcrow = (const int*)(ws + WS_SRCROW);
              pg8::gemm_phase<EpiSwiglu, ExpertGatherOrder, true, true, false, true>(lds, g, S, E, tid); }
            if (l == 0) { __syncthreads(); ExpertGatherOrder S; S.init(XE_ALL - XE_LAT, 5632, G, bid, 256); S.srcrow = (const int*)(ws + WS_SRCROW);
              pg8::gemm_phase<EpiSwiglu, ExpertGatherOrder, true, true, true, true>(lds, g, S, Eh, tid);
              TAIL_CONV(((XE_ALL - XE_LAT) / 256) * 22, 3); });
        SEAM(pb + 9);
        PH(12, pb + 10, LAUNDER(); pg8::Gemm g{(const bf16*)(ws + WS_ACT), w_d(A, l), XE_LAT, D, DFF}; EpiDown E{(bf16*)(ws + WS_Y), (const float*)(ws + WS_GATEV), false}; EpiDown Eh{(bf16*)(ws + WS_Y), (const float*)(ws + WS_GATEV), true};
            { ExpertOrder S; S.init(XE_LAT, D, G, bid);
              pg8::gemm_phase<EpiDown, ExpertOrder, true, true, false, true, true>(lds, g, S, E, tid); }
            if (l == 0) { __syncthreads(); ExpertOrder S; S.init(XE_ALL - XE_LAT, D, G, bid, 256);
              pg8::gemm_phase<EpiDown, ExpertOrder, true, true, true, true, true>(lds, g, S, Eh, tid);
              TAIL_CONV(((XE_ALL - XE_LAT) / 256) * 4, 4); });
        SEAM(pb + 10);
    }
    PH(13, NPHASES - 1, LAUNDER(); final_phase(A, lane, wave, vcu, G););
#undef IN
#undef SEAM
}
}

extern "C" void kernel_launch(void* const* d_in, const int* in_sizes, int n_in, void* d_out, int out_size, void* d_ws, size_t ws_size, hipStream_t stream) {
    using namespace mk;
    static int grid = 0;
    if (grid == 0) {
        if (n_in != 30 || out_size != NLAT * D || ws_size < WS_NEED) { fprintf(stderr, "kernel_launch: unexpected shapes: n_in %d out %d ws %zu (need %zu)\n", n_in, out_size, ws_size, (size_t)WS_NEED); grid = -1; return; }
        int dev = 0, cus = 0, per_cu = 0;
        if (hipGetDevice(&dev) != hipSuccess || hipDeviceGetAttribute(&cus, hipDeviceAttributeMultiprocessorCount, dev) != hipSuccess) { grid = -1; return; }
        if (hipFuncSetAttribute((const void*)mk_fwd, hipFuncAttributeMaxDynamicSharedMemorySize, LDS_BYTES) != hipSuccess) { fprintf(stderr, "kernel_launch: hipFuncSetAttribute failed\n"); grid = -1; return; }
        if (hipOccupancyMaxActiveBlocksPerMultiprocessor(&per_cu, (const void*)mk_fwd, 512, LDS_BYTES) != hipSuccess || per_cu < 1) fprintf(stderr, "kernel_launch: occupancy query reports %d\n", per_cu);
        (void)hipGetLastError();
        grid = cus;
    }
    if (grid < 0) return;
    if (hipMemsetAsync((char*)d_ws + WS_CTL, 0, CTL_ZERO_BYTES, stream) != hipSuccess) return;
    Args a{};
    for (int i = 0; i < 30; ++i) a.in[i] = (const float*)d_in[i];
    a.out = (float*)d_out; a.ws = (unsigned char*)d_ws;
    if (PER_PHASE_LAUNCH) {
        for (int p = 0; p < NPHASES; ++p) { a.ph_lo = p; a.ph_hi = p + 1; a.li = 0; hipLaunchKernelGGL(mk_fwd, dim3(grid), dim3(512), LDS_BYTES, stream, a); }
    } else {
#if defined(MK_PROBE_KIND) && MK_PROBE_KIND >= 0
        int cuts[16]; int nc = 0; cuts[nc++] = 0;
        const int k0 = (MK_PROBE_KIND == 0) ? 0 : MK_PROBE_KIND, k1 = (MK_PROBE_KIND == 0 || MK_PROBE_KIND == 13) ? -1 : MK_PROBE_KIND + NPH_LAYER;
        const int kk0 = (MK_PROBE_KIND == 13) ? NPHASES - 1 : k0;
        int li = 0;
        auto launch = [&](int lo, int hi) { a.ph_lo = lo; a.ph_hi = hi; a.li = li++; a.pad = (hi == lo + 1 && li > 1) ? MK_PROBE_VAR : 0; hipLaunchKernelGGL(mk_fwd, dim3(grid), dim3(512), LDS_BYTES, stream, a); };
        launch(0, kk0 + 1); launch(kk0, kk0 + 1);
        if (k1 >= 0) { launch(kk0 + 1, k1 + 1); launch(k1, k1 + 1); if (k1 + 1 < NPHASES) launch(k1 + 1, NPHASES); }
        else if (kk0 + 1 < NPHASES) launch(kk0 + 1, NPHASES);
        (void)cuts; (void)nc;
#else
        a.ph_lo = 0; a.ph_hi = NPHASES; a.li = 0; hipLaunchKernelGGL(mk_fwd, dim3(grid), dim3(512), LDS_BYTES, stream, a);
#endif
    }
}
```

```cpp
#include <hip/hip_runtime.h>
#include <cstdio>
#include <cstdint>
#ifndef MK_N_LAUNCHES
#define MK_N_LAUNCHES 1
#endif
#define MK_PROBE_KIND -1
#define MK_XPROBE 0
#define MK_PROBE_VAR 0
namespace pg8 {
#define PG8_LAS __attribute__((address_space(3)))
typedef unsigned short bf16_t;
typedef short bf16x8 __attribute__((ext_vector_type(8)));
typedef float f32x4 __attribute__((ext_vector_type(4)));
typedef unsigned u32x4 __attribute__((ext_vector_type(4)));
constexpr int BM = 256, BK = 64, HALF = 128, HTB = HALF * BK * 2  , STAGE_BYTES = 8 * HTB, NXCD = 8, WGM = 8;

__host__ __device__ __forceinline__ int lds_byte(int r, int c) { const int st = (r >> 4) * 2 + (c >> 5), rr = r & 15, cc = c & 31, ob = rr * 64 + cc * 2; return st * 1024 + (ob ^ (((ob >> 9) & 1) << 5)); }
__host__ __device__ __forceinline__ void stage_rc(int b, int& R, int& C) { const int st = b / 1024, sb = b % 1024, swz = sb ^ (((sb >> 9) & 1) << 5); R = (st >> 1) * 16 + swz / 64; C = (st & 1) * 32 + (swz % 64) / 2; }
__host__ __device__ __forceinline__ int perm32(int rho) { const int n = rho >> 4, i = rho & 15; return 8 * (i >> 2) + 4 * n + (i & 3); }

struct Unit { int pm, pn; };
struct Gemm { const bf16_t* A; const bf16_t* Bt; int M, N, K; };

struct StaticOrder {
    int nM, nN, nwg, G, c;
    __host__ __device__ void init(int M, int N, int G_, int c_) { nM = M / BM; nN = N / BM; nwg = nM * nN; G = G_; c = c_; }
    __host__ __device__ bool next(int i, Unit& u) const {
        const long L = (long)i * G + c; if (L >= nwg) return false;
        int wgid = (int)L; { const int q = nwg / NXCD, r = nwg % NXCD, xcd = wgid % NXCD, off = wgid / NXCD; wgid = (xcd < r ? xcd * (q + 1) : r * (q + 1) + (xcd - r) * q) + off; }
        const int nig = WGM * nN, gid = wgid / nig, fm = gid * WGM, gsz = (nM - fm) < WGM ? (nM - fm) : WGM;
        u.pm = fm + ((wgid % nig) % gsz); u.pn = (wgid % nig) / gsz; return true;
    }
    __device__ __forceinline__ void a_ready(const Unit&) const {}
    __device__ __forceinline__ void done(const Unit&) const {}
};

__device__ __forceinline__ unsigned cvt_pk_bf16(float lo, float hi) { unsigned r; asm volatile("v_cvt_pk_bf16_f32 %0, %1, %2" : "=v"(r) : "v"(lo), "v"(hi)); return r; }
typedef float f32x2 __attribute__((ext_vector_type(2)));
__device__ __forceinline__ f32x2 gelu_pk(f32x2 v) {
    const f32x2 av = __builtin_elementwise_abs(v), d = av * 0.2316418882f + 1.0f;
    f32x2 t; t.x = __builtin_amdgcn_rcpf(d.x); t.y = __builtin_amdgcn_rcpf(d.y);
    f32x2 q = t * 0.5307027145f + (-0.7265760135f); q = q * t + 0.7107068705f; q = q * t + (-0.142248368f); q = q * t + 0.127414796f; q = q * t;
    const f32x2 s = (v * v) * (-0.72134752044f);
    f32x2 e; e.x = __builtin_amdgcn_exp2f(s.x); e.y = __builtin_amdgcn_exp2f(s.y);
    const f32x2 m = v * (q * e), r = v - m;
    f32x2 o; o.x = v.x < 0.f ? m.x : r.x; o.y = v.y < 0.f ? m.y : r.y; return o;
}

template <int ACT  > struct EpiBf16 {
    static constexpr bool PERM = true, AFTER_DRAIN = false; static_assert(ACT == 0 || ACT == 1, "EpiBf16: ACT is 0 (none) or 1 (gelu_pk)");
    bf16_t* O; int ldc; const float* bias; int split_cols; size_t split_stride; float scale0;
    __device__ __forceinline__ void operator()(const f32x4 (&acc)[2][2][4][2], const Unit& u, int wr, int wc, int fr, int fq) const {
        const int row0 = u.pm * BM + wr * 64 + fr; int colt = u.pn * BM; bf16_t* base = O;
        float sc = 1.f; if (split_cols) { const int t = colt / split_cols; base += (size_t)t * split_stride; colt -= t * split_cols; if (t == 0) sc = scale0; }
        const int col0 = colt + wc * 32 + 8 * fq, bcol0 = u.pn * BM + wc * 32 + 8 * fq;
        f32x4 bv[2][2];
#pragma unroll
        for (int bj = 0; bj < 2; ++bj)
#pragma unroll
            for (int n = 0; n < 2; ++n) bv[bj][n] = bias ? *(const f32x4*)(bias + bcol0 + bj * HALF + 4 * n) : (f32x4){0.f, 0.f, 0.f, 0.f};
#pragma unroll
        for (int ai = 0; ai < 2; ++ai)
#pragma unroll
            for (int m = 0; m < 4; ++m) { bf16_t* rowp = base + (size_t)(row0 + ai * HALF + m * 16) * ldc + col0;
#pragma unroll
                for (int bj = 0; bj < 2; ++bj) { f32x4 v0 = acc[ai][bj][m][0] + bv[bj][0], v1 = acc[ai][bj][m][1] + bv[bj][1];
                    if (ACT == 1) { f32x2 a = gelu_pk((f32x2){v0[0], v0[1]}), b = gelu_pk((f32x2){v0[2], v0[3]}), c = gelu_pk((f32x2){v1[0], v1[1]}), d = gelu_pk((f32x2){v1[2], v1[3]});
                        v0 = (f32x4){a.x, a.y, b.x, b.y}; v1 = (f32x4){c.x, c.y, d.x, d.y}; }
                    v0 = v0 * sc; v1 = v1 * sc; u32x4 w; w.x = cvt_pk_bf16(v0[0], v0[1]); w.y = cvt_pk_bf16(v0[2], v0[3]); w.z = cvt_pk_bf16(v1[0], v1[1]); w.w = cvt_pk_bf16(v1[2], v1[3]);
                    *(u32x4*)(rowp + bj * HALF) = w; } }
    }
};
template <class S> constexpr bool sched_gather_v = false;
template <class Epi, class Sched, bool ALIGN_EPI = false, bool SP2 = false, bool HALF_ROWS = false, bool BTILED = false, bool ATILED = false>
__device__ __forceinline__ void gemm_phase(PG8_LAS unsigned char* lds, const Gemm g, const Sched& S, const Epi& E, int tid_in) {
    int tid_l = tid_in; asm volatile("" : "+v"(tid_l));
    const int tid = tid_l, wid = __builtin_amdgcn_readfirstlane(tid >> 6), lane = tid & 63, wr = wid >> 2, wc = wid & 3, fr = lane & 15, fq = lane >> 4;
    const int K = g.K, nt = K / BK;
    unsigned voffA[2], voffB[2];
#pragma unroll
    for (int i = 0; i < 2; ++i) { int R, C; stage_rc(tid * 16 + i * 8192, R, C); const int Rb = Epi::PERM ? ((R & ~31) + perm32(R & 31)) : R;
        voffA[i] = ATILED ? (unsigned)((R >> 5) * (K / 64) * 2048 + (R & 31) * 64 + C) * 2u : (unsigned)(R * K + C) * 2u; voffB[i] = BTILED ? (unsigned)((Rb >> 5) * (K / 64) * 2048 + (Rb & 31) * 64 + C) * 2u : (unsigned)(Rb * K + C) * 2u; }
    const size_t kstep = (size_t)(BK * 2);
    const size_t kstepA = ATILED ? (size_t)4096 : kstep;
    const size_t kstepB = BTILED ? (size_t)4096 : kstep;
    const size_t hstep = (size_t)HALF * K * 2;
    const size_t tstep = 2 * hstep;
    constexpr bool GATHER = sched_gather_v<Sched>;
    const size_t hstepA = GATHER ? (size_t)0 : hstep;
    const unsigned ldsw = (unsigned)wid * 1024u;
    const int aoff = lds_byte(wr * 64 + fr, fq * 8), boff = lds_byte(wc * 32 + fr, fq * 8);
#define PG8_SA(b, h) (((b) * 2 + (h)) * HTB)
#define PG8_SB(b, h) ((4 + (b) * 2 + (h)) * HTB)
#define PG8_STAGE(bufoff, gbase, voff) do { _Pragma("unroll") for (int _i = 0; _i < 2; ++_i) \
        __builtin_amdgcn_global_load_lds((const unsigned*)((const char*)(gbase) + (voff)[_i]), (PG8_LAS unsigned*)(lds + (bufoff) + ldsw + _i * 8192), 16, 0, 0); } while (0)
#define PG8_LDA(dst, b, h) do { _Pragma("unroll") for (int m = 0; m < 4; ++m) _Pragma("unroll") for (int k = 0; k < 2; ++k) dst[m][k] = *(const PG8_LAS bf16x8*)(lds + PG8_SA(b, h) + aoff + m * 2048 + k * 1024); } while (0)
#define PG8_LDB(dst, b, h) do { _Pragma("unroll") for (int n = 0; n < 2; ++n) _Pragma("unroll") for (int k = 0; k < 2; ++k) dst[n][k] = *(const PG8_LAS bf16x8*)(lds + PG8_SB(b, h) + boff + n * 2048 + k * 1024); } while (0)
#define PG8_MMA(ai, bj, At, Bt) do { __builtin_amdgcn_s_setprio(1); _Pragma("unroll") for (int m = 0; m < 4; ++m) _Pragma("unroll") for (int n = 0; n < 2; ++n) _Pragma("unroll") for (int k = 0; k < 2; ++k) \
        acc[ai][bj][m][n] = __builtin_amdgcn_mfma_f32_16x16x32_bf16(Bt[n][k], At[m][k], acc[ai][bj][m][n], 0, 0, 0); __builtin_amdgcn_s_setprio(0); } while (0)
#define PG8_WAIT_V(n) asm volatile("s_waitcnt vmcnt(" #n ")" ::: "memory")
#define PG8_WAIT_L(n) asm volatile("s_waitcnt lgkmcnt(" #n ")" ::: "memory")
#define PG8_BAR __builtin_amdgcn_s_barrier()
#define PG8_SCHED __builtin_amdgcn_sched_barrier(0)
    Unit cur, nxt; int ui = 0;
    if (!S.next(0, cur)) return;
    f32x4 acc[2][2][4][2];
#pragma unroll
    for (int a = 0; a < 2; ++a)
#pragma unroll
        for (int b = 0; b < 2; ++b)
#pragma unroll
            for (int m = 0; m < 4; ++m)
#pragma unroll
                for (int n = 0; n < 2; ++n) acc[a][b][m][n] = (f32x4){0.f, 0.f, 0.f, 0.f};
    bf16x8 At[4][2], B0[2][2], B1[2][2];
    const char* cA = GATHER ? (const char*)g.A : (const char*)g.A + (size_t)cur.pm * tstep; const char* cB = (const char*)g.Bt + (size_t)cur.pn * tstep;
    unsigned vA[2][2], nvA[2][2];
#define PG8_AOFF(dst, u) do { _Pragma("unroll") for (int _h = 0; _h < 2; ++_h) _Pragma("unroll") for (int _i = 0; _i < 2; ++_i) { \
        if constexpr (GATHER) { int R_, C_; stage_rc(tid * 16 + _i * 8192, R_, C_); dst[_h][_i] = (unsigned)S.aoff(u, _h * HALF + R_) * (unsigned)(K * 2) + (unsigned)(C_ * 2); } else dst[_h][_i] = voffA[_i]; } } while (0)
    PG8_AOFF(vA, cur);
#pragma unroll
    for (int _h = 0; _h < 2; ++_h)
#pragma unroll
        for (int _i = 0; _i < 2; ++_i) nvA[_h][_i] = vA[_h][_i];
    S.a_ready(cur);
    if constexpr (SP2) {
        PG8_STAGE(PG8_SB(0, 0), cB, voffB); PG8_STAGE(PG8_SB(0, 1), cB + hstep, voffB); PG8_STAGE(PG8_SA(0, 0), cA, vA[0]); PG8_STAGE(PG8_SA(0, 1), cA + hstepA, vA[1]);
        if (wr == 1) PG8_BAR;
        PG8_WAIT_V(2); PG8_BAR;
        PG8_STAGE(PG8_SB(1, 0), cB + kstepB, voffB); PG8_STAGE(PG8_SA(1, 0), cA + kstepA, vA[0]); PG8_STAGE(PG8_SB(1, 1), cB + hstep + kstepB, voffB);
        PG8_WAIT_V(6); PG8_BAR;
    } else {
        PG8_STAGE(PG8_SB(0, 0), cB, voffB); PG8_STAGE(PG8_SA(0, 0), cA, vA[0]); PG8_STAGE(PG8_SB(0, 1), cB + hstep, voffB); PG8_STAGE(PG8_SA(0, 1), cA + hstepA, vA[1]);
        if (wr == 1) PG8_BAR;
        PG8_WAIT_V(4); PG8_BAR;
        PG8_STAGE(PG8_SB(1, 0), cB + kstepB, voffB); PG8_STAGE(PG8_SA(1, 0), cA + kstepA, vA[0]); PG8_STAGE(PG8_SB(1, 1), cB + hstep + kstepB, voffB);
        PG8_WAIT_V(6); PG8_BAR;
    }
    for (;;) {
        const bool has_next = S.next(ui + 1, nxt);
        const char* nA = (has_next && !GATHER) ? (const char*)g.A + (size_t)nxt.pm * tstep : cA;
        if constexpr (GATHER) { if (has_next) PG8_AOFF(nvA, nxt); } const char* nB = has_next ? (const char*)g.Bt + (size_t)nxt.pn * tstep : cB;
#pragma unroll 1
        for (int t = 0; t < nt; t += 2) {
            const bool last = (t == nt - 2);
            const char* a1 = cA + (size_t)(t + 1) * kstepA;
            const char* a2 = last ? nA : cA + (size_t)(t + 2) * kstepA; const char* b2 = last ? nB : cB + (size_t)(t + 2) * kstepB;
            const char* a3 = a2 + kstepA; const char* b3 = b2 + kstepB;
            unsigned sA0[2], sA1[2]; sA0[0] = last ? nvA[0][0] : vA[0][0]; sA0[1] = last ? nvA[0][1] : vA[0][1]; sA1[0] = last ? nvA[1][0] : vA[1][0]; sA1[1] = last ? nvA[1][1] : vA[1][1];
            if (last && has_next) S.a_ready(nxt);
            if constexpr (SP2) {
            PG8_LDB(B0, 0, 0); PG8_LDB(B1, 0, 1); PG8_SCHED; PG8_LDA(At, 0, 0); PG8_STAGE(PG8_SA(1, 1), a1 + hstepA, vA[1]);
            PG8_WAIT_V(8); PG8_WAIT_L(0); PG8_BAR; if (!HALF_ROWS || wr == 0) { PG8_MMA(0, 0, At, B0); PG8_MMA(0, 1, At, B1); } PG8_BAR; PG8_SCHED;
            PG8_LDA(At, 0, 1); PG8_STAGE(PG8_SB(0, 0), b2, voffB); PG8_STAGE(PG8_SB(0, 1), b2 + hstep, voffB); PG8_STAGE(PG8_SA(0, 0), a2, sA0);
            PG8_WAIT_V(8); PG8_WAIT_L(0); PG8_BAR; if constexpr (!HALF_ROWS) { PG8_MMA(1, 0, At, B0); PG8_MMA(1, 1, At, B1); } PG8_BAR; PG8_SCHED;
            PG8_LDB(B0, 1, 0); PG8_LDB(B1, 1, 1); PG8_SCHED; PG8_LDA(At, 1, 0); PG8_STAGE(PG8_SA(0, 1), a2 + hstepA, sA1);
            PG8_WAIT_V(8); PG8_WAIT_L(0); PG8_BAR; if (!HALF_ROWS || wr == 0) { PG8_MMA(0, 0, At, B0); PG8_MMA(0, 1, At, B1); } PG8_BAR; PG8_SCHED;
            PG8_LDA(At, 1, 1); PG8_STAGE(PG8_SB(1, 0), b3, voffB); PG8_STAGE(PG8_SB(1, 1), b3 + hstep, voffB); PG8_STAGE(PG8_SA(1, 0), a3, sA0);
            PG8_WAIT_V(8); PG8_WAIT_L(0); PG8_BAR; if constexpr (!HALF_ROWS) { PG8_MMA(1, 0, At, B0); PG8_MMA(1, 1, At, B1); } PG8_BAR; PG8_SCHED;
            } else {
            PG8_LDB(B0, 0, 0); PG8_SCHED; PG8_LDA(At, 0, 0); PG8_STAGE(PG8_SA(1, 1), a1 + hstepA, vA[1]);
            PG8_WAIT_L(8); PG8_BAR; PG8_WAIT_L(0); PG8_MMA(0, 0, At, B0); PG8_BAR; PG8_SCHED;
            PG8_LDB(B1, 0, 1); PG8_STAGE(PG8_SB(0, 0), b2, voffB);
            PG8_BAR; PG8_WAIT_L(0); PG8_MMA(0, 1, At, B1); PG8_BAR;
            PG8_LDA(At, 0, 1); PG8_STAGE(PG8_SA(0, 0), a2, sA0);
            PG8_BAR; PG8_WAIT_L(0); PG8_MMA(1, 0, At, B0); PG8_BAR; PG8_SCHED;
            PG8_STAGE(PG8_SB(0, 1), b2 + hstep, voffB);
            PG8_WAIT_V(6); PG8_BAR; PG8_MMA(1, 1, At, B1); PG8_BAR;
            PG8_LDB(B0, 1, 0); PG8_SCHED; PG8_LDA(At, 1, 0); PG8_STAGE(PG8_SA(0, 1), a2 + hstepA, sA1);
            PG8_WAIT_L(8); PG8_BAR; PG8_WAIT_L(0); PG8_MMA(0, 0, At, B0); PG8_BAR; PG8_SCHED;
            PG8_LDB(B1, 1, 1); PG8_STAGE(PG8_SB(1, 0), b3, voffB);
            PG8_BAR; PG8_WAIT_L(0); PG8_MMA(0, 1, At, B1); PG8_BAR;
            PG8_LDA(At, 1, 1); PG8_STAGE(PG8_SA(1, 0), a3, sA0);
            PG8_BAR; PG8_WAIT_L(0); PG8_MMA(1, 0, At, B0); PG8_BAR; PG8_SCHED;
            PG8_STAGE(PG8_SB(1, 1), b3 + hstep, voffB);
            PG8_WAIT_V(6); PG8_BAR; PG8_MMA(1, 1, At, B1); PG8_BAR;
            }
        }
        if constexpr (ALIGN_EPI) { if (wr == 0) PG8_BAR; }
        if constexpr (!Epi::AFTER_DRAIN) { E(acc, cur, wr, wc, fr, fq); S.done(cur); }
        if (!has_next) break;
#pragma unroll
        for (int a = 0; a < 2; ++a)
#pragma unroll
            for (int b = 0; b < 2; ++b)
#pragma unroll
                for (int m = 0; m < 4; ++m)
#pragma unroll
                    for (int n = 0; n < 2; ++n) acc[a][b][m][n] = (f32x4){0.f, 0.f, 0.f, 0.f};
        cur = nxt; cA = nA; cB = nB; ++ui;
#pragma unroll
        for (int _h = 0; _h < 2; ++_h) { vA[_h][0] = nvA[_h][0]; vA[_h][1] = nvA[_h][1]; }
        if constexpr (ALIGN_EPI) { if (wr == 1) PG8_BAR; }
    }
    PG8_WAIT_V(0);
    if constexpr (!ALIGN_EPI) { if (wr == 0) PG8_BAR; }
    PG8_BAR;
    if constexpr (Epi::AFTER_DRAIN) { E.fused(acc, cur, wr, wc, fr, fq, lds, wid, lane); S.done(cur); }
#undef PG8_AOFF
#undef PG8_SA
#undef PG8_SB
#undef PG8_STAGE
#undef PG8_LDA
#undef PG8_LDB
#undef PG8_MMA
#undef PG8_WAIT_V
#undef PG8_WAIT_L
#undef PG8_BAR
#undef PG8_SCHED
}
}

namespace mk {
typedef unsigned short bf16;
typedef short bf16x8 __attribute__((ext_vector_type(8)));
typedef float f32x4 __attribute__((ext_vector_type(4)));
typedef float f32x16 __attribute__((ext_vector_type(16)));
typedef unsigned u32x4 __attribute__((ext_vector_type(4)));
typedef unsigned u32x2 __attribute__((ext_vector_type(2)));
#define LAS __attribute__((address_space(3)))
#define GAS __attribute__((address_space(1)))

constexpr int D = 1024, NB = 2, SEQ = 16384, CTXL = 256;
constexpr int NLAT = NB * SEQ, NCTX = NB * CTXL, NROW = NLAT + NCTX;
constexpr int NP = 2560;
constexpr int NTILE = 260;
constexpr int DFF = 2816, NE = 16;
constexpr int XE_LAT = 65536, XE_ALL = 69632;
constexpr float EPS = 1e-6f;
constexpr float LOG2E = 1.4426950408889634f;

constexpr size_t MiB = (size_t)1 << 20;
constexpr size_t WS_CTL = 0, CTL_ZERO_BYTES = 1 * MiB;
constexpr size_t WS_MOD = 1 * MiB;
constexpr size_t WS_LAM = WS_MOD + 160 * 1024;
constexpr size_t WS_ROPE = WS_MOD + 256 * 1024;
constexpr size_t WS_WIN = 2 * MiB, WS_W2 = 7 * MiB, WS_WOUT = 8 * MiB, WS_WGU = 16 * MiB, WS_WD = 192 * MiB;
constexpr size_t WS_X1 = 280 * MiB, WS_X2 = 410 * MiB, WS_H2 = 540 * MiB, WS_Y = 605 * MiB;
constexpr size_t WS_AFF = 741 * MiB, WS_SEL = 744 * MiB, WS_SRCROW = 747 * MiB, WS_GATEV = 747 * MiB + 512 * 1024;
constexpr size_t WS_H = 748 * MiB, WS_P = 813 * MiB, WS_A2 = 976 * MiB, WS_U = 1001 * MiB;
constexpr size_t WS_QNA = 1066 * MiB, WS_QMLA = 1083 * MiB, WS_QDIFF = 1108 * MiB, WS_QGQA = 1125 * MiB;
constexpr size_t WS_KNA = 1142 * MiB, WS_KMLA = 1159 * MiB, WS_KDIFF = 1184 * MiB, WS_KGQA = 1201 * MiB;
constexpr size_t WS_VNA = 1210 * MiB, WS_VMLA = 1227 * MiB, WS_VDIFF = 1244 * MiB, WS_VGQA = 1261 * MiB;
constexpr size_t WS_O = 1270 * MiB;
constexpr size_t WS_XE = 748 * MiB, WS_ACT = 884 * MiB;
constexpr size_t WS_END = 1336 * MiB;
constexpr size_t WS_X2B = 16 * MiB, WS_WGU1 = 410 * MiB, WS_WGU1B = 1345 * MiB, WS_NEED = 1400 * MiB;
constexpr int GU_SPLIT_E = 11, GU_GAP_TILES = (int)((WS_WGU1B - WS_WGU1 - (size_t)GU_SPLIT_E * 11 * MiB) / (512 * 1024));
static_assert(GU_GAP_TILES % 22 == 0 && GU_GAP_TILES > 0, "gate/up split");
constexpr size_t OUT_WD1 = 0, OUT_WIN1 = 88 * MiB, OUT_W21 = 93 * MiB, OUT_WOUT1 = 94 * MiB;
static_assert(WS_ACT + (size_t)XE_ALL * DFF * 2 <= WS_O + (size_t)NROW * D * 2 && WS_O + (size_t)NROW * D * 2 <= WS_END, "ws map");
static_assert(WS_XE + (size_t)XE_ALL * D * 2 <= WS_ACT && WS_P + (size_t)NROW * NP * 2 <= WS_A2 && WS_Y + (size_t)XE_ALL * D * 2 <= WS_AFF, "ws map");

constexpr int CW_TMO = 0, CW_BAR = 4096;

constexpr int RING_BYTES = 131072;
constexpr int MISC_OFF = RING_BYTES + 320;
constexpr int LDS_BYTES = 147456;

struct Args { const float* in[30]; float* out; unsigned char* ws; int ph_lo, ph_hi, li, pad; };
enum { I_X = 0, I_C, I_CTX, I_CCTX, I_WMOD, I_BMOD, I_GATTN, I_GFFN, I_WIN, I_GNAQ, I_GNAK, I_RPB, I_GCQ, I_WUQ, I_GMQ, I_GCKV, I_WUKV, I_GKN, I_GKR,
       I_GDQ, I_GDK, I_DLAM, I_GDSUB, I_GGQ, I_GGK, I_WOUT, I_WROUTER, I_WGATE, I_WUP, I_WDOWN };

__device__ __forceinline__ bf16* w_in(const Args& a, int l) { return (bf16*)(l == 0 ? a.ws + WS_WIN : (unsigned char*)a.out + OUT_WIN1); }
__device__ __forceinline__ bf16* w_2(const Args& a, int l) { return (bf16*)(l == 0 ? a.ws + WS_W2 : (unsigned char*)a.out + OUT_W21); }
__device__ __forceinline__ bf16* w_out(const Args& a, int l) { return (bf16*)(l == 0 ? a.ws + WS_WOUT : (unsigned char*)a.out + OUT_WOUT1); }
__device__ __forceinline__ bf16* w_gu(const Args& a, int l) { return (bf16*)(a.ws + (l == 0 ? WS_WGU : WS_WGU1)); }
__device__ __forceinline__ bf16* w_d(const Args& a, int l) { return (bf16*)(l == 0 ? a.ws + WS_WD : (unsigned char*)a.out + OUT_WD1); }
__device__ __forceinline__ float* x2_of(const Args& a) { return (float*)(a.ws + WS_X2B); }
#if defined(MK_PROBE_KIND) && MK_PROBE_KIND >= 0
#define PV(bit) ((a.pad >> (bit)) & 1)
#else
#define PV(bit) 0
#endif
__device__ __forceinline__ float bf2f(unsigned short h) { return __uint_as_float((unsigned)h << 16); }
typedef float f32x2_t __attribute__((ext_vector_type(2))); typedef __bf16 bf16x2_t __attribute__((ext_vector_type(2)));
__device__ __forceinline__ unsigned pk2(float lo, float hi) { f32x2_t v = {lo, hi}; bf16x2_t b = __builtin_convertvector(v, bf16x2_t); return __builtin_bit_cast(unsigned, b); }
__device__ __forceinline__ int lane_now() { int l; asm volatile("v_mbcnt_lo_u32_b32 %0, -1, 0\n\tv_mbcnt_hi_u32_b32 %0, -1, %0" : "=v"(l)); return l; }
__device__ __forceinline__ int shx_i(int v, int m) { return __builtin_amdgcn_ds_bpermute((lane_now() ^ m) << 2, v); }
__device__ __forceinline__ float shx(float v, int m) { return __int_as_float(shx_i(__float_as_int(v), m)); }
__device__ __forceinline__ float shl(float v, int src_lane) { return __int_as_float(__builtin_amdgcn_ds_bpermute(src_lane << 2, __float_as_int(v))); }
__device__ __forceinline__ float wave_sum(float v) {
#pragma unroll
    for (int o = 1; o < 64; o <<= 1) v += shx(v, o);
    return v;
}
__device__ __forceinline__ int mset_of_row(int m) { return m < SEQ ? 0 : (m < NLAT ? 1 : 2); }
#define LDS_WAIT() asm volatile("s_waitcnt lgkmcnt(0)" ::: "memory")
#define VM_WAIT() asm volatile("s_waitcnt vmcnt(0)" ::: "memory")

__device__ __forceinline__ void pro_phase(const Args& a, LAS unsigned char* lds, int tid, int bid, int G) {
    LAS float* sc = (LAS float*)lds;
    LAS float* part = sc + 3 * 1024;
    float* MOD = (float*)(a.ws + WS_MOD);
    for (int u = bid; u < 96; u += G) {
        const int l = u / 48, cb = (u % 48) * 128;
        for (int i = tid; i < 3 * 1024; i += 512) { const int s = i >> 10, k = i & 1023; const float cv = s < 2 ? a.in[I_C][s * 1024 + k] : a.in[I_CCTX][k]; sc[i] = cv / (1.f + expf(-cv)); }
        __syncthreads();
        const int col = tid & 127, kq = tid >> 7;
        const float* w = a.in[I_WMOD] + (size_t)l * 1024 * 6144 + cb + col;
        float a0 = 0.f, a1 = 0.f, a2 = 0.f;
#pragma unroll 1
        for (int k0 = kq * 256; k0 < kq * 256 + 256; k0 += 32) {
            float wv[32];
#pragma unroll
            for (int i = 0; i < 32; ++i) wv[i] = w[(size_t)(k0 + i) * 6144];
            __builtin_amdgcn_sched_barrier(0);
#pragma unroll
            for (int i = 0; i < 32; ++i) { a0 += sc[k0 + i] * wv[i]; a1 += sc[1024 + k0 + i] * wv[i]; a2 += sc[2048 + k0 + i] * wv[i]; }
        }
        part[(kq * 3 + 0) * 128 + col] = a0; part[(kq * 3 + 1) * 128 + col] = a1; part[(kq * 3 + 2) * 128 + col] = a2;
        __syncthreads();
        if (tid < 384) { const int s = tid >> 7, c = tid & 127;
            const float r = ((part[(0 * 3 + s) * 128 + c] + part[(1 * 3 + s) * 128 + c]) + (part[(2 * 3 + s) * 128 + c] + part[(3 * 3 + s) * 128 + c])) + a.in[I_BMOD][l * 6144 + cb + c];
            MOD[(l * 3 + s) * 6144 + cb + c] = r; }
        __syncthreads();
    }
    if (bid == 0 && tid < 2) {
        const float* lp = a.in[I_DLAM] + tid * 128; float s0 = 0.f, s1 = 0.f;
        for (int i = 0; i < 32; ++i) { s0 += lp[i] * lp[32 + i]; s1 += lp[64 + i] * lp[96 + i]; }
        const float lam_init = 0.8f - 0.6f * expf(-0.3f * (float)tid);
        ((float*)(a.ws + WS_LAM))[2 * tid] = expf(s0) - expf(s1) + lam_init; ((float*)(a.ws + WS_LAM))[2 * tid + 1] = 1.f - lam_init;
    }
}

__device__ __forceinline__ void conv_item(const float* src, size_t sld, bf16* dst, size_t dld, bool zero, LAS float* scr, int lane) {
    const int c = lane & 7;
    if (zero) {
#pragma unroll
        for (int j = 0; j < 4; ++j) { const int n = (lane >> 3) + 8 * j; *(u32x4*)(dst + (size_t)n * dld + 8 * c) = (u32x4){0u, 0u, 0u, 0u}; }
        return;
    }
    f32x4 v[8];
#pragma unroll
    for (int i = 0; i < 8; ++i) { const int kk = 8 * i + (lane >> 3), c4 = 4 * (lane & 7); v[i] = *(const f32x4*)(src + (size_t)kk * sld + c4); }
    __builtin_amdgcn_sched_barrier(0);
#pragma unroll
    for (int i = 0; i < 8; ++i) { const int kk = 8 * i + (lane >> 3), c4 = 4 * (lane & 7); LAS float* d = scr + kk * 33 + c4; d[0] = v[i].x; d[1] = v[i].y; d[2] = v[i].z; d[3] = v[i].w; }
    LDS_WAIT(); asm volatile("" ::: "memory");
#pragma unroll
    for (int j = 0; j < 4; ++j) { const int n = (lane >> 3) + 8 * j; const LAS float* s = scr + (8 * c) * 33 + n;
        u32x4 o; o.x = pk2(s[0 * 33], s[1 * 33]); o.y = pk2(s[2 * 33], s[3 * 33]); o.z = pk2(s[4 * 33], s[5 * 33]); o.w = pk2(s[6 * 33], s[7 * 33]);
        *(u32x4*)(dst + (size_t)n * dld + 8 * c) = o; }
    LDS_WAIT(); asm volatile("" ::: "memory");
}
constexpr int CV_WIN = 1280, CV_WOUT = 512, CV_W2 = 1024, CV_GU = 16 * 2816, CV_D = 16 * 1408, CV_ALL = CV_WIN + CV_WOUT + CV_W2 + CV_GU + CV_D;
__device__ __forceinline__ void conv_items(const Args& a, int l, int lo, int hi, LAS unsigned char* lds, int lane, int wave, int gw, int NGW) {
    LAS float* scr = (LAS float*)(lds + wave * 8704);
    bf16* WIN = w_in(a, l); bf16* W2 = w_2(a, l); bf16* WOUT = w_out(a, l); bf16* WGU = w_gu(a, l); bf16* WD = w_d(a, l);
    for (int it0 = lo + gw; it0 < hi; it0 += NGW) {
        int it = it0;
        if (it < CV_WIN) { const int kb = it / 80, nb = it % 80, n0 = 32 * nb, k0 = 64 * kb; const bool zero = n0 >= 2464;
            const int sc = n0 < 1152 ? n0 : (n0 < 2432 ? n0 + 32 : n0 - 2432 + 1152);
            conv_item(a.in[I_WIN] + (size_t)l * 1024 * 2464 + (size_t)k0 * 2464 + (zero ? 0 : sc), 2464, WIN + ((size_t)(n0 >> 5) * 16 + kb) * 2048, 64, zero, scr, lane); continue; }
        it -= CV_WIN;
        if (it < CV_WOUT) { const int kb = it / 32, nb = it % 32, n0 = 32 * nb, k0 = 64 * kb;
            conv_item(a.in[I_WOUT] + (size_t)l * 1024 * 1024 + (size_t)k0 * 1024 + n0, 1024, WOUT + ((size_t)(n0 >> 5) * 16 + kb) * 2048, 64, false, scr, lane); continue; }
        it -= CV_WOUT;
        if (it < CV_W2) { const int n = it;
#pragma unroll
            for (int i = 0; i < 6; ++i) { const int k = lane + 64 * i; float v = 0.f;
                if (n < 512) { const int h = n >> 7, j = n & 127; if (j < 96 && k < 256) v = a.in[I_WUQ][(size_t)l * 256 * 384 + (size_t)k * 384 + 96 * h + j] * a.in[I_GCQ][l * 256 + k]; }
                else { if (k >= 256) v = a.in[I_WUKV][(size_t)l * 128 * 512 + (size_t)(k - 256) * 512 + (n - 512)] * a.in[I_GCKV][l * 128 + (k - 256)]; }
                W2[((((size_t)(n >> 5) * 24 + (k >> 4)) * 64) + ((k >> 3) & 1) * 32 + (n & 31)) * 8 + (k & 7)] = (bf16)(pk2(v, 0.f) & 0xffffu); }
            continue; }
        it -= CV_W2;
        if (it < CV_GU) { const int e = it / 2816, r = it % 2816, kb = r / 176, nb = r % 176, n0 = 32 * nb, k0 = 64 * kb, pn = n0 >> 8, half = (n0 >> 7) & 1, j0 = n0 & 127;
            const float* src = (half ? a.in[I_WUP] : a.in[I_WGATE]) + ((size_t)(l * 16 + e) * 1024 + k0) * 2816 + 128 * pn + j0;
            const size_t gap = (l == 1 && e >= GU_SPLIT_E) ? (size_t)GU_GAP_TILES * 256 * 1024 : 0;
            conv_item(src, 2816, WGU + ((size_t)((e * 5632 + n0) >> 5) * 16 + kb) * 2048 + gap, 64, false, scr, lane); continue; }
        it -= CV_GU;
        { const int e = it / 1408, r = it % 1408, kb = r / 32, nb = r % 32, n0 = 32 * nb, k0 = 64 * kb;
            conv_item(a.in[I_WDOWN] + ((size_t)(l * 16 + e) * 2816 + k0) * 1024 + n0, 1024, WD + ((size_t)((e * 1024 + n0) >> 5) * 44 + kb) * 2048, 64, false, scr, lane); }
    }
}

__device__ __forceinline__ int xe_rowbase(int set4, int e) { return set4 < 2 ? (set4 * 16 + e) * 2048 : XE_LAT + e * 256 + (set4 - 2) * 32; }
__device__ __forceinline__ void combine_row(const Args& a, int l, int m, int lane, f32x4 (&v)[4], const f32x4 (&g2)[4]) {
    const float* X1 = (const float*)(a.ws + WS_X1); const bf16* Y = (const bf16*)(a.ws + WS_Y); const int* SEL = (const int*)(a.ws + WS_SEL);
    const int set4 = m < SEQ ? 0 : (m < NLAT ? 1 : (m < NLAT + CTXL ? 2 : 3));
    f32x4 s[4];
#pragma unroll
    for (int j = 0; j < 4; ++j) s[j] = (f32x4){0.f, 0.f, 0.f, 0.f};
    f32x4 xr[4];
#pragma unroll
    for (int j = 0; j < 4; ++j) xr[j] = *(const f32x4*)(X1 + (size_t)m * D + 4 * lane + 256 * j);
#define ACC_Y(w_) do { _Pragma("unroll") for (int j = 0; j < 4; ++j) { s[j].x += __uint_as_float(w_[j].x << 16); s[j].y += __uint_as_float(w_[j].x & 0xffff0000u); s[j].z += __uint_as_float(w_[j].y << 16); s[j].w += __uint_as_float(w_[j].y & 0xffff0000u); } } while (0)
    const int myslot = (lane < 16) ? SEL[(size_t)m * 16 + lane] : -1;
    unsigned mask = (unsigned)__ballot(myslot >= 0);
    while (mask) {
        const int ea = __builtin_ctz(mask); mask &= mask - 1u;
        const bf16* ya = Y + (size_t)(xe_rowbase(set4, ea) + __builtin_amdgcn_readlane(myslot, ea)) * D + 4 * lane;
        u32x2 wa[4];
#pragma unroll
        for (int j = 0; j < 4; ++j) wa[j] = *(const u32x2*)(ya + 256 * j);
        if (mask) {
            const int eb = __builtin_ctz(mask); mask &= mask - 1u;
            const bf16* yb = Y + (size_t)(xe_rowbase(set4, eb) + __builtin_amdgcn_readlane(myslot, eb)) * D + 4 * lane;
            u32x2 wb[4];
#pragma unroll
            for (int j = 0; j < 4; ++j) wb[j] = *(const u32x2*)(yb + 256 * j);
            ACC_Y(wa); ACC_Y(wb);
        } else { ACC_Y(wa); }
    }
#undef ACC_Y
#pragma unroll
    for (int j = 0; j < 4; ++j) v[j] = xr[j] + g2[j] * s[j];
}
__device__ __forceinline__ void ld_gate2(const Args& a, int l, int set, int lane, f32x4 (&g2)[4]) {
    const float* MOD = (const float*)(a.ws + WS_MOD) + (size_t)(l * 3 + set) * 6144;
#pragma unroll
    for (int j = 0; j < 4; ++j) g2[j] = *(const f32x4*)(MOD + 5 * 1024 + 4 * lane + 256 * j);
}
__device__ __forceinline__ void modul_phase(const Args& a, int l, int lane, int wave, int vcu, int G) {
    const int gw = vcu * 8 + wave, NGW = G * 8;
    bf16* H = (bf16*)(a.ws + WS_H); float* X2 = x2_of(a);
    const float* gat = a.in[I_GATTN] + l * D;
    int cset = -1; f32x4 gg[4], sh[4], g2[4];
#pragma unroll
    for (int j = 0; j < 4; ++j) { gg[j] = (f32x4){0.f, 0.f, 0.f, 0.f}; sh[j] = gg[j]; g2[j] = gg[j]; }
    f32x4 vn[4];
#define MD_SRC(m_) ((m_) < NLAT ? a.in[I_X] + (size_t)(m_) * D : a.in[I_CTX] + (size_t)((m_) - NLAT) * D)
    if (l == 0 && gw < NROW) { const float* src = MD_SRC(gw);
#pragma unroll
        for (int j = 0; j < 4; ++j) vn[j] = *(const f32x4*)(src + 4 * lane + 256 * j); }
    for (int m = gw; m < NROW; m += NGW) {
        const int set = mset_of_row(m);
        if (set != cset) { cset = set; const float* MOD = (const float*)(a.ws + WS_MOD) + (size_t)(l * 3 + set) * 6144;
#pragma unroll
            for (int j = 0; j < 4; ++j) { const int c = 4 * lane + 256 * j; const f32x4 g = *(const f32x4*)(gat + c), scl = *(const f32x4*)(MOD + 1024 + c); sh[j] = *(const f32x4*)(MOD + c); gg[j] = g * (scl + 1.f); }
            if (l == 1) ld_gate2(a, 0, set, lane, g2); }
        f32x4 v[4];
        if (l == 0) {
#pragma unroll
            for (int j = 0; j < 4; ++j) v[j] = vn[j];
            if (m + NGW < NROW) { const float* src = MD_SRC(m + NGW);
#pragma unroll
                for (int j = 0; j < 4; ++j) vn[j] = *(const f32x4*)(src + 4 * lane + 256 * j); }
            __builtin_amdgcn_sched_barrier(0); }
        else { combine_row(a, 0, m, lane, v, g2);
#pragma unroll
            for (int j = 0; j < 4; ++j) *(f32x4*)(X2 + (size_t)m * D + 4 * lane + 256 * j) = v[j]; }
        float ss = 0.f;
#pragma unroll
        for (int j = 0; j < 4; ++j) ss += (v[j].x * v[j].x + v[j].y * v[j].y) + (v[j].z * v[j].z + v[j].w * v[j].w);
        const float rstd = rsqrtf(wave_sum(ss) * (1.f / D) + EPS);
#pragma unroll
        for (int j = 0; j < 4; ++j) { const int c = 4 * lane + 256 * j; const f32x4 h = v[j] * rstd * gg[j] + sh[j];
            u32x2 o; o.x = pk2(h.x, h.y); o.y = pk2(h.z, h.w); *(u32x2*)(H + (size_t)m * D + c) = o; }
    }
#undef MD_SRC
}
__device__ __forceinline__ void final_phase(const Args& a, int lane, int wave, int vcu, int G) {
    const int gw = vcu * 8 + wave, NGW = G * 8;
    int cset = -1; f32x4 g2[4];
#pragma unroll
    for (int j = 0; j < 4; ++j) g2[j] = (f32x4){0.f, 0.f, 0.f, 0.f};
    for (int m = gw; m < NLAT; m += NGW) {
        const int set = mset_of_row(m);
        if (set != cset) { cset = set; ld_gate2(a, 1, set, lane, g2); }
        f32x4 v[4]; combine_row(a, 1, m, lane, v, g2);
#pragma unroll
        for (int j = 0; j < 4; ++j) *(f32x4*)(a.out + (size_t)m * D + 4 * lane + 256 * j) = v[j];
    }
}
#define XB_TMO      128
#define XB_XCNT(j)  (256  + 64 * (j))
#define XB_XSUB(j)  (1280 + 64 * (j))
#define XB_XGEN(j)  (2304 + 64 * (j))
#define XB_TOP      3328
#define XB_TOPGEN   3392
#define XCD_BAR_WORDS 3456
#define XB_SPIN_CAP (1u << 18)

__device__ __forceinline__ unsigned xb_ld(unsigned* p)              { return __hip_atomic_load(p, __ATOMIC_RELAXED, __HIP_MEMORY_SCOPE_AGENT); }
__device__ __forceinline__ unsigned xb_add(unsigned* p, unsigned v) { return __hip_atomic_fetch_add(p, v, __ATOMIC_RELAXED, __HIP_MEMORY_SCOPE_AGENT); }
__device__ __forceinline__ unsigned xb_xcc_id() { return (unsigned)__builtin_amdgcn_s_getreg((3 << 11) | 20) & 0xFu; }
#define XB_SPIN(cond, bar) do { unsigned _sp = 0; while (cond) { __builtin_amdgcn_s_sleep(1); \
    if ((++_sp & 255u) == 0u) { if (xb_ld(&(bar)[XB_TMO])) break; if (_sp > XB_SPIN_CAP) { atomicAdd(&(bar)[XB_TMO], 1u); break; } } } } while (0)

struct XcdBarrier {
    unsigned* bar; unsigned x;
    volatile LAS unsigned* st;
};

__device__ __forceinline__ XcdBarrier xcd_barrier_post(unsigned* bar, volatile LAS unsigned* st, bool t0  ) {
    XcdBarrier b; b.bar = bar; b.x = xb_xcc_id(); b.st = st;
    if (t0) (void)xb_add(&bar[XB_XCNT(b.x)], 1u);
    return b;
}
__device__ __forceinline__ void xcd_barrier_complete(unsigned* bar, unsigned x, unsigned& nloc, unsigned& nx) {
    const unsigned G = gridDim.x * gridDim.y * gridDim.z;
    unsigned sum, cnt, mine, sp = 0u;
    for (;;) {
        sum = 0u; cnt = 0u; mine = 0u;
#pragma unroll
        for (unsigned j = 0; j < 16; ++j) { const unsigned c = xb_ld(&bar[XB_XCNT(j)]); sum += c; cnt += (c > 0u) ? 1u : 0u; mine = (j == x) ? c : mine; }
        if (sum == G) break;
        __builtin_amdgcn_s_sleep(1);
        if ((++sp & 255u) == 0u) { if (xb_ld(&bar[XB_TMO])) break; if (sp > XB_SPIN_CAP) { atomicAdd(&bar[XB_TMO], 1u); break; } }
    }
    nloc = mine > 0u ? mine : 1u; nx = cnt > 0u ? cnt : 1u;
}

__device__ __forceinline__ void xcd_barrier(const XcdBarrier& b, bool t0  ) {
    asm volatile("s_waitcnt vmcnt(0)" ::: "memory");
    __syncthreads();
    if (t0) {
        unsigned* bar = b.bar;
        __builtin_amdgcn_s_waitcnt(0);
        unsigned nloc = b.st[0], nx = b.st[1];
        if (nloc == 0u) { xcd_barrier_complete(bar, b.x, nloc, nx); b.st[0] = nloc; b.st[1] = nx; }
        const unsigned old = xb_add(&bar[XB_XSUB(b.x)], 1u);
        const unsigned gen = old / nloc;
        if (old + 1u == (gen + 1u) * nloc) {
            __builtin_amdgcn_fence(__ATOMIC_RELEASE, "agent");
            asm volatile("s_waitcnt vmcnt(0)" ::: "memory");
            const unsigned og = xb_add(&bar[XB_TOP], 1u);
            const unsigned tg = og / nx;
            if (og + 1u == (tg + 1u) * nx) xb_add(&bar[XB_TOPGEN], 1u);
            else XB_SPIN(xb_ld(&bar[XB_TOPGEN]) == tg, bar);
            __builtin_amdgcn_fence(__ATOMIC_ACQUIRE, "agent");
            xb_add(&bar[XB_XGEN(b.x)], 1u);
            asm volatile("s_waitcnt vmcnt(0)" ::: "memory");
        } else {
            XB_SPIN(xb_ld(&bar[XB_XGEN(b.x)]) == gen, bar);
            __builtin_amdgcn_fence(__ATOMIC_ACQUIRE, "agent");
            asm volatile("s_waitcnt vmcnt(0)" ::: "memory");
        }
    }
    __syncthreads();
}

struct TokTile { int m0; int b; int ktile; int prow; bool lat; };
__device__ __forceinline__ TokTile tok_tile(int T) {
    TokTile t; t.m0 = 64 * T;
    if (T < 512) { t.b = T >> 8; t.prow = T & 255; t.ktile = 4 + t.prow; t.lat = true; }
    else { const int c = T - 512; t.b = c >> 2; t.ktile = c & 3; t.prow = 0; t.lat = false; }
    return t;
}
template <int N> __device__ __forceinline__ void ld_row(const bf16* p, float (&v)[N]) {
#pragma unroll
    for (int i = 0; i < N / 8; ++i) { const u32x4 w = *(const u32x4*)(p + 8 * i);
        v[8 * i + 0] = __uint_as_float(w.x << 16); v[8 * i + 1] = __uint_as_float(w.x & 0xffff0000u); v[8 * i + 2] = __uint_as_float(w.y << 16); v[8 * i + 3] = __uint_as_float(w.y & 0xffff0000u);
        v[8 * i + 4] = __uint_as_float(w.z << 16); v[8 * i + 5] = __uint_as_float(w.z & 0xffff0000u); v[8 * i + 6] = __uint_as_float(w.w << 16); v[8 * i + 7] = __uint_as_float(w.w & 0xffff0000u); }
}
template <int N> __device__ __forceinline__ void up_row(const u32x4 (&raw)[8], float (&v)[N]) {
#pragma unroll
    for (int i = 0; i < N / 8; ++i) { const u32x4 w = raw[i];
        v[8 * i + 0] = __uint_as_float(w.x << 16); v[8 * i + 1] = __uint_as_float(w.x & 0xffff0000u); v[8 * i + 2] = __uint_as_float(w.y << 16); v[8 * i + 3] = __uint_as_float(w.y & 0xffff0000u);
        v[8 * i + 4] = __uint_as_float(w.z << 16); v[8 * i + 5] = __uint_as_float(w.z & 0xffff0000u); v[8 * i + 6] = __uint_as_float(w.w << 16); v[8 * i + 7] = __uint_as_float(w.w & 0xffff0000u); }
}
template <int N> __device__ __forceinline__ void rms_gain(float (&v)[N], const float* g) {
    float ss = 0.f;
#pragma unroll
    for (int i = 0; i < N; ++i) ss += v[i] * v[i];
    const float r = rsqrtf(ss * (1.f / N) + EPS);
#pragma unroll
    for (int i = 0; i < N; ++i) v[i] = v[i] * r * g[i];
}
constexpr float ROPE_INVR[16] = {1.591549431e-01f, 8.949940161e-02f, 5.032921210e-02f, 2.830219583e-02f, 1.591549431e-02f, 8.949940161e-03f, 5.032921210e-03f, 2.830219583e-03f,
                                 1.591549431e-03f, 8.949940161e-04f, 5.032921210e-04f, 2.830219583e-04f, 1.591549431e-04f, 8.949940161e-05f, 5.032921210e-05f, 2.830219583e-05f};
template <int OFF, int NR, int N> __device__ __forceinline__ void rope2d(float (&v)[N], float tr, float tc) {
    constexpr int Q = NR / 4, FS = 64 / NR;
#pragma unroll
    for (int d = 0; d < Q; ++d) {
        { const float t = __builtin_amdgcn_fractf(tr * ROPE_INVR[FS * d]); const float c = __builtin_amdgcn_cosf(t), s = __builtin_amdgcn_sinf(t); const float x1 = v[OFF + d], x2 = v[OFF + Q + d]; v[OFF + d] = x1 * c - x2 * s; v[OFF + Q + d] = x1 * s + x2 * c; }
        { const float t = __builtin_amdgcn_fractf(tc * ROPE_INVR[FS * d]); const float c = __builtin_amdgcn_cosf(t), s = __builtin_amdgcn_sinf(t); const float x1 = v[OFF + 2 * Q + d], x2 = v[OFF + 3 * Q + d]; v[OFF + 2 * Q + d] = x1 * c - x2 * s; v[OFF + 3 * Q + d] = x1 * s + x2 * c; }
    }
}
template <int N> __device__ __forceinline__ void st_row(bf16* p, const float (&v)[N], float sc) {
#pragma unroll
    for (int i = 0; i < N / 8; ++i) { u32x4 w; w.x = pk2(v[8 * i] * sc, v[8 * i + 1] * sc); w.y = pk2(v[8 * i + 2] * sc, v[8 * i + 3] * sc); w.z = pk2(v[8 * i + 4] * sc, v[8 * i + 5] * sc); w.w = pk2(v[8 * i + 6] * sc, v[8 * i + 7] * sc);
        *(u32x4*)(p + 8 * i) = w; }
}
template <int N> __device__ __forceinline__ void st_ktile(bf16* tile, int chunk0, const float (&v)[N], int lane) {
#pragma unroll
    for (int i = 0; i < N / 8; ++i) { u32x4 w; w.x = pk2(v[8 * i], v[8 * i + 1]); w.y = pk2(v[8 * i + 2], v[8 * i + 3]); w.z = pk2(v[8 * i + 4], v[8 * i + 5]); w.w = pk2(v[8 * i + 6], v[8 * i + 7]);
        *(u32x4*)(tile + (size_t)(chunk0 + i) * 512 + lane * 8) = w; }
}
__device__ __forceinline__ void st_vtile(bf16* tile, const float (&v)[64], LAS bf16* scr, int lane) {
#pragma unroll
    for (int dv = 0; dv < 64; dv += 2) { const unsigned w = pk2(v[dv], v[dv + 1]); scr[dv * 72 + lane] = (bf16)(w & 0xffffu); scr[(dv + 1) * 72 + lane] = (bf16)(w >> 16); }
    LDS_WAIT(); asm volatile("" ::: "memory");
#pragma unroll
    for (int kc = 0; kc < 8; ++kc) { const u32x4 w = *(const LAS u32x4*)(scr + lane * 72 + kc * 8); *(u32x4*)(tile + (size_t)kc * 512 + lane * 8) = w; }
    LDS_WAIT(); asm volatile("" ::: "memory");
}
template <int N> __device__ __forceinline__ void ld_row_oct(const bf16* p, float (&v)[N]) {
#pragma unroll
    for (int i = 0; i < N / 8; ++i) { const u32x4 w = *(const u32x4*)(p + 512 * i);
        v[8 * i + 0] = __uint_as_float(w.x << 16); v[8 * i + 1] = __uint_as_float(w.x & 0xffff0000u); v[8 * i + 2] = __uint_as_float(w.y << 16); v[8 * i + 3] = __uint_as_float(w.y & 0xffff0000u);
        v[8 * i + 4] = __uint_as_float(w.z << 16); v[8 * i + 5] = __uint_as_float(w.z & 0xffff0000u); v[8 * i + 6] = __uint_as_float(w.w << 16); v[8 * i + 7] = __uint_as_float(w.w & 0xffff0000u); }
}
template <int NCH> __device__ __forceinline__ void norm_wide(const bf16* src, const float* g, bf16* a2f, int m, int k0) {
    float ss = 0.f;
#pragma unroll
    for (int c = 0; c < NCH; ++c) { asm volatile("" ::: "memory"); float v[64]; ld_row_oct<64>(src + 4096 * c, v);
#pragma unroll
        for (int i = 0; i < 64; ++i) ss += v[i] * v[i]; }
    const float r = rsqrtf(ss * (1.f / (64 * NCH)) + EPS);
    asm volatile("" ::: "memory");
#pragma unroll
    for (int c = 0; c < NCH; ++c) { asm volatile("" ::: "memory"); float v[64]; ld_row_oct<64>(src + 4096 * c, v);
#pragma unroll
        for (int i = 0; i < 64; ++i) v[i] = v[i] * r * g[64 * c + i];
#pragma unroll
        for (int i = 0; i < 8; ++i) { const int k = k0 + 64 * c + 8 * i; u32x4 w; w.x = pk2(v[8 * i], v[8 * i + 1]); w.y = pk2(v[8 * i + 2], v[8 * i + 3]); w.z = pk2(v[8 * i + 4], v[8 * i + 5]); w.w = pk2(v[8 * i + 6], v[8 * i + 7]);
            *(u32x4*)(a2f + ((((size_t)(m >> 5) * 24 + (k >> 4)) * 64) + ((k >> 3) & 1) * 32 + (m & 31)) * 8) = w; } }
}
constexpr int NJ1 = 43, NJ2 = 12, NTT = NROW / 64;
constexpr float C2_64 = 0.125f * LOG2E, C2_32 = 0.17677669529663687f * LOG2E, C2_96 = 0.10206207261596575f * LOG2E;
__device__ __forceinline__ bf16* ktile_ptr(unsigned char* ws, size_t off, int nheads, int dk, int b, int h, int kt) { return (bf16*)(ws + off) + ((size_t)(b * nheads + h) * NTILE + kt) * (size_t)(64 * dk); }

__device__ __forceinline__ int job1_col(int j) {
    if (j < 4) return 64 * j; if (j < 8) return 256 + 64 * (j - 4); if (j < 12) return 512 + 64 * (j - 8); if (j == 12) return 768; if (j == 13) return 1024; if (j == 14) return 2432;
    if (j < 23) return 1152 + 32 * (j - 15); if (j < 31) return 1408 + 32 * (j - 23); if (j < 35) return 1664 + 64 * (j - 31); if (j < 39) return 1920 + 64 * (j - 35); if (j < 41) return 2176 + 64 * (j - 39);
    return 2304 + 64 * (j - 41);
}
__device__ __forceinline__ void prep1_phase(const Args& a, int l, LAS unsigned char* lds, int lane_in, int wave, int vcu, int G) {
    LAS bf16* scr = (LAS bf16*)(lds + wave * 9216);
    const int gw = vcu * 8 + wave, NGW = G * 8;
    const bf16* P = (const bf16*)(a.ws + WS_P);
    u32x4 raw[8];
#define P1_LOAD(it_, lane_) do { const int T_ = (it_) / NJ1, j_ = (it_) % NJ1; const bf16* p_ = P + (((size_t)T_ * (NP / 8) + (job1_col(j_) >> 3)) * 64 + (lane_)) * 8; _Pragma("unroll") for (int i_ = 0; i_ < 8; ++i_) raw[i_] = *(const u32x4*)(p_ + 512 * i_); } while (0)
#define P1_NEXT() do { if (it + NGW < NTT * NJ1) P1_LOAD(it + NGW, lane); __builtin_amdgcn_sched_barrier(0); } while (0)
    if (gw < NTT * NJ1) P1_LOAD(gw, lane_in);
    for (int it = gw; it < NTT * NJ1; it += NGW) {
        int lane = lane_in; asm volatile("" : "+v"(lane));
        const int T = it / NJ1, j = it % NJ1; const TokTile tt = tok_tile(T); const int m = tt.m0 + lane;
        const float tr = (float)tt.prow, tc = (float)lane;
        if (j < 4) { float v[64]; up_row<64>(raw, v); P1_NEXT(); rms_gain<64>(v, a.in[I_GNAQ] + l * 64); st_row<64>((bf16*)(a.ws + WS_QNA) + (size_t)m * 256 + 64 * j, v, C2_64); }
        else if (j < 8) { const int h = j - 4; float v[64]; up_row<64>(raw, v); P1_NEXT(); rms_gain<64>(v, a.in[I_GNAK] + l * 64); st_ktile<64>(ktile_ptr(a.ws, WS_KNA, 4, 64, tt.b, h, tt.ktile), 0, v, lane); }
        else if (j < 12) { const int h = j - 8; float v[64]; up_row<64>(raw, v); P1_NEXT(); st_vtile(ktile_ptr(a.ws, WS_VNA, 4, 64, tt.b, h, tt.ktile), v, scr, lane); }
        else if (j < 14) { P1_NEXT(); }
        else if (j == 14) { float v[32]; up_row<32>(raw, v); P1_NEXT(); rms_gain<32>(v, a.in[I_GKR] + l * 32); if (tt.lat) rope2d<0, 32, 32>(v, tr, tc);
#pragma unroll
            for (int h = 0; h < 4; ++h) st_ktile<32>(ktile_ptr(a.ws, WS_KMLA, 4, 96, tt.b, h, tt.ktile), 8, v, lane); }
        else if (j < 23) { const int h = (j - 15) >> 1, c = (j - 15) & 1; float v[32]; up_row<32>(raw, v); P1_NEXT(); rms_gain<32>(v, a.in[I_GDQ] + l * 64 + 32 * c); if (tt.lat) rope2d<0, 32, 32>(v, tr, tc);
            st_row<32>((bf16*)(a.ws + WS_QDIFF) + (size_t)m * 256 + 64 * h + 32 * c, v, C2_32); }
        else if (j < 31) { const int h = (j - 23) >> 1, c = (j - 23) & 1; float v[32]; up_row<32>(raw, v); P1_NEXT(); rms_gain<32>(v, a.in[I_GDK] + l * 64 + 32 * c); if (tt.lat) rope2d<0, 32, 32>(v, tr, tc);
            st_ktile<32>(ktile_ptr(a.ws, WS_KDIFF, 4, 64, tt.b, h, tt.ktile), 4 * c, v, lane); }
        else if (j < 35) { const int h = j - 31; float v[64]; up_row<64>(raw, v); P1_NEXT(); st_vtile(ktile_ptr(a.ws, WS_VDIFF, 4, 64, tt.b, h, tt.ktile), v, scr, lane); }
        else if (j < 39) { const int h = j - 35; float v[64]; up_row<64>(raw, v); P1_NEXT(); rms_gain<64>(v, a.in[I_GGQ] + l * 64); if (tt.lat) rope2d<0, 64, 64>(v, tr, tc);
            st_row<64>((bf16*)(a.ws + WS_QGQA) + (size_t)m * 256 + 64 * h, v, C2_64); }
        else if (j < 41) { const int h = j - 39; float v[64]; up_row<64>(raw, v); P1_NEXT(); rms_gain<64>(v, a.in[I_GGK] + l * 64); if (tt.lat) rope2d<0, 64, 64>(v, tr, tc);
            st_ktile<64>(ktile_ptr(a.ws, WS_KGQA, 2, 64, tt.b, h, tt.ktile), 0, v, lane); }
        else { const int h = j - 41; float v[64]; up_row<64>(raw, v); P1_NEXT(); st_vtile(ktile_ptr(a.ws, WS_VGQA, 2, 64, tt.b, h, tt.ktile), v, scr, lane); }
    }
#undef P1_LOAD
#undef P1_NEXT
}
__device__ __forceinline__ void prep2_phase(const Args& a, int l, LAS unsigned char* lds, int lane_in, int wave, int vcu, int G) {
    LAS bf16* scr = (LAS bf16*)(lds + wave * 9216);
    const int gw = vcu * 8 + wave, NGW = G * 8;
    const bf16* U = (const bf16*)(a.ws + WS_U);
    u32x4 raw[8];
#define P2_LOAD(it_, lane_) do { const int T_ = (it_) / NJ2, j_ = (it_) % NJ2; const bf16* p_ = U + (size_t)(64 * T_ + (lane_)) * D + (j_ < 4 ? 128 * j_ : (j_ < 8 ? 512 + 128 * (j_ - 4) : 512 + 128 * (j_ - 8) + 64)); \
        _Pragma("unroll") for (int i_ = 0; i_ < 8; ++i_) raw[i_] = *(const u32x4*)(p_ + 8 * i_); } while (0)
#define P2_NEXT() do { if (it + NGW < NTT * NJ2) P2_LOAD(it + NGW, lane); __builtin_amdgcn_sched_barrier(0); } while (0)
    if (gw < NTT * NJ2) P2_LOAD(gw, lane_in);
    for (int it = gw; it < NTT * NJ2; it += NGW) {
        int lane = lane_in; asm volatile("" : "+v"(lane));
        const int T = it / NJ2, j = it % NJ2; const TokTile tt = tok_tile(T); const int m = tt.m0 + lane;
        const bf16* urow = U + (size_t)m * D; const float tr = (float)tt.prow, tc = (float)lane;
        if (j < 4) { const bf16* src = urow + 128 * j; const float* g = a.in[I_GMQ] + l * 96; bf16* dst = (bf16*)(a.ws + WS_QMLA) + (size_t)m * 384 + 96 * j; float ss = 0.f;
            P2_NEXT();
#pragma unroll
            for (int c = 0; c < 3; ++c) { asm volatile("" ::: "memory"); float v[32]; ld_row<32>(src + 32 * c, v);
#pragma unroll
                for (int i = 0; i < 32; ++i) ss += v[i] * v[i]; }
            const float r = rsqrtf(ss * (1.f / 96.f) + EPS);
#pragma unroll
            for (int c = 0; c < 3; ++c) { asm volatile("" ::: "memory"); float v[32]; ld_row<32>(src + 32 * c, v);
#pragma unroll
                for (int i = 0; i < 32; ++i) v[i] = v[i] * r * g[32 * c + i];
                if (c == 2 && tt.lat) rope2d<0, 32, 32>(v, tr, tc);
                st_row<32>(dst + 32 * c, v, C2_96); } }
        else if (j < 8) { const int h = j - 4; float v[64]; up_row<64>(raw, v); P2_NEXT(); rms_gain<64>(v, a.in[I_GKN] + l * 64); st_ktile<64>(ktile_ptr(a.ws, WS_KMLA, 4, 96, tt.b, h, tt.ktile), 0, v, lane); }
        else { const int h = j - 8; float v[64]; up_row<64>(raw, v); P2_NEXT(); st_vtile(ktile_ptr(a.ws, WS_VMLA, 4, 64, tt.b, h, tt.ktile), v, scr, lane); }
    }
#undef P2_LOAD
#undef P2_NEXT
}

__device__ __forceinline__ int pi32(int r) { return (r & 0x13) | ((r & 4) << 1) | ((r & 8) >> 1); }
__device__ __forceinline__ bf16x8 pack8(const f32x16& p, int base) {
    u32x4 w; w.x = pk2(p[base], p[base + 1]); w.y = pk2(p[base + 2], p[base + 3]); w.z = pk2(p[base + 4], p[base + 5]); w.w = pk2(p[base + 6], p[base + 7]);
    return __builtin_bit_cast(bf16x8, w);
}
#define MFMA32(A, B, C) __builtin_amdgcn_mfma_f32_32x32x16_bf16((A), (B), (C), 0, 0, 0)
__device__ __forceinline__ void store_ot(bf16* orow, const f32x16& o0, const f32x16& o1, int hi) {
#pragma unroll
    for (int g = 0; g < 4; ++g) {
        u32x2 w0, w1; w0.x = pk2(o0[4 * g], o0[4 * g + 1]); w0.y = pk2(o0[4 * g + 2], o0[4 * g + 3]); w1.x = pk2(o1[4 * g], o1[4 * g + 1]); w1.y = pk2(o1[4 * g + 2], o1[4 * g + 3]);
        *(u32x2*)(orow + 8 * g + 4 * hi) = w0; *(u32x2*)(orow + 32 + 8 * g + 4 * hi) = w1;
    }
}
#define SBAR() __builtin_amdgcn_sched_barrier(0)
#define EX2(x) __builtin_amdgcn_exp2f(x)
#define ZERO16 ((f32x16){})
__device__ __forceinline__ float fadd_s(float a, float b) { float r; asm("v_add_f32_e32 %0, %1, %2" : "=v"(r) : "v"(a), "v"(b)); return r; }
#define FADD(a, b) fadd_s((a), (b))
#if defined(MK_XPROBE) && MK_XPROBE == 2
#define XPROBE(x) do { float d0_, d1_; asm volatile("v_exp_f32 %0, %2\n\tv_exp_f32 %1, %2" : "=&v"(d0_), "=&v"(d1_) : "v"(x)); } while (0)
#else
#define XPROBE(x) do { } while (0)
#endif
#define ATT_GQA_PRE(KCUR1) do { \
        kf0 = *(const LAS bf16x8*)(KCUR1 + 0); \
        kf1 = *(const LAS bf16x8*)(KCUR1 + 2048); \
    } while (0)
#define ATT_GQA_ITER(KCUR1, KNEXT0, KNEXT1, VPREV1, VCUR0) do { \
        kf2 = *(const LAS bf16x8*)(KCUR1 + 4096); \
        SB_a = MFMA32(kf0, qa[0], ZERO16); \
        SA_a[0] = EX2(SA_a[0]); SA_a[1] = EX2(SA_a[1]); \
        SBAR(); \
        SB_b = MFMA32(kf0, qb[0], ZERO16); \
        la += SA_a[0]; la += SA_a[1]; PA_a_lo[0] = pk2(SA_a[0], SA_a[1]); XPROBE(SA_a[0]); \
        SA_a[2] = EX2(SA_a[2]); SA_a[3] = EX2(SA_a[3]); \
        SBAR(); \
        kf3 = *(const LAS bf16x8*)(KCUR1 + 6144); \
        SB_a = MFMA32(kf1, qa[1], SB_a); \
        la += SA_a[2]; la += SA_a[3]; PA_a_lo[1] = pk2(SA_a[2], SA_a[3]); XPROBE(SA_a[2]); \
        SA_a[4] = EX2(SA_a[4]); SA_a[5] = EX2(SA_a[5]); \
        SBAR(); \
        SB_b = MFMA32(kf1, qb[1], SB_b); \
        la += SA_a[4]; la += SA_a[5]; PA_a_lo[2] = pk2(SA_a[4], SA_a[5]); XPROBE(SA_a[4]); \
        SA_a[6] = EX2(SA_a[6]); SA_a[7] = EX2(SA_a[7]); \
        SBAR(); \
        vf0 = *(const LAS bf16x8*)(VPREV1 + 0); \
        SB_a = MFMA32(kf2, qa[2], SB_a); \
        la += SA_a[6]; la += SA_a[7]; PA_a_lo[3] = pk2(SA_a[6], SA_a[7]); XPROBE(SA_a[6]); \
        SA_a[8] = EX2(SA_a[8]); SA_a[9] = EX2(SA_a[9]); \
        SBAR(); \
        vf1 = *(const LAS bf16x8*)(VPREV1 + 512); \
        SB_b = MFMA32(kf2, qb[2], SB_b); \
        la += SA_a[8]; la += SA_a[9]; PA_a_hi[0] = pk2(SA_a[8], SA_a[9]); XPROBE(SA_a[8]); \
        SA_a[10] = EX2(SA_a[10]); SA_a[11] = EX2(SA_a[11]); \
        SBAR(); \
        SB_a = MFMA32(kf3, qa[3], SB_a); \
        la += SA_a[10]; la += SA_a[11]; PA_a_hi[1] = pk2(SA_a[10], SA_a[11]); XPROBE(SA_a[10]); \
        SA_a[12] = EX2(SA_a[12]); SA_a[13] = EX2(SA_a[13]); \
        SBAR(); \
        SB_b = MFMA32(kf3, qb[3], SB_b); \
        la += SA_a[12]; la += SA_a[13]; PA_a_hi[2] = pk2(SA_a[12], SA_a[13]); XPROBE(SA_a[12]); \
        SA_a[14] = EX2(SA_a[14]); SA_a[15] = EX2(SA_a[15]); \
        SBAR(); \
        vf2 = *(const LAS bf16x8*)(VPREV1 + 2048); \
        oa0 = MFMA32(vf0, PB_a_lo, oa0); \
        la += SA_a[14]; la += SA_a[15]; PA_a_hi[3] = pk2(SA_a[14], SA_a[15]); XPROBE(SA_a[14]); \
        SA_b[0] = EX2(SA_b[0]); SA_b[1] = EX2(SA_b[1]); \
        SBAR(); \
        vf3 = *(const LAS bf16x8*)(VPREV1 + 2560); \
        oa1 = MFMA32(vf1, PB_a_lo, oa1); \
        lb += SA_b[0]; lb += SA_b[1]; PA_b_lo[0] = pk2(SA_b[0], SA_b[1]); XPROBE(SA_b[0]); \
        SA_b[2] = EX2(SA_b[2]); SA_b[3] = EX2(SA_b[3]); \
        SBAR(); \
        ob0 = MFMA32(vf0, PB_b_lo, ob0); \
        lb += SA_b[2]; lb += SA_b[3]; PA_b_lo[1] = pk2(SA_b[2], SA_b[3]); XPROBE(SA_b[2]); \
        SA_b[4] = EX2(SA_b[4]); SA_b[5] = EX2(SA_b[5]); \
        SBAR(); \
        ob1 = MFMA32(vf1, PB_b_lo, ob1); \
        lb += SA_b[4]; lb += SA_b[5]; PA_b_lo[2] = pk2(SA_b[4], SA_b[5]); XPROBE(SA_b[4]); \
        SA_b[6] = EX2(SA_b[6]); SA_b[7] = EX2(SA_b[7]); \
        SBAR(); \
        kf0 = *(const LAS bf16x8*)(KNEXT0 + 0); \
        oa0 = MFMA32(vf2, PB_a_hi, oa0); \
        lb += SA_b[6]; lb += SA_b[7]; PA_b_lo[3] = pk2(SA_b[6], SA_b[7]); XPROBE(SA_b[6]); \
        SA_b[8] = EX2(SA_b[8]); SA_b[9] = EX2(SA_b[9]); \
        SBAR(); \
        oa1 = MFMA32(vf3, PB_a_hi, oa1); \
        lb += SA_b[8]; lb += SA_b[9]; PA_b_hi[0] = pk2(SA_b[8], SA_b[9]); XPROBE(SA_b[8]); \
        SA_b[10] = EX2(SA_b[10]); SA_b[11] = EX2(SA_b[11]); \
        SBAR(); \
        kf1 = *(const LAS bf16x8*)(KNEXT0 + 2048); \
        ob0 = MFMA32(vf2, PB_b_hi, ob0); \
        lb += SA_b[10]; lb += SA_b[11]; PA_b_hi[1] = pk2(SA_b[10], SA_b[11]); XPROBE(SA_b[10]); \
        SA_b[12] = EX2(SA_b[12]); SA_b[13] = EX2(SA_b[13]); \
        SBAR(); \
        ob1 = MFMA32(vf3, PB_b_hi, ob1); \
        lb += SA_b[12]; lb += SA_b[13]; PA_b_hi[2] = pk2(SA_b[12], SA_b[13]); XPROBE(SA_b[12]); \
        SA_b[14] = EX2(SA_b[14]); SA_b[15] = EX2(SA_b[15]); \
        lb += SA_b[14]; lb += SA_b[15]; PA_b_hi[3] = pk2(SA_b[14], SA_b[15]); XPROBE(SA_b[14]); \
        SBAR(); \
        kf2 = *(const LAS bf16x8*)(KNEXT0 + 4096); \
        SA_a = MFMA32(kf0, qa[0], ZERO16); \
        SB_a[0] = EX2(SB_a[0]); SB_a[1] = EX2(SB_a[1]); \
        SBAR(); \
        SA_b = MFMA32(kf0, qb[0], ZERO16); \
        la += SB_a[0]; la += SB_a[1]; PB_a_lo[0] = pk2(SB_a[0], SB_a[1]); XPROBE(SB_a[0]); \
        SB_a[2] = EX2(SB_a[2]); SB_a[3] = EX2(SB_a[3]); \
        SBAR(); \
        kf3 = *(const LAS bf16x8*)(KNEXT0 + 6144); \
        SA_a = MFMA32(kf1, qa[1], SA_a); \
        la += SB_a[2]; la += SB_a[3]; PB_a_lo[1] = pk2(SB_a[2], SB_a[3]); XPROBE(SB_a[2]); \
        SB_a[4] = EX2(SB_a[4]); SB_a[5] = EX2(SB_a[5]); \
        SBAR(); \
        SA_b = MFMA32(kf1, qb[1], SA_b); \
        la += SB_a[4]; la += SB_a[5]; PB_a_lo[2] = pk2(SB_a[4], SB_a[5]); XPROBE(SB_a[4]); \
        SB_a[6] = EX2(SB_a[6]); SB_a[7] = EX2(SB_a[7]); \
        SBAR(); \
        vf0 = *(const LAS bf16x8*)(VCUR0 + 0); \
        SA_a = MFMA32(kf2, qa[2], SA_a); \
        la += SB_a[6]; la += SB_a[7]; PB_a_lo[3] = pk2(SB_a[6], SB_a[7]); XPROBE(SB_a[6]); \
        SB_a[8] = EX2(SB_a[8]); SB_a[9] = EX2(SB_a[9]); \
        SBAR(); \
        vf1 = *(const LAS bf16x8*)(VCUR0 + 512); \
        SA_b = MFMA32(kf2, qb[2], SA_b); \
        la += SB_a[8]; la += SB_a[9]; PB_a_hi[0] = pk2(SB_a[8], SB_a[9]); XPROBE(SB_a[8]); \
        SB_a[10] = EX2(SB_a[10]); SB_a[11] = EX2(SB_a[11]); \
        SBAR(); \
        SA_a = MFMA32(kf3, qa[3], SA_a); \
        la += SB_a[10]; la += SB_a[11]; PB_a_hi[1] = pk2(SB_a[10], SB_a[11]); XPROBE(SB_a[10]); \
        SB_a[12] = EX2(SB_a[12]); SB_a[13] = EX2(SB_a[13]); \
        SBAR(); \
        SA_b = MFMA32(kf3, qb[3], SA_b); \
        la += SB_a[12]; la += SB_a[13]; PB_a_hi[2] = pk2(SB_a[12], SB_a[13]); XPROBE(SB_a[12]); \
        SB_a[14] = EX2(SB_a[14]); SB_a[15] = EX2(SB_a[15]); \
        SBAR(); \
        vf2 = *(const LAS bf16x8*)(VCUR0 + 2048); \
        oa0 = MFMA32(vf0, PA_a_lo, oa0); \
        la += SB_a[14]; la += SB_a[15]; PB_a_hi[3] = pk2(SB_a[14], SB_a[15]); XPROBE(SB_a[14]); \
        SB_b[0] = EX2(SB_b[0]); SB_b[1] = EX2(SB_b[1]); \
        SBAR(); \
        vf3 = *(const LAS bf16x8*)(VCUR0 + 2560); \
        oa1 = MFMA32(vf1, PA_a_lo, oa1); \
        lb += SB_b[0]; lb += SB_b[1]; PB_b_lo[0] = pk2(SB_b[0], SB_b[1]); XPROBE(SB_b[0]); \
        SB_b[2] = EX2(SB_b[2]); SB_b[3] = EX2(SB_b[3]); \
        SBAR(); \
        ob0 = MFMA32(vf0, PA_b_lo, ob0); \
        lb += SB_b[2]; lb += SB_b[3]; PB_b_lo[1] = pk2(SB_b[2], SB_b[3]); XPROBE(SB_b[2]); \
        SB_b[4] = EX2(SB_b[4]); SB_b[5] = EX2(SB_b[5]); \
        SBAR(); \
        ob1 = MFMA32(vf1, PA_b_lo, ob1); \
        lb += SB_b[4]; lb += SB_b[5]; PB_b_lo[2] = pk2(SB_b[4], SB_b[5]); XPROBE(SB_b[4]); \
        SB_b[6] = EX2(SB_b[6]); SB_b[7] = EX2(SB_b[7]); \
        SBAR(); \
        kf0 = *(const LAS bf16x8*)(KNEXT1 + 0); \
        oa0 = MFMA32(vf2, PA_a_hi, oa0); \
        lb += SB_b[6]; lb += SB_b[7]; PB_b_lo[3] = pk2(SB_b[6], SB_b[7]); XPROBE(SB_b[6]); \
        SB_b[8] = EX2(SB_b[8]); SB_b[9] = EX2(SB_b[9]); \
        SBAR(); \
        oa1 = MFMA32(vf3, PA_a_hi, oa1); \
        lb += SB_b[8]; lb += SB_b[9]; PB_b_hi[0] = pk2(SB_b[8], SB_b[9]); XPROBE(SB_b[8]); \
        SB_b[10] = EX2(SB_b[10]); SB_b[11] = EX2(SB_b[11]); \
        SBAR(); \
        kf1 = *(const LAS bf16x8*)(KNEXT1 + 2048); \
        ob0 = MFMA32(vf2, PA_b_hi, ob0); \
        lb += SB_b[10]; lb += SB_b[11]; PB_b_hi[1] = pk2(SB_b[10], SB_b[11]); XPROBE(SB_b[10]); \
        SB_b[12] = EX2(SB_b[12]); SB_b[13] = EX2(SB_b[13]); \
        SBAR(); \
        ob1 = MFMA32(vf3, PA_b_hi, ob1); \
        lb += SB_b[12]; lb += SB_b[13]; PB_b_hi[2] = pk2(SB_b[12], SB_b[13]); XPROBE(SB_b[12]); \
        SB_b[14] = EX2(SB_b[14]); SB_b[15] = EX2(SB_b[15]); \
        lb += SB_b[14]; lb += SB_b[15]; PB_b_hi[3] = pk2(SB_b[14], SB_b[15]); XPROBE(SB_b[14]); \
        SBAR(); \
    } while (0)

#define ATT_MLA_PRE(KCUR1) do { \
        kf0 = *(const LAS bf16x8*)(KCUR1 + 0); \
        kf1 = *(const LAS bf16x8*)(KCUR1 + 2048); \
    } while (0)
#define ATT_MLA_ITER(KCUR1, KNEXT0, KNEXT1, VPREV1, VCUR0) do { \
        kf2 = *(const LAS bf16x8*)(KCUR1 + 4096); \
        SB_a = MFMA32(kf0, qa[0], ZERO16); \
        SA_a[0] = EX2(SA_a[0]); SA_a[1] = EX2(SA_a[1]); \
        SBAR(); \
        SB_b = MFMA32(kf0, qb[0], ZERO16); \
        la += SA_a[0]; la += SA_a[1]; PA_a_lo[0] = pk2(SA_a[0], SA_a[1]); XPROBE(SA_a[0]); \
        SA_a[2] = EX2(SA_a[2]); SA_a[3] = EX2(SA_a[3]); \
        SBAR(); \
        kf3 = *(const LAS bf16x8*)(KCUR1 + 6144); \
        SB_a = MFMA32(kf1, qa[1], SB_a); \
        la += SA_a[2]; la += SA_a[3]; PA_a_lo[1] = pk2(SA_a[2], SA_a[3]); XPROBE(SA_a[2]); \
        SA_a[4] = EX2(SA_a[4]); SA_a[5] = EX2(SA_a[5]); \
        SBAR(); \
        SB_b = MFMA32(kf1, qb[1], SB_b); \
        la += SA_a[4]; la += SA_a[5]; PA_a_lo[2] = pk2(SA_a[4], SA_a[5]); XPROBE(SA_a[4]); \
        SA_a[6] = EX2(SA_a[6]); SA_a[7] = EX2(SA_a[7]); \
        SBAR(); \
        kf0 = *(const LAS bf16x8*)(KCUR1 + 8192); \
        SB_a = MFMA32(kf2, qa[2], SB_a); \
        la += SA_a[6]; la += SA_a[7]; PA_a_lo[3] = pk2(SA_a[6], SA_a[7]); XPROBE(SA_a[6]); \
        SBAR(); \
        SB_b = MFMA32(kf2, qb[2], SB_b); \
        SA_a[8] = EX2(SA_a[8]); SA_a[9] = EX2(SA_a[9]); \
        SBAR(); \
        kf1 = *(const LAS bf16x8*)(KCUR1 + 10240); \
        SB_a = MFMA32(kf3, qa[3], SB_a); \
        la += SA_a[8]; la += SA_a[9]; PA_a_hi[0] = pk2(SA_a[8], SA_a[9]); XPROBE(SA_a[8]); \
        SA_a[10] = EX2(SA_a[10]); SA_a[11] = EX2(SA_a[11]); \
        SBAR(); \
        SB_b = MFMA32(kf3, qb[3], SB_b); \
        la += SA_a[10]; la += SA_a[11]; PA_a_hi[1] = pk2(SA_a[10], SA_a[11]); XPROBE(SA_a[10]); \
        SA_a[12] = EX2(SA_a[12]); SA_a[13] = EX2(SA_a[13]); \
        SBAR(); \
        vf0 = *(const LAS bf16x8*)(VPREV1 + 0); \
        SB_a = MFMA32(kf0, qa[4], SB_a); \
        la += SA_a[12]; la += SA_a[13]; PA_a_hi[2] = pk2(SA_a[12], SA_a[13]); XPROBE(SA_a[12]); \
        SA_a[14] = EX2(SA_a[14]); SA_a[15] = EX2(SA_a[15]); \
        SBAR(); \
        vf1 = *(const LAS bf16x8*)(VPREV1 + 512); \
        SB_b = MFMA32(kf0, qb[4], SB_b); \
        la += SA_a[14]; la += SA_a[15]; PA_a_hi[3] = pk2(SA_a[14], SA_a[15]); XPROBE(SA_a[14]); \
        SBAR(); \
        SB_a = MFMA32(kf1, qa[5], SB_a); \
        SA_b[0] = EX2(SA_b[0]); SA_b[1] = EX2(SA_b[1]); \
        SBAR(); \
        SB_b = MFMA32(kf1, qb[5], SB_b); \
        lb += SA_b[0]; lb += SA_b[1]; PA_b_lo[0] = pk2(SA_b[0], SA_b[1]); XPROBE(SA_b[0]); \
        SA_b[2] = EX2(SA_b[2]); SA_b[3] = EX2(SA_b[3]); \
        SBAR(); \
        vf2 = *(const LAS bf16x8*)(VPREV1 + 2048); \
        oa0 = MFMA32(vf0, PB_a_lo, oa0); \
        lb += SA_b[2]; lb += SA_b[3]; PA_b_lo[1] = pk2(SA_b[2], SA_b[3]); XPROBE(SA_b[2]); \
        SA_b[4] = EX2(SA_b[4]); SA_b[5] = EX2(SA_b[5]); \
        SBAR(); \
        vf3 = *(const LAS bf16x8*)(VPREV1 + 2560); \
        oa1 = MFMA32(vf1, PB_a_lo, oa1); \
        lb += SA_b[4]; lb += SA_b[5]; PA_b_lo[2] = pk2(SA_b[4], SA_b[5]); XPROBE(SA_b[4]); \
        SA_b[6] = EX2(SA_b[6]); SA_b[7] = EX2(SA_b[7]); \
        SBAR(); \
        ob0 = MFMA32(vf0, PB_b_lo, ob0); \
        lb += SA_b[6]; lb += SA_b[7]; PA_b_lo[3] = pk2(SA_b[6], SA_b[7]); XPROBE(SA_b[6]); \
        SBAR(); \
        ob1 = MFMA32(vf1, PB_b_lo, ob1); \
        SA_b[8] = EX2(SA_b[8]); SA_b[9] = EX2(SA_b[9]); \
        SBAR(); \
        kf0 = *(const LAS bf16x8*)(KNEXT0 + 0); \
        oa0 = MFMA32(vf2, PB_a_hi, oa0); \
        lb += SA_b[8]; lb += SA_b[9]; PA_b_hi[0] = pk2(SA_b[8], SA_b[9]); XPROBE(SA_b[8]); \
        SA_b[10] = EX2(SA_b[10]); SA_b[11] = EX2(SA_b[11]); \
        SBAR(); \
        oa1 = MFMA32(vf3, PB_a_hi, oa1); \
        lb += SA_b[10]; lb += SA_b[11]; PA_b_hi[1] = pk2(SA_b[10], SA_b[11]); XPROBE(SA_b[10]); \
        SA_b[12] = EX2(SA_b[12]); SA_b[13] = EX2(SA_b[13]); \
        SBAR(); \
        kf1 = *(const LAS bf16x8*)(KNEXT0 + 2048); \
        ob0 = MFMA32(vf2, PB_b_hi, ob0); \
        lb += SA_b[12]; lb += SA_b[13]; PA_b_hi[2] = pk2(SA_b[12], SA_b[13]); XPROBE(SA_b[12]); \
        SA_b[14] = EX2(SA_b[14]); SA_b[15] = EX2(SA_b[15]); \
        SBAR(); \
        ob1 = MFMA32(vf3, PB_b_hi, ob1); \
        lb += SA_b[14]; lb += SA_b[15]; PA_b_hi[3] = pk2(SA_b[14], SA_b[15]); XPROBE(SA_b[14]); \
        SBAR(); \
        kf2 = *(const LAS bf16x8*)(KNEXT0 + 4096); \
        SA_a = MFMA32(kf0, qa[0], ZERO16); \
        SB_a[0] = EX2(SB_a[0]); SB_a[1] = EX2(SB_a[1]); \
        SBAR(); \
        SA_b = MFMA32(kf0, qb[0], ZERO16); \
        la += SB_a[0]; la += SB_a[1]; PB_a_lo[0] = pk2(SB_a[0], SB_a[1]); XPROBE(SB_a[0]); \
        SB_a[2] = EX2(SB_a[2]); SB_a[3] = EX2(SB_a[3]); \
        SBAR(); \
        kf3 = *(const LAS bf16x8*)(KNEXT0 + 6144); \
        SA_a = MFMA32(kf1, qa[1], SA_a); \
        la += SB_a[2]; la += SB_a[3]; PB_a_lo[1] = pk2(SB_a[2], SB_a[3]); XPROBE(SB_a[2]); \
        SB_a[4] = EX2(SB_a[4]); SB_a[5] = EX2(SB_a[5]); \
        SBAR(); \
        SA_b = MFMA32(kf1, qb[1], SA_b); \
        la += SB_a[4]; la += SB_a[5]; PB_a_lo[2] = pk2(SB_a[4], SB_a[5]); XPROBE(SB_a[4]); \
        SB_a[6] = EX2(SB_a[6]); SB_a[7] = EX2(SB_a[7]); \
        SBAR(); \
        kf0 = *(const LAS bf16x8*)(KNEXT0 + 8192); \
        SA_a = MFMA32(kf2, qa[2], SA_a); \
        la += SB_a[6]; la += SB_a[7]; PB_a_lo[3] = pk2(SB_a[6], SB_a[7]); XPROBE(SB_a[6]); \
        SBAR(); \
        SA_b = MFMA32(kf2, qb[2], SA_b); \
        SB_a[8] = EX2(SB_a[8]); SB_a[9] = EX2(SB_a[9]); \
        SBAR(); \
        kf1 = *(const LAS bf16x8*)(KNEXT0 + 10240); \
        SA_a = MFMA32(kf3, qa[3], SA_a); \
        la += SB_a[8]; la += SB_a[9]; PB_a_hi[0] = pk2(SB_a[8], SB_a[9]); XPROBE(SB_a[8]); \
        SB_a[10] = EX2(SB_a[10]); SB_a[11] = EX2(SB_a[11]); \
        SBAR(); \
        SA_b = MFMA32(kf3, qb[3], SA_b); \
        la += SB_a[10]; la += SB_a[11]; PB_a_hi[1] = pk2(SB_a[10], SB_a[11]); XPROBE(SB_a[10]); \
        SB_a[12] = EX2(SB_a[12]); SB_a[13] = EX2(SB_a[13]); \
        SBAR(); \
        vf0 = *(const LAS bf16x8*)(VCUR0 + 0); \
        SA_a = MFMA32(kf0, qa[4], SA_a); \
        la += SB_a[12]; la += SB_a[13]; PB_a_hi[2] = pk2(SB_a[12], SB_a[13]); XPROBE(SB_a[12]); \
        SB_a[14] = EX2(SB_a[14]); SB_a[15] = EX2(SB_a[15]); \
        SBAR(); \
        vf1 = *(const LAS bf16x8*)(VCUR0 + 512); \
        SA_b = MFMA32(kf0, qb[4], SA_b); \
        la += SB_a[14]; la += SB_a[15]; PB_a_hi[3] = pk2(SB_a[14], SB_a[15]); XPROBE(SB_a[14]); \
        SBAR(); \
        SA_a = MFMA32(kf1, qa[5], SA_a); \
        SB_b[0] = EX2(SB_b[0]); SB_b[1] = EX2(SB_b[1]); \
        SBAR(); \
        SA_b = MFMA32(kf1, qb[5], SA_b); \
        lb += SB_b[0]; lb += SB_b[1]; PB_b_lo[0] = pk2(SB_b[0], SB_b[1]); XPROBE(SB_b[0]); \
        SB_b[2] = EX2(SB_b[2]); SB_b[3] = EX2(SB_b[3]); \
        SBAR(); \
        vf2 = *(const LAS bf16x8*)(VCUR0 + 2048); \
        oa0 = MFMA32(vf0, PA_a_lo, oa0); \
        lb += SB_b[2]; lb += SB_b[3]; PB_b_lo[1] = pk2(SB_b[2], SB_b[3]); XPROBE(SB_b[2]); \
        SB_b[4] = EX2(SB_b[4]); SB_b[5] = EX2(SB_b[5]); \
        SBAR(); \
        vf3 = *(const LAS bf16x8*)(VCUR0 + 2560); \
        oa1 = MFMA32(vf1, PA_a_lo, oa1); \
        lb += SB_b[4]; lb += SB_b[5]; PB_b_lo[2] = pk2(SB_b[4], SB_b[5]); XPROBE(SB_b[4]); \
        SB_b[6] = EX2(SB_b[6]); SB_b[7] = EX2(SB_b[7]); \
        SBAR(); \
        ob0 = MFMA32(vf0, PA_b_lo, ob0); \
        lb += SB_b[6]; lb += SB_b[7]; PB_b_lo[3] = pk2(SB_b[6], SB_b[7]); XPROBE(SB_b[6]); \
        SBAR(); \
        ob1 = MFMA32(vf1, PA_b_lo, ob1); \
        SB_b[8] = EX2(SB_b[8]); SB_b[9] = EX2(SB_b[9]); \
        SBAR(); \
        kf0 = *(const LAS bf16x8*)(KNEXT1 + 0); \
        oa0 = MFMA32(vf2, PA_a_hi, oa0); \
        lb += SB_b[8]; lb += SB_b[9]; PB_b_hi[0] = pk2(SB_b[8], SB_b[9]); XPROBE(SB_b[8]); \
        SB_b[10] = EX2(SB_b[10]); SB_b[11] = EX2(SB_b[11]); \
        SBAR(); \
        oa1 = MFMA32(vf3, PA_a_hi, oa1); \
        lb += SB_b[10]; lb += SB_b[11]; PB_b_hi[1] = pk2(SB_b[10], SB_b[11]); XPROBE(SB_b[10]); \
        SB_b[12] = EX2(SB_b[12]); SB_b[13] = EX2(SB_b[13]); \
        SBAR(); \
        kf1 = *(const LAS bf16x8*)(KNEXT1 + 2048); \
        ob0 = MFMA32(vf2, PA_b_hi, ob0); \
        lb += SB_b[12]; lb += SB_b[13]; PB_b_hi[2] = pk2(SB_b[12], SB_b[13]); XPROBE(SB_b[12]); \
        SB_b[14] = EX2(SB_b[14]); SB_b[15] = EX2(SB_b[15]); \
        SBAR(); \
        ob1 = MFMA32(vf3, PA_b_hi, ob1); \
        lb += SB_b[14]; lb += SB_b[15]; PB_b_hi[3] = pk2(SB_b[14], SB_b[15]); XPROBE(SB_b[14]); \
        SBAR(); \
    } while (0)

#define ATT_DIFF_PRE(KCUR1) do { \
        kf0 = *(const LAS bf16x8*)(KCUR1 + 0); \
        kf1 = *(const LAS bf16x8*)(KCUR1 + 4096); \
        kf2 = *(const LAS bf16x8*)(KCUR1 + 2048); \
        kf3 = *(const LAS bf16x8*)(KCUR1 + 6144); \
    } while (0)
#define ATT_DIFF_ITER(KCUR1, KNEXT0, KNEXT1, VPREV1, VCUR0) do { \
        vf0 = *(const LAS bf16x8*)(VPREV1 + 0); \
        SB_a = MFMA32(kf0, qa[0], ZERO16); \
        SA_a[0] = EX2(SA_a[0]); SA_a[1] = EX2(SA_a[1]); \
        SA_a[2] = EX2(SA_a[2]); SA_a[3] = EX2(SA_a[3]); \
        SBAR(); \
        vf1 = *(const LAS bf16x8*)(VPREV1 + 512); \
        SB_b = MFMA32(kf1, qb[0], ZERO16); \
        la += SA_a[0]; la += SA_a[1]; PA_a_lo[0] = pk2(SA_a[0], SA_a[1]); XPROBE(SA_a[0]); \
        la += SA_a[2]; la += SA_a[3]; PA_a_lo[1] = pk2(SA_a[2], SA_a[3]); XPROBE(SA_a[2]); \
        SA_a[4] = EX2(SA_a[4]); SA_a[5] = EX2(SA_a[5]); \
        SBAR(); \
        SB_a = MFMA32(kf2, qa[1], SB_a); \
        la += SA_a[4]; la += SA_a[5]; PA_a_lo[2] = pk2(SA_a[4], SA_a[5]); XPROBE(SA_a[4]); \
        SA_a[6] = EX2(SA_a[6]); SA_a[7] = EX2(SA_a[7]); \
        SBAR(); \
        SB_b = MFMA32(kf3, qb[1], SB_b); \
        la += SA_a[6]; la += SA_a[7]; PA_a_lo[3] = pk2(SA_a[6], SA_a[7]); XPROBE(SA_a[6]); \
        SA_a[8] = EX2(SA_a[8]); SA_a[9] = EX2(SA_a[9]); \
        SA_a[10] = EX2(SA_a[10]); SA_a[11] = EX2(SA_a[11]); \
        SBAR(); \
        vf2 = *(const LAS bf16x8*)(VPREV1 + 2048); \
        oa0 = MFMA32(vf0, PB_a_lo, oa0); \
        la += SA_a[8]; la += SA_a[9]; PA_a_hi[0] = pk2(SA_a[8], SA_a[9]); XPROBE(SA_a[8]); \
        la += SA_a[10]; la += SA_a[11]; PA_a_hi[1] = pk2(SA_a[10], SA_a[11]); XPROBE(SA_a[10]); \
        SA_a[12] = EX2(SA_a[12]); SA_a[13] = EX2(SA_a[13]); \
        SBAR(); \
        vf3 = *(const LAS bf16x8*)(VPREV1 + 2560); \
        oa1 = MFMA32(vf1, PB_a_lo, oa1); \
        la += SA_a[12]; la += SA_a[13]; PA_a_hi[2] = pk2(SA_a[12], SA_a[13]); XPROBE(SA_a[12]); \
        SA_a[14] = EX2(SA_a[14]); SA_a[15] = EX2(SA_a[15]); \
        SBAR(); \
        ob0 = MFMA32(vf0, PB_b_lo, ob0); \
        la += SA_a[14]; la += SA_a[15]; PA_a_hi[3] = pk2(SA_a[14], SA_a[15]); XPROBE(SA_a[14]); \
        SA_b[0] = EX2(SA_b[0]); SA_b[1] = EX2(SA_b[1]); \
        SA_b[2] = EX2(SA_b[2]); SA_b[3] = EX2(SA_b[3]); \
        SBAR(); \
        ob1 = MFMA32(vf1, PB_b_lo, ob1); \
        lb += SA_b[0]; lb += SA_b[1]; PA_b_lo[0] = pk2(SA_b[0], SA_b[1]); XPROBE(SA_b[0]); \
        lb += SA_b[2]; lb += SA_b[3]; PA_b_lo[1] = pk2(SA_b[2], SA_b[3]); XPROBE(SA_b[2]); \
        SA_b[4] = EX2(SA_b[4]); SA_b[5] = EX2(SA_b[5]); \
        SBAR(); \
        kf0 = *(const LAS bf16x8*)(KNEXT0 + 0); \
        oa0 = MFMA32(vf2, PB_a_hi, oa0); \
        lb += SA_b[4]; lb += SA_b[5]; PA_b_lo[2] = pk2(SA_b[4], SA_b[5]); XPROBE(SA_b[4]); \
        SA_b[6] = EX2(SA_b[6]); SA_b[7] = EX2(SA_b[7]); \
        SBAR(); \
        kf1 = *(const LAS bf16x8*)(KNEXT0 + 4096); \
        oa1 = MFMA32(vf3, PB_a_hi, oa1); \
        lb += SA_b[6]; lb += SA_b[7]; PA_b_lo[3] = pk2(SA_b[6], SA_b[7]); XPROBE(SA_b[6]); \
        SA_b[8] = EX2(SA_b[8]); SA_b[9] = EX2(SA_b[9]); \
        SA_b[10] = EX2(SA_b[10]); SA_b[11] = EX2(SA_b[11]); \
        SBAR(); \
        kf2 = *(const LAS bf16x8*)(KNEXT0 + 2048); \
        ob0 = MFMA32(vf2, PB_b_hi, ob0); \
        lb += SA_b[8]; lb += SA_b[9]; PA_b_hi[0] = pk2(SA_b[8], SA_b[9]); XPROBE(SA_b[8]); \
        lb += SA_b[10]; lb += SA_b[11]; PA_b_hi[1] = pk2(SA_b[10], SA_b[11]); XPROBE(SA_b[10]); \
        SA_b[12] = EX2(SA_b[12]); SA_b[13] = EX2(SA_b[13]); \
        SBAR(); \
        kf3 = *(const LAS bf16x8*)(KNEXT0 + 6144); \
        ob1 = MFMA32(vf3, PB_b_hi, ob1); \
        lb += SA_b[12]; lb += SA_b[13]; PA_b_hi[2] = pk2(SA_b[12], SA_b[13]); XPROBE(SA_b[12]); \
        SA_b[14] = EX2(SA_b[14]); SA_b[15] = EX2(SA_b[15]); \
        lb += SA_b[14]; lb += SA_b[15]; PA_b_hi[3] = pk2(SA_b[14], SA_b[15]); XPROBE(SA_b[14]); \
        SBAR(); \
        vf0 = *(const LAS bf16x8*)(VCUR0 + 0); \
        SA_a = MFMA32(kf0, qa[0], ZERO16); \
        SB_a[0] = EX2(SB_a[0]); SB_a[1] = EX2(SB_a[1]); \
        SB_a[2] = EX2(SB_a[2]); SB_a[3] = EX2(SB_a[3]); \
        SBAR(); \
        vf1 = *(const LAS bf16x8*)(VCUR0 + 512); \
        SA_b = MFMA32(kf1, qb[0], ZERO16); \
        la += SB_a[0]; la += SB_a[1]; PB_a_lo[0] = pk2(SB_a[0], SB_a[1]); XPROBE(SB_a[0]); \
        la += SB_a[2]; la += SB_a[3]; PB_a_lo[1] = pk2(SB_a[2], SB_a[3]); XPROBE(SB_a[2]); \
        SB_a[4] = EX2(SB_a[4]); SB_a[5] = EX2(SB_a[5]); \
        SBAR(); \
        SA_a = MFMA32(kf2, qa[1], SA_a); \
        la += SB_a[4]; la += SB_a[5]; PB_a_lo[2] = pk2(SB_a[4], SB_a[5]); XPROBE(SB_a[4]); \
        SB_a[6] = EX2(SB_a[6]); SB_a[7] = EX2(SB_a[7]); \
        SBAR(); \
        SA_b = MFMA32(kf3, qb[1], SA_b); \
        la += SB_a[6]; la += SB_a[7]; PB_a_lo[3] = pk2(SB_a[6], SB_a[7]); XPROBE(SB_a[6]); \
        SB_a[8] = EX2(SB_a[8]); SB_a[9] = EX2(SB_a[9]); \
        SB_a[10] = EX2(SB_a[10]); SB_a[11] = EX2(SB_a[11]); \
        SBAR(); \
        vf2 = *(const LAS bf16x8*)(VCUR0 + 2048); \
        oa0 = MFMA32(vf0, PA_a_lo, oa0); \
        la += SB_a[8]; la += SB_a[9]; PB_a_hi[0] = pk2(SB_a[8], SB_a[9]); XPROBE(SB_a[8]); \
        la += SB_a[10]; la += SB_a[11]; PB_a_hi[1] = pk2(SB_a[10], SB_a[11]); XPROBE(SB_a[10]); \
        SB_a[12] = EX2(SB_a[12]); SB_a[13] = EX2(SB_a[13]); \
        SBAR(); \
        vf3 = *(const LAS bf16x8*)(VCUR0 + 2560); \
        oa1 = MFMA32(vf1, PA_a_lo, oa1); \
        la += SB_a[12]; la += SB_a[13]; PB_a_hi[2] = pk2(SB_a[12], SB_a[13]); XPROBE(SB_a[12]); \
        SB_a[14] = EX2(SB_a[14]); SB_a[15] = EX2(SB_a[15]); \
        SBAR(); \
        ob0 = MFMA32(vf0, PA_b_lo, ob0); \
        la += SB_a[14]; la += SB_a[15]; PB_a_hi[3] = pk2(SB_a[14], SB_a[15]); XPROBE(SB_a[14]); \
        SB_b[0] = EX2(SB_b[0]); SB_b[1] = EX2(SB_b[1]); \
        SB_b[2] = EX2(SB_b[2]); SB_b[3] = EX2(SB_b[3]); \
        SBAR(); \
        ob1 = MFMA32(vf1, PA_b_lo, ob1); \
        lb += SB_b[0]; lb += SB_b[1]; PB_b_lo[0] = pk2(SB_b[0], SB_b[1]); XPROBE(SB_b[0]); \
        lb += SB_b[2]; lb += SB_b[3]; PB_b_lo[1] = pk2(SB_b[2], SB_b[3]); XPROBE(SB_b[2]); \
        SB_b[4] = EX2(SB_b[4]); SB_b[5] = EX2(SB_b[5]); \
        SBAR(); \
        kf0 = *(const LAS bf16x8*)(KNEXT1 + 0); \
        oa0 = MFMA32(vf2, PA_a_hi, oa0); \
        lb += SB_b[4]; lb += SB_b[5]; PB_b_lo[2] = pk2(SB_b[4], SB_b[5]); XPROBE(SB_b[4]); \
        SB_b[6] = EX2(SB_b[6]); SB_b[7] = EX2(SB_b[7]); \
        SBAR(); \
        kf1 = *(const LAS bf16x8*)(KNEXT1 + 4096); \
        oa1 = MFMA32(vf3, PA_a_hi, oa1); \
        lb += SB_b[6]; lb += SB_b[7]; PB_b_lo[3] = pk2(SB_b[6], SB_b[7]); XPROBE(SB_b[6]); \
        SB_b[8] = EX2(SB_b[8]); SB_b[9] = EX2(SB_b[9]); \
        SB_b[10] = EX2(SB_b[10]); SB_b[11] = EX2(SB_b[11]); \
        SBAR(); \
        kf2 = *(const LAS bf16x8*)(KNEXT1 + 2048); \
        ob0 = MFMA32(vf2, PA_b_hi, ob0); \
        lb += SB_b[8]; lb += SB_b[9]; PB_b_hi[0] = pk2(SB_b[8], SB_b[9]); XPROBE(SB_b[8]); \
        lb += SB_b[10]; lb += SB_b[11]; PB_b_hi[1] = pk2(SB_b[10], SB_b[11]); XPROBE(SB_b[10]); \
        SB_b[12] = EX2(SB_b[12]); SB_b[13] = EX2(SB_b[13]); \
        SBAR(); \
        kf3 = *(const LAS bf16x8*)(KNEXT1 + 6144); \
        ob1 = MFMA32(vf3, PA_b_hi, ob1); \
        lb += SB_b[12]; lb += SB_b[13]; PB_b_hi[2] = pk2(SB_b[12], SB_b[13]); XPROBE(SB_b[12]); \
        SB_b[14] = EX2(SB_b[14]); SB_b[15] = EX2(SB_b[15]); \
        lb += SB_b[14]; lb += SB_b[15]; PB_b_hi[3] = pk2(SB_b[14], SB_b[15]); XPROBE(SB_b[14]); \
        SBAR(); \
    } while (0)

template <int DK, bool DIFF>
__device__ __forceinline__ void attn_dense_unit(const bf16* Q, int qp, int wave_rows, int nrows, size_t q_off1, const bf16* Kt, const bf16* Vt, int ntiles, bf16* O, size_t o_off1,
                                                LAS unsigned char* lds, int tid_in, const float* lamp, const float* gsub) {
    int tid = tid_in; asm volatile("" : "+v"(tid));
    constexpr int KB = 128 * DK;
    constexpr int KPIECES = DK / 8;
    constexpr int BUF = KB + 8192;
    constexpr int NS = DIFF ? 2 : DK / 16;
    const int lane = tid & 63, r = lane & 31, hi = lane >> 5; const int wid = __builtin_amdgcn_readfirstlane(tid >> 6);
    const bool valid = wave_rows * wid < nrows;
    const size_t wrow = valid ? (size_t)(wave_rows * wid + r) : (size_t)r;
    const bf16* qrow = Q + wrow * qp;
    bf16x8 qa[NS], qb[NS];
#pragma unroll
    for (int s = 0; s < NS; ++s) { qa[s] = *(const bf16x8*)(qrow + 16 * s + 8 * hi); qb[s] = *(const bf16x8*)(qrow + (DIFF ? 32 : q_off1) + 16 * s + 8 * hi); }
    f32x16 oa0 = {}, oa1 = {}, ob0 = {}, ob1 = {}; float la = 0.f, lb = 0.f;
    const int koff = hi * 1024 + pi32(r) * 16, voff = hi * 1024 + r * 16;
#define ATT_STAGE(t, slot) do { \
        const char* kg = (const char*)Kt + (size_t)(t) * KB; const char* vg = (const char*)Vt + (size_t)(t) * 8192; \
        __builtin_amdgcn_global_load_lds((const unsigned*)(kg + wid * 1024 + lane * 16), (LAS unsigned*)(lds + (slot) * BUF + wid * 1024), 16, 0, 0); \
        if (KPIECES > 8 && wid < KPIECES - 8) __builtin_amdgcn_global_load_lds((const unsigned*)(kg + (wid + 8) * 1024 + lane * 16), (LAS unsigned*)(lds + (slot) * BUF + (wid + 8) * 1024), 16, 0, 0); \
        __builtin_amdgcn_global_load_lds((const unsigned*)(vg + wid * 1024 + lane * 16), (LAS unsigned*)(lds + (slot) * BUF + KB + wid * 1024), 16, 0, 0); } while (0)
    ATT_STAGE(0, 0); ATT_STAGE(1, 1);
    VM_WAIT(); __syncthreads();
    f32x16 SA_a = {}, SA_b = {}, SB_a, SB_b;
    u32x4 PA_a_lo_, PA_a_hi_, PA_b_lo_, PA_b_hi_, PB_a_lo_, PB_a_hi_, PB_b_lo_, PB_b_hi_;
    { unsigned z = 0u; asm volatile("" : "+v"(z)); PB_a_lo_ = (u32x4){z, z, z, z}; PB_a_hi_ = PB_a_lo_; PB_b_lo_ = PB_a_lo_; PB_b_hi_ = PB_a_lo_; }
    bf16x8 kf0, kf1, kf2, kf3, vf0, vf1, vf2, vf3;
#define PA_a_lo PA_a_lo_
#define PA_a_hi PA_a_hi_
#define PA_b_lo PA_b_lo_
#define PA_b_hi PA_b_hi_
#define PB_a_lo PB_a_lo_
#define PB_a_hi PB_a_hi_
#define PB_b_lo PB_b_lo_
#define PB_b_hi PB_b_hi_
#undef MFMA32
#define MFMA32(A, B, C) __builtin_amdgcn_mfma_f32_32x32x16_bf16(__builtin_bit_cast(bf16x8, (A)), __builtin_bit_cast(bf16x8, (B)), (C), 0, 0, 0)
    {
        const LAS unsigned char* kp_ = lds + koff;
#pragma unroll
        for (int st = 0; st < NS; ++st) {
            if constexpr (!DIFF) { const bf16x8 kf = *(const LAS bf16x8*)(kp_ + st * 2048); SA_a = MFMA32(kf, qa[st], SA_a); SA_b = MFMA32(kf, qb[st], SA_b); }
            else { const bf16x8 k1 = *(const LAS bf16x8*)(kp_ + st * 2048), k2 = *(const LAS bf16x8*)(kp_ + (st + 2) * 2048); SA_a = MFMA32(k1, qa[st], SA_a); SA_b = MFMA32(k2, qb[st], SA_b); } }
    }
    if constexpr (DIFF) { ATT_DIFF_PRE(lds + 512 + koff); } else if constexpr (DK == 96) { ATT_MLA_PRE(lds + 512 + koff); } else { ATT_GQA_PRE(lds + 512 + koff); }
    int sp = 0, s0 = 0, s1 = 1, s2 = 2;
#pragma unroll 1
    for (int t = 0; t < ntiles; ++t) {
        { const int tn = min(t + 2, ntiles - 1); ATT_STAGE(tn, s2); }
        const LAS unsigned char* kcur1 = lds + s0 * BUF + 512 + koff; const LAS unsigned char* knext0 = lds + s1 * BUF + koff; const LAS unsigned char* knext1 = knext0 + 512;
        const LAS unsigned char* vprev1 = lds + sp * BUF + KB + 4096 + voff; const LAS unsigned char* vcur0 = lds + s0 * BUF + KB + voff;
        if constexpr (DIFF) { ATT_DIFF_ITER(kcur1, knext0, knext1, vprev1, vcur0); }
        else if constexpr (DK == 96) { ATT_MLA_ITER(kcur1, knext0, knext1, vprev1, vcur0); }
        else { ATT_GQA_ITER(kcur1, knext0, knext1, vprev1, vcur0); }
        sp = s0; s0 = s1; s1 = s2; s2 = (s2 + 1) & 3;
        VM_WAIT(); __syncthreads();
    }
    {
        const LAS unsigned char* vp_ = lds + sp * BUF + KB + 4096 + voff;
        const bf16x8 v00 = *(const LAS bf16x8*)(vp_), v01 = *(const LAS bf16x8*)(vp_ + 512), v10 = *(const LAS bf16x8*)(vp_ + 2048), v11 = *(const LAS bf16x8*)(vp_ + 2560);
        oa0 = MFMA32(v00, PB_a_lo, oa0); oa1 = MFMA32(v01, PB_a_lo, oa1); ob0 = MFMA32(v00, PB_b_lo, ob0); ob1 = MFMA32(v01, PB_b_lo, ob1);
        oa0 = MFMA32(v10, PB_a_hi, oa0); oa1 = MFMA32(v11, PB_a_hi, oa1); ob0 = MFMA32(v10, PB_b_hi, ob0); ob1 = MFMA32(v11, PB_b_hi, ob1);
    }
#undef MFMA32
#define MFMA32(A, B, C) __builtin_amdgcn_mfma_f32_32x32x16_bf16((A), (B), (C), 0, 0, 0)
#undef PA_a_lo
#undef PA_a_hi
#undef PA_b_lo
#undef PA_b_hi
#undef PB_a_lo
#undef PB_a_hi
#undef PB_b_lo
#undef PB_b_hi
#undef ATT_STAGE
    int tid2 = tid_in; asm volatile("" : "+v"(tid2));
    const int lane2 = tid2 & 63, r2 = lane2 & 31, hi2 = lane2 >> 5; const int wid2 = __builtin_amdgcn_readfirstlane(tid2 >> 6);
    const bool valid2 = wave_rows * wid2 < nrows;
    bf16* orow = O + (valid2 ? (size_t)(wave_rows * wid2 + r2) : (size_t)r2) * D;
    la += shx(la, 32); lb += shx(lb, 32);
    if constexpr (!DIFF) {
        const float ia = __builtin_amdgcn_rcpf(la), ib = __builtin_amdgcn_rcpf(lb);
#pragma unroll
        for (int i = 0; i < 16; ++i) { oa0[i] *= ia; oa1[i] *= ia; ob0[i] *= ib; ob1[i] *= ib; }
        if (valid2) { store_ot(orow, oa0, oa1, hi2); store_ot(orow + o_off1, ob0, ob1, hi2); }
    } else {
        const float lam = lamp[0], lam_scale = lamp[1]; const float ia = __builtin_amdgcn_rcpf(la), ib = lam * __builtin_amdgcn_rcpf(lb); float ss = 0.f;
#pragma unroll
        for (int i = 0; i < 16; ++i) { oa0[i] = oa0[i] * ia - ob0[i] * ib; oa1[i] = oa1[i] * ia - ob1[i] * ib; ss += oa0[i] * oa0[i] + oa1[i] * oa1[i]; }
        ss += shx(ss, 32);
        const float rr = rsqrtf(ss * (1.f / 64.f) + EPS) * lam_scale;
#pragma unroll
        for (int i = 0; i < 16; ++i) { const int dv = 8 * (i >> 2) + 4 * hi2 + (i & 3); oa0[i] *= rr * gsub[dv]; oa1[i] *= rr * gsub[32 + dv]; }
        if (valid2) store_ot(orow, oa0, oa1, hi2);
    }
    __syncthreads();
}
__device__ __forceinline__ void attn_na_unit(const Args& a, int b, int h, int g, LAS unsigned char* lds, const LAS float* bias_l, int tid_in) {
    int tid = tid_in; asm volatile("" : "+v"(tid));
    const int lane = tid & 63, r = lane & 31, hi = lane >> 5; const int wid = __builtin_amdgcn_readfirstlane(tid >> 6);
    const int wr = wid >> 1, qb = wid & 1, gr = 4 * g + wr;
    const int m = b * SEQ + gr * 64 + 32 * qb + r;
    const bf16* qrow = (const bf16*)(a.ws + WS_QNA) + (size_t)m * 256 + 64 * h;
    bf16x8 qf[4];
#pragma unroll
    for (int s = 0; s < 4; ++s) qf[s] = *(const bf16x8*)(qrow + 16 * s + 8 * hi);
    const int c = 32 * qb + r, c0 = min(max(c - 8, 0), 48), r0 = min(max(gr - 4, 0), 248);
    const int lo = min(max(4 * g - 4, 0), 248), hiw = min(max(4 * g - 1, 0), 248) + 7, ntile = 4 + (hiw - lo + 1);
    const bf16* Kt = ktile_ptr(a.ws, WS_KNA, 4, 64, b, h, 0); const bf16* Vt = ktile_ptr(a.ws, WS_VNA, 4, 64, b, h, 0);
    f32x16 o0 = {}, o1 = {}; float l0 = 0.f;
    const int koff = hi * 1024 + pi32(r) * 16, voff = hi * 1024 + r * 16;
    int boff[2][16];
#pragma unroll
    for (int kb = 0; kb < 2; ++kb)
#pragma unroll
        for (int i = 0; i < 16; ++i) { const int kc = 32 * kb + 16 * (i >> 3) + 8 * hi + (i & 7); const bool ok = (kc >= c0) && (kc < c0 + 16);
            boff[kb][i] = 4 * (ok ? min(max(kc - c + 15, 0), 30) : 31); }
#define NA_STAGE(t, buf) do { const int kt_ = (t) < 4 ? (t) : 4 + lo + ((t) - 4); \
        const char* kg = (const char*)Kt + (size_t)kt_ * 8192; const char* vg = (const char*)Vt + (size_t)kt_ * 8192; \
        __builtin_amdgcn_global_load_lds((const unsigned*)(kg + wid * 1024 + lane * 16), (LAS unsigned*)(lds + (buf) * 16384 + wid * 1024), 16, 0, 0); \
        __builtin_amdgcn_global_load_lds((const unsigned*)(vg + wid * 1024 + lane * 16), (LAS unsigned*)(lds + (buf) * 16384 + 8192 + wid * 1024), 16, 0, 0); } while (0)
    NA_STAGE(0, 0); NA_STAGE(1, 1); NA_STAGE(2, 2);
#pragma unroll 1
    for (int t = 0; t < ntile; ++t) {
        if (t + 2 < ntile) asm volatile("s_waitcnt vmcnt(4)" ::: "memory"); else if (t + 1 < ntile) asm volatile("s_waitcnt vmcnt(2)" ::: "memory"); else VM_WAIT();
        __syncthreads();
        if (t + 3 < ntile) NA_STAGE(t + 3, (t + 3) & 3);
        const int wrow = lo + (t - 4);
        const bool win = t >= 4; const bool rel = !win || (wrow >= r0 && wrow < r0 + 8);
        if (rel) {
            const LAS unsigned char* kb_ = lds + (t & 3) * 16384; const LAS unsigned char* vb_ = kb_ + 8192;
            const LAS unsigned char* brow = (const LAS unsigned char*)bias_l + (win ? (wrow - gr + 7) * 128 : 0);
#pragma unroll
            for (int kb = 0; kb < 2; ++kb) {
                f32x16 s = {};
#pragma unroll
                for (int st = 0; st < 4; ++st) { const bf16x8 kf = *(const LAS bf16x8*)(kb_ + st * 2048 + kb * 512 + koff); s = MFMA32(kf, qf[st], s); }
                const bool dead0 = win && kb == 0 && qb == 1, dead1 = win && kb == 1 && qb == 0;
                if (win) {
#pragma unroll
                    for (int hf = 0; hf < 2; ++hf) {
                        if (hf == 0 ? dead0 : dead1) {
#pragma unroll
                            for (int i = 8 * hf; i < 8 * hf + 8; ++i) s[i] = 0.f;
                        } else {
#pragma unroll
                            for (int i = 8 * hf; i < 8 * hf + 8; ++i) { const float bias = *(const LAS float*)(brow + boff[kb][i]); s[i] = __builtin_amdgcn_exp2f(s[i] + bias); l0 += s[i]; }
                        }
                    }
                } else {
#pragma unroll
                    for (int i = 0; i < 16; ++i) { s[i] = __builtin_amdgcn_exp2f(s[i]); l0 += s[i]; }
                }
                const bf16x8 p0 = pack8(s, 0), p1 = pack8(s, 8);
                const bf16x8 v00 = *(const LAS bf16x8*)(vb_ + (4 * kb + 0) * 1024 + voff), v01 = *(const LAS bf16x8*)(vb_ + (4 * kb + 0) * 1024 + 512 + voff);
                const bf16x8 v10 = *(const LAS bf16x8*)(vb_ + (4 * kb + 2) * 1024 + voff), v11 = *(const LAS bf16x8*)(vb_ + (4 * kb + 2) * 1024 + 512 + voff);
                if (!dead0) { o0 = MFMA32(v00, p0, o0); o1 = MFMA32(v01, p0, o1); }
                if (!dead1) { o0 = MFMA32(v10, p1, o0); o1 = MFMA32(v11, p1, o1); }
            }
        }
    }
#undef NA_STAGE
    l0 += shx(l0, 32);
    const float i0 = __builtin_amdgcn_rcpf(l0);
#pragma unroll
    for (int i = 0; i < 16; ++i) { o0[i] *= i0; o1[i] *= i0; }
    store_ot((bf16*)(a.ws + WS_O) + (size_t)m * D + 64 * h, o0, o1, hi);
    __syncthreads();
}
__device__ __forceinline__ void attn_phase(const Args& a, int l, LAS unsigned char* lds, int tid, int vcu, int G) {
    unsigned char* ws = a.ws; bf16* O = (bf16*)(ws + WS_O);
    const float* lamp = (const float*)(ws + WS_LAM) + 2 * l; const float* gsub = a.in[I_GDSUB] + l * 64;
    const bool ctxq = (l == 0);
#define CTX_LOOP(c, coff, n) for (int c = (((vcu - (coff)) % G) + G) % G; c < (ctxq ? (n) : 0); c += G)
    for (int u = vcu; u < 256; u += G) { const int bh = u >> 5, b = bh >> 2, h = bh & 3; const size_t m0 = (size_t)b * SEQ + 512 * (u & 31);
        attn_dense_unit<96, false>((const bf16*)(ws + WS_QMLA) + m0 * 384 + 96 * h, 384, 64, 512, (size_t)32 * 384, ktile_ptr(ws, WS_KMLA, 4, 96, b, h, 0), ktile_ptr(ws, WS_VMLA, 4, 64, b, h, 0), NTILE,
                                   O + m0 * D + 256 + 64 * h, (size_t)32 * D, lds, tid, lamp, gsub); }
    CTX_LOOP(c, 0, 8) { const int b = c >> 2, h = c & 3; const size_t m0 = (size_t)NLAT + b * CTXL;
        attn_dense_unit<96, false>((const bf16*)(ws + WS_QMLA) + m0 * 384 + 96 * h, 384, 64, 256, (size_t)32 * 384, ktile_ptr(ws, WS_KMLA, 4, 96, b, h, 0), ktile_ptr(ws, WS_VMLA, 4, 64, b, h, 0), 4,
                                   O + m0 * D + 256 + 64 * h, (size_t)32 * D, lds, tid, lamp, gsub); }
    for (int u = vcu; u < 512; u += G) { const int bh = (u & 255) >> 5, qt = (u & 31) + 32 * (u >> 8), b = bh >> 2, h = bh & 3; const size_t m0 = (size_t)b * SEQ + 256 * qt;
        attn_dense_unit<64, true>((const bf16*)(ws + WS_QDIFF) + m0 * 256 + 64 * h, 256, 32, 256, 0, ktile_ptr(ws, WS_KDIFF, 4, 64, b, h, 0), ktile_ptr(ws, WS_VDIFF, 4, 64, b, h, 0), NTILE,
                                  O + m0 * D + 512 + 64 * h, 0, lds, tid, lamp, gsub); }
    CTX_LOOP(c, 8, 8) { const int b = c >> 2, h = c & 3; const size_t m0 = (size_t)NLAT + b * CTXL;
        attn_dense_unit<64, true>((const bf16*)(ws + WS_QDIFF) + m0 * 256 + 64 * h, 256, 32, 256, 0, ktile_ptr(ws, WS_KDIFF, 4, 64, b, h, 0), ktile_ptr(ws, WS_VDIFF, 4, 64, b, h, 0), 4,
                                  O + m0 * D + 512 + 64 * h, 0, lds, tid, lamp, gsub); }
    for (int u = vcu; u < 256; u += G) { const int bk = u >> 6, b = bk >> 1, kh = bk & 1; const size_t m0 = (size_t)b * SEQ + 256 * (u & 63);
        attn_dense_unit<64, false>((const bf16*)(ws + WS_QGQA) + m0 * 256 + 128 * kh, 256, 32, 256, 64, ktile_ptr(ws, WS_KGQA, 2, 64, b, kh, 0), ktile_ptr(ws, WS_VGQA, 2, 64, b, kh, 0), NTILE,
                                   O + m0 * D + 768 + 128 * kh, 64, lds, tid, lamp, gsub); }
    CTX_LOOP(c, 16, 4) { const int b = c >> 1, kh = c & 1; const size_t m0 = (size_t)NLAT + b * CTXL;
        attn_dense_unit<64, false>((const bf16*)(ws + WS_QGQA) + m0 * 256 + 128 * kh, 256, 32, 256, 64, ktile_ptr(ws, WS_KGQA, 2, 64, b, kh, 0), ktile_ptr(ws, WS_VGQA, 2, 64, b, kh, 0), 4,
                                   O + m0 * D + 768 + 128 * kh, 64, lds, tid, lamp, gsub); }
    { LAS float* bl = (LAS float*)(lds + 65536); const float* rpb = a.in[I_RPB] + (size_t)l * 4 * 465;
      for (int i = tid; i < 4 * 480; i += 512) { const int h = i / 480, rem = i % 480, dy = rem >> 5, dx = rem & 31; bl[i] = dx < 31 ? rpb[h * 465 + dy * 31 + dx] * LOG2E : -3.0e38f; }
      __syncthreads();
      for (int u = vcu; u < 512; u += G) { const int bh = u >> 6, b = bh >> 2, h = bh & 3; attn_na_unit(a, b, h, u & 63, lds, bl + h * 480, tid); } }
    CTX_LOOP(c, 24, 8) { const int b = c >> 2, h = c & 3; const size_t m0 = (size_t)NLAT + b * CTXL;
        attn_dense_unit<64, false>((const bf16*)(ws + WS_QNA) + m0 * 256 + 64 * h, 256, 64, 256, (size_t)32 * 256, ktile_ptr(ws, WS_KNA, 4, 64, b, h, 0), ktile_ptr(ws, WS_VNA, 4, 64, b, h, 0), 4,
                                   O + m0 * D + 64 * h, (size_t)32 * D, lds, tid, lamp, gsub); }
#undef CTX_LOOP
}

__device__ __forceinline__ void up2_phase(const Args& a, int l, int lane_in, int wave, int vcu, int G) {
    const int gw = vcu * 8 + wave, NGW = G * 8;
    const bf16* P = (const bf16*)(a.ws + WS_P); const bf16* W2 = w_2(a, l);
    for (int it = gw; it < NTT * NJ2; it += NGW) {
        int lane = lane_in; asm volatile("" : "+v"(lane));
        const int r = lane & 31, hi = lane >> 5, pr = pi32(r);
        const int T = it / NJ2, j = it % NJ2; const TokTile tt = tok_tile(T);
        if (j < 4) {
            const bf16* wrow0 = W2 + (size_t)(4 * j) * 24 * 512 + (hi * 32 + pr) * 8;
            const bf16* wrow2 = W2 + (size_t)(4 * j + 2) * 24 * 512 + (hi * 32 + r) * 8;
            const bf16* arow = P + (((size_t)T * (NP / 8) + 96 + hi) * 64 + r) * 8;
            f32x16 acc[3][2];
#pragma unroll
            for (int nb = 0; nb < 3; ++nb) { acc[nb][0] = (f32x16){}; acc[nb][1] = (f32x16){}; }
#pragma unroll 1
            for (int kg = 0; kg < 4; ++kg) {
                bf16x8 wf[4][3], af[4][2];
#pragma unroll
                for (int st = 0; st < 4; ++st) wf[st][0] = *(const bf16x8*)(wrow0 + (4 * kg + st) * 512);
#pragma unroll
                for (int st = 0; st < 4; ++st) wf[st][1] = *(const bf16x8*)(wrow0 + 24 * 512 + (4 * kg + st) * 512);
#pragma unroll
                for (int st = 0; st < 4; ++st) wf[st][2] = *(const bf16x8*)(wrow2 + (4 * kg + st) * 512);
#pragma unroll
                for (int st = 0; st < 4; ++st) af[st][0] = *(const bf16x8*)(arow + (4 * kg + st) * 1024);
#pragma unroll
                for (int st = 0; st < 4; ++st) af[st][1] = *(const bf16x8*)(arow + 256 + (4 * kg + st) * 1024);
                __builtin_amdgcn_sched_barrier(0);
#pragma unroll
                for (int st = 0; st < 4; ++st)
#pragma unroll
                    for (int nb = 0; nb < 3; ++nb) { acc[nb][0] = MFMA32(wf[st][nb], af[st][0], acc[nb][0]); acc[nb][1] = MFMA32(wf[st][nb], af[st][1], acc[nb][1]); }
            }
            const float* g = a.in[I_GMQ] + l * 96;
            f32x4 gv[12];
#pragma unroll
            for (int nb = 0; nb < 2; ++nb)
#pragma unroll
                for (int run = 0; run < 2; ++run) { const float* gp = g + 32 * nb + 16 * run + 8 * hi; gv[4 * nb + 2 * run] = *(const f32x4*)gp; gv[4 * nb + 2 * run + 1] = *(const f32x4*)(gp + 4); }
#pragma unroll
            for (int aa = 0; aa < 4; ++aa) gv[8 + aa] = *(const f32x4*)(g + 64 + 8 * aa + 4 * hi);
            __builtin_amdgcn_sched_barrier(0);
#pragma unroll
            for (int tb = 0; tb < 2; ++tb) {
                float ss = 0.f;
#pragma unroll
                for (int nb = 0; nb < 3; ++nb)
#pragma unroll
                    for (int i = 0; i < 16; ++i) ss += acc[nb][tb][i] * acc[nb][tb][i];
                ss += shx(ss, 32);
                const float rr = rsqrtf(ss * (1.f / 96.f) + EPS);
                bf16* dst = (bf16*)(a.ws + WS_QMLA) + (size_t)(tt.m0 + 32 * tb + r) * 384 + 96 * j;
#pragma unroll
                for (int nb = 0; nb < 2; ++nb)
#pragma unroll
                    for (int run = 0; run < 2; ++run) { const f32x4 g0 = gv[4 * nb + 2 * run], g1 = gv[4 * nb + 2 * run + 1]; const int b = 8 * run; const float sc = rr * C2_96;
                        u32x4 w; w.x = pk2(acc[nb][tb][b] * sc * g0.x, acc[nb][tb][b + 1] * sc * g0.y); w.y = pk2(acc[nb][tb][b + 2] * sc * g0.z, acc[nb][tb][b + 3] * sc * g0.w);
                        w.z = pk2(acc[nb][tb][b + 4] * sc * g1.x, acc[nb][tb][b + 5] * sc * g1.y); w.w = pk2(acc[nb][tb][b + 6] * sc * g1.z, acc[nb][tb][b + 7] * sc * g1.w);
                        *(u32x4*)(dst + 32 * nb + 16 * run + 8 * hi) = w; }
                float v[16];
#pragma unroll
                for (int aa = 0; aa < 4; ++aa) { v[4 * aa] = acc[2][tb][4 * aa] * rr * gv[8 + aa].x; v[4 * aa + 1] = acc[2][tb][4 * aa + 1] * rr * gv[8 + aa].y; v[4 * aa + 2] = acc[2][tb][4 * aa + 2] * rr * gv[8 + aa].z; v[4 * aa + 3] = acc[2][tb][4 * aa + 3] * rr * gv[8 + aa].w; }
                if (tt.lat) { const float tr = (float)tt.prow, tc = (float)(32 * tb + r);
#pragma unroll
                    for (int b = 0; b < 4; ++b) { const float inv = hi ? ROPE_INVR[2 * (4 + b)] : ROPE_INVR[2 * b];
                        { const float t = __builtin_amdgcn_fractf(tr * inv); const float c = __builtin_amdgcn_cosf(t), s = __builtin_amdgcn_sinf(t); const float x1 = v[b], x2 = v[4 + b]; v[b] = x1 * c - x2 * s; v[4 + b] = x1 * s + x2 * c; }
                        { const float t = __builtin_amdgcn_fractf(tc * inv); const float c = __builtin_amdgcn_cosf(t), s = __builtin_amdgcn_sinf(t); const float x1 = v[8 + b], x2 = v[12 + b]; v[8 + b] = x1 * c - x2 * s; v[12 + b] = x1 * s + x2 * c; } } }
#pragma unroll
                for (int aa = 0; aa < 4; ++aa) { u32x2 w; w.x = pk2(v[4 * aa] * C2_96, v[4 * aa + 1] * C2_96); w.y = pk2(v[4 * aa + 2] * C2_96, v[4 * aa + 3] * C2_96); *(u32x2*)(dst + 64 + 8 * aa + 4 * hi) = w; }
            }
        } else if (j < 8) {
            const int h = j - 4;
            const bf16* wrow = W2 + ((size_t)(16 + 4 * h) * 24 + 16) * 512 + (hi * 32 + pr) * 8;
            const bf16* arow = P + (((size_t)T * (NP / 8) + 128 + hi) * 64 + r) * 8;
            f32x16 acc[2][2];
#pragma unroll
            for (int nb = 0; nb < 2; ++nb) { acc[nb][0] = (f32x16){}; acc[nb][1] = (f32x16){}; }
#pragma unroll 1
            for (int kg = 0; kg < 2; ++kg) {
                bf16x8 wf[4][2], af[4][2];
#pragma unroll
                for (int st = 0; st < 4; ++st) wf[st][0] = *(const bf16x8*)(wrow + (4 * kg + st) * 512);
#pragma unroll
                for (int st = 0; st < 4; ++st) wf[st][1] = *(const bf16x8*)(wrow + 24 * 512 + (4 * kg + st) * 512);
#pragma unroll
                for (int st = 0; st < 4; ++st) af[st][0] = *(const bf16x8*)(arow + (4 * kg + st) * 1024);
#pragma unroll
                for (int st = 0; st < 4; ++st) af[st][1] = *(const bf16x8*)(arow + 256 + (4 * kg + st) * 1024);
                __builtin_amdgcn_sched_barrier(0);
#pragma unroll
                for (int st = 0; st < 4; ++st)
#pragma unroll
                    for (int nb = 0; nb < 2; ++nb) { acc[nb][0] = MFMA32(wf[st][nb], af[st][0], acc[nb][0]); acc[nb][1] = MFMA32(wf[st][nb], af[st][1], acc[nb][1]); }
            }
            const float* g = a.in[I_GKN] + l * 64;
            f32x4 gv[8];
#pragma unroll
            for (int nb = 0; nb < 2; ++nb)
#pragma unroll
                for (int run = 0; run < 2; ++run) { const float* gp = g + 32 * nb + 16 * run + 8 * hi; gv[4 * nb + 2 * run] = *(const f32x4*)gp; gv[4 * nb + 2 * run + 1] = *(const f32x4*)(gp + 4); }
            __builtin_amdgcn_sched_barrier(0);
            bf16* kt = ktile_ptr(a.ws, WS_KMLA, 4, 96, tt.b, h, tt.ktile);
#pragma unroll
            for (int tb = 0; tb < 2; ++tb) {
                float ss = 0.f;
#pragma unroll
                for (int nb = 0; nb < 2; ++nb)
#pragma unroll
                    for (int i = 0; i < 16; ++i) ss += acc[nb][tb][i] * acc[nb][tb][i];
                ss += shx(ss, 32);
                const float rr = rsqrtf(ss * (1.f / 64.f) + EPS);
#pragma unroll
                for (int nb = 0; nb < 2; ++nb)
#pragma unroll
                    for (int run = 0; run < 2; ++run) { const f32x4 g0 = gv[4 * nb + 2 * run], g1 = gv[4 * nb + 2 * run + 1]; const int b = 8 * run;
                        u32x4 w; w.x = pk2(acc[nb][tb][b] * rr * g0.x, acc[nb][tb][b + 1] * rr * g0.y); w.y = pk2(acc[nb][tb][b + 2] * rr * g0.z, acc[nb][tb][b + 3] * rr * g0.w);
                        w.z = pk2(acc[nb][tb][b + 4] * rr * g1.x, acc[nb][tb][b + 5] * rr * g1.y); w.w = pk2(acc[nb][tb][b + 6] * rr * g1.z, acc[nb][tb][b + 7] * rr * g1.w);
                        *(u32x4*)(kt + (size_t)(4 * nb + 2 * run + hi) * 512 + (32 * tb + r) * 8) = w; }
            }
        } else {
            const int h = j - 8;
            const bf16* wrow = W2 + ((size_t)(16 + 4 * h + 2) * 24 + 16) * 512 + (hi * 32 + r) * 8;
            const bf16* arow = P + (((size_t)T * (NP / 8) + 128 + hi) * 64 + pr) * 8;
            float ssv[2] = {0.f, 0.f};
            f32x16 acc[2][2];
#pragma unroll
            for (int tb = 0; tb < 2; ++tb) { acc[tb][0] = (f32x16){}; acc[tb][1] = (f32x16){}; }
#pragma unroll 1
            for (int kg = 0; kg < 2; ++kg) {
                bf16x8 wf[4][2], af[4][2];
#pragma unroll
                for (int st = 0; st < 4; ++st) wf[st][0] = *(const bf16x8*)(wrow + (4 * kg + st) * 512);
#pragma unroll
                for (int st = 0; st < 4; ++st) wf[st][1] = *(const bf16x8*)(wrow + 24 * 512 + (4 * kg + st) * 512);
#pragma unroll
                for (int st = 0; st < 4; ++st) af[st][0] = *(const bf16x8*)(arow + (4 * kg + st) * 1024);
#pragma unroll
                for (int st = 0; st < 4; ++st) af[st][1] = *(const bf16x8*)(arow + 256 + (4 * kg + st) * 1024);
                __builtin_amdgcn_sched_barrier(0);
#pragma unroll
                for (int st = 0; st < 4; ++st)
#pragma unroll
                    for (int tb = 0; tb < 2; ++tb) { acc[tb][0] = MFMA32(af[st][tb], wf[st][0], acc[tb][0]); acc[tb][1] = MFMA32(af[st][tb], wf[st][1], acc[tb][1]);
                        const u32x4 w = __builtin_bit_cast(u32x4, af[st][tb]);
                        const float a0 = __uint_as_float(w.x << 16), a1 = __uint_as_float(w.x & 0xffff0000u), a2 = __uint_as_float(w.y << 16), a3 = __uint_as_float(w.y & 0xffff0000u),
                                    a4 = __uint_as_float(w.z << 16), a5 = __uint_as_float(w.z & 0xffff0000u), a6 = __uint_as_float(w.w << 16), a7 = __uint_as_float(w.w & 0xffff0000u);
                        ssv[tb] += ((a0 * a0 + a1 * a1) + (a2 * a2 + a3 * a3)) + ((a4 * a4 + a5 * a5) + (a6 * a6 + a7 * a7)); }
            }
#pragma unroll
            for (int tb = 0; tb < 2; ++tb) { ssv[tb] += shx(ssv[tb], 32); const float rs = rsqrtf(ssv[tb] * (1.f / 128.f) + EPS);
#pragma unroll
                for (int i = 0; i < 16; ++i) { const float f = shl(rs, 8 * (i >> 2) + 4 * hi + (i & 3)); acc[tb][0][i] *= f; acc[tb][1][i] *= f; } }
            bf16* vt = ktile_ptr(a.ws, WS_VMLA, 4, 64, tt.b, h, tt.ktile);
#pragma unroll
            for (int tb = 0; tb < 2; ++tb)
#pragma unroll
                for (int nb = 0; nb < 2; ++nb)
#pragma unroll
                    for (int run = 0; run < 2; ++run) { const int b = 8 * run;
                        u32x4 w; w.x = pk2(acc[tb][nb][b], acc[tb][nb][b + 1]); w.y = pk2(acc[tb][nb][b + 2], acc[tb][nb][b + 3]); w.z = pk2(acc[tb][nb][b + 4], acc[tb][nb][b + 5]); w.w = pk2(acc[tb][nb][b + 6], acc[tb][nb][b + 7]);
                        *(u32x4*)(vt + (size_t)(4 * tb + 2 * run + hi) * 512 + (32 * nb + r) * 8) = w; }
        }
    }
}

using pg8::Unit; using pg8::BM; using pg8::HALF;
struct EpiRes {
    static constexpr bool PERM = false, AFTER_DRAIN = false;
    const float* xlat; const float* xctx; float* out; const float* mod;
    __device__ __forceinline__ void operator()(const f32x4 (&acc)[2][2][4][2], const Unit& u, int wr, int wc, int fr, int fq) const {
        const int row0 = u.pm * BM + wr * 64 + fr, col0 = u.pn * BM + wc * 32 + 4 * fq;
        const int set = u.pm < 64 ? 0 : (u.pm < 128 ? 1 : 2);
        const float* base = u.pm < 128 ? xlat : xctx - (size_t)NLAT * D;
        const float* g1 = mod + set * 6144 + 2048 + col0;
        f32x4 gv[2][2];
#pragma unroll
        for (int bj = 0; bj < 2; ++bj)
#pragma unroll
            for (int n = 0; n < 2; ++n) gv[bj][n] = *(const f32x4*)(g1 + bj * HALF + n * 16);
#pragma unroll
        for (int ai = 0; ai < 2; ++ai) {
            f32x4 bv[4][2][2];
#pragma unroll
            for (int m = 0; m < 4; ++m) { const size_t ro = (size_t)(row0 + ai * HALF + m * 16) * D + col0;
#pragma unroll
                for (int bj = 0; bj < 2; ++bj)
#pragma unroll
                    for (int n = 0; n < 2; ++n) bv[m][bj][n] = *(const f32x4*)(base + ro + bj * HALF + n * 16); }
            __builtin_amdgcn_sched_barrier(0);
#pragma unroll
            for (int m = 0; m < 4; ++m) { const size_t ro = (size_t)(row0 + ai * HALF + m * 16) * D + col0;
#pragma unroll
                for (int bj = 0; bj < 2; ++bj)
#pragma unroll
                    for (int n = 0; n < 2; ++n) *(f32x4*)(out + ro + bj * HALF + n * 16) = bv[m][bj][n] + gv[bj][n] * acc[ai][bj][m][n]; }
        }
    }
};
struct EpiPTile {
    static constexpr bool PERM = true, AFTER_DRAIN = false;
    bf16* P;
    __device__ __forceinline__ void operator()(const f32x4 (&acc)[2][2][4][2], const Unit& u, int wr, int wc, int fr, int fq) const {
        const int row0 = u.pm * BM + wr * 64 + fr, col0 = u.pn * BM + wc * 32 + 8 * fq;
#pragma unroll
        for (int ai = 0; ai < 2; ++ai)
#pragma unroll
            for (int m = 0; m < 4; ++m) { const int row = row0 + ai * HALF + m * 16; bf16* tp = P + ((size_t)(row >> 6) * (NP / 8) * 64 + (row & 63)) * 8;
#pragma unroll
                for (int bj = 0; bj < 2; ++bj) { const f32x4 v0 = acc[ai][bj][m][0], v1 = acc[ai][bj][m][1];
                    u32x4 w; w.x = pk2(v0[0], v0[1]); w.y = pk2(v0[2], v0[3]); w.z = pk2(v1[0], v1[1]); w.w = pk2(v1[2], v1[3]);
                    *(u32x4*)(tp + (size_t)((col0 + bj * HALF) >> 3) * 512) = w; } }
    }
};
struct ExpertOrder {
    pg8::StaticOrder base; int ntn, pm_off, gap;
    __device__ __forceinline__ void init(int nrows, int N, int G, int c, int pm_off_ = 0, int gap_ = 0) { base.init(nrows, N, G, c); ntn = N / BM; pm_off = pm_off_; gap = gap_; }
    __device__ __forceinline__ bool next(int i, Unit& u) const { if (!base.next(i, u)) return false; u.pm += pm_off; const int e = u.pm < 256 ? ((u.pm >> 3) & 15) : (u.pm - 256); u.pn += e * ntn + (e >= GU_SPLIT_E ? gap : 0); return true; }
    __device__ __forceinline__ void a_ready(const Unit&) const {}
    __device__ __forceinline__ void done(const Unit&) const {}
};
struct ExpertGatherOrder : ExpertOrder {
    const int* srcrow;
    __device__ __forceinline__ int aoff(const Unit& u, int r) const { return srcrow[u.pm * BM + r]; }
};
}
namespace pg8 { template <> constexpr bool sched_gather_v<mk::ExpertGatherOrder> = true; }
namespace mk {
struct EpiSwiglu {
    static constexpr bool PERM = true, AFTER_DRAIN = false;
    bf16* act; bool half;
    __device__ __forceinline__ void operator()(const f32x4 (&acc)[2][2][4][2], const Unit& u, int wr, int wc, int fr, int fq) const {
        const int pnl = u.pn % 22; const int row0 = u.pm * BM + wr * 64 + fr, col0 = pnl * 128 + wc * 32 + 8 * fq;
#pragma unroll
        for (int ai = 0; ai < 2; ++ai) if (!(half && ai == 1))
#pragma unroll
            for (int m = 0; m < 4; ++m) { float r[8];
#pragma unroll
                for (int n = 0; n < 2; ++n)
#pragma unroll
                    for (int c = 0; c < 4; ++c) { const float g = acc[ai][0][m][n][c], up = acc[ai][1][m][n][c]; r[4 * n + c] = g * __builtin_amdgcn_rcpf(1.f + __builtin_amdgcn_exp2f(-g * LOG2E)) * up; }
                u32x4 w; w.x = pk2(r[0], r[1]); w.y = pk2(r[2], r[3]); w.z = pk2(r[4], r[5]); w.w = pk2(r[6], r[7]);
                { const int row = row0 + ai * HALF + m * 16;
                  *(u32x4*)(act + ((size_t)(row >> 5) * (DFF / 64) + (col0 >> 6)) * 2048 + (row & 31) * 64 + (col0 & 63)) = w; } }
    }
};
struct EpiDown {
    static constexpr bool PERM = true, AFTER_DRAIN = false;
    bf16* y; const float* gatev; bool half;
    __device__ __forceinline__ void operator()(const f32x4 (&acc)[2][2][4][2], const Unit& u, int wr, int wc, int fr, int fq) const {
        const int pnl = u.pn & 3; const int row0 = u.pm * BM + wr * 64 + fr, col0 = pnl * BM + wc * 32 + 8 * fq;
        float gtv[2][4];
#pragma unroll
        for (int ai = 0; ai < 2; ++ai)
#pragma unroll
            for (int m = 0; m < 4; ++m) gtv[ai][m] = gatev[row0 + ai * HALF + m * 16];
        __builtin_amdgcn_sched_barrier(0);
#pragma unroll
        for (int ai = 0; ai < 2; ++ai) if (!(half && ai == 1))
#pragma unroll
            for (int m = 0; m < 4; ++m) { const int row = row0 + ai * HALF + m * 16; const float gt = gtv[ai][m];
#pragma unroll
                for (int bj = 0; bj < 2; ++bj) { const f32x4 v0 = acc[ai][bj][m][0] * gt, v1 = acc[ai][bj][m][1] * gt;
                    u32x4 w; w.x = pk2(v0[0], v0[1]); w.y = pk2(v0[2], v0[3]); w.z = pk2(v1[0], v1[1]); w.w = pk2(v1[2], v1[3]);
                    *(u32x4*)(y + (size_t)row * D + col0 + bj * HALF) = w; } }
    }
};

__device__ __forceinline__ void router_phase(const Args& a, int l, LAS unsigned char* lds, int tid, int lane, int wave, int vcu, int G) {
    LAS float* Wl = (LAS float*)lds;
    LAS float* A1l = Wl + 16384;
    LAS float* biasl = A1l + 3072;
    LAS float* SHl = biasl + 64;
    const float* wr = a.in[I_WROUTER] + (size_t)l * 1024 * 16; const float* gff = a.in[I_GFFN] + l * D;
    const float* MODL = (const float*)(a.ws + WS_MOD) + (size_t)l * 3 * 6144;
    { float wv[32];
#pragma unroll
      for (int i = 0; i < 32; ++i) wv[i] = wr[tid + 512 * i];
      float ag[6], am[6], as_[6];
#pragma unroll
      for (int i = 0; i < 6; ++i) { const int idx = tid + 512 * i, set = idx >> 10, c = idx & 1023; ag[i] = gff[c]; am[i] = MODL[set * 6144 + 4096 + c]; as_[i] = MODL[set * 6144 + 3072 + c]; }
      __builtin_amdgcn_sched_barrier(0);
#pragma unroll
      for (int i = 0; i < 32; ++i) { const int idx = tid + 512 * i, c = idx >> 4, e = idx & 15; Wl[(((c >> 4) * 4 + ((c >> 2) & 3)) * 16 + e) * 4 + (c & 3)] = wv[i]; }
#pragma unroll
      for (int i = 0; i < 6; ++i) { const int idx = tid + 512 * i; A1l[idx] = ag[i] * (1.f + am[i]); SHl[idx] = as_[i]; } }
    __syncthreads();
    if (tid < 384) { const int se = tid >> 3, part = tid & 7, set = se >> 4, e = se & 15; float sacc = 0.f;
        for (int c = part * 128; c < part * 128 + 128; ++c) sacc += SHl[set * 1024 + c] * Wl[(((c >> 4) * 4 + ((c >> 2) & 3)) * 16 + e) * 4 + (c & 3)];
        sacc += shx(sacc, 1); sacc += shx(sacc, 2); sacc += shx(sacc, 4);
        if (part == 0) biasl[se] = sacc; }
    __syncthreads();
    const int ntile = ((l == 0) ? NROW : NLAT) / 16, nround = (ntile + 2 * G - 1) / (2 * G);
    const float* X1 = (const float*)(a.ws + WS_X1); bf16* H2 = (bf16*)(a.ws + WS_H2); float* AFF = (float*)(a.ws + WS_AFF);
    const int r = lane & 15, kq = lane >> 4, grp = wave >> 2, q = wave & 3;
    LAS float* PART = SHl + 3072;
    LAS float* SSP = PART + 2 * 2 * 4 * 256;
    const LAS float* wp = Wl + lane * 4 + 256 * 16 * q;
    f32x4 xa[16], xb[16];
#define RT_LOADT(dst, tI_) do { const float* xr_ = X1 + (size_t)((tI_) * 16 + r) * D + 256 * q + 4 * kq; _Pragma("unroll") for (int jj = 0; jj < 16; ++jj) dst[jj] = *(const f32x4*)(xr_ + 16 * jj); __builtin_amdgcn_sched_barrier(0); } while (0)
    int tI = vcu * 2 + grp;
    if (!PV(1)) {
    if (tI < ntile) RT_LOADT(xa, tI);
#pragma unroll 1
    for (int i = 0; i < nround; ++i) {
        const int par = i & 1; const bool act = tI < ntile; const int tN = ((i + 1) * G + vcu) * 2 + grp;
        if (i + 1 < nround && tN < ntile) RT_LOADT(xb, tN);
        const int m0 = tI * 16; const int set = act ? mset_of_row(m0) : 0;
        const LAS float* a1p = A1l + set * 1024 + 256 * q + 4 * kq;
        if (act) {
            f32x4 acc = {0.f, 0.f, 0.f, 0.f}; float ss = 0.f;
#pragma unroll
            for (int jj = 0; jj < 16; ++jj) { const f32x4 xv = xa[jj]; const f32x4 av = *(const LAS f32x4*)(a1p + 16 * jj); const f32x4 wv = *(const LAS f32x4*)(wp + 256 * jj);
                ss += (xv.x * xv.x + xv.y * xv.y) + (xv.z * xv.z + xv.w * xv.w);
                const f32x4 t = xv * av; xa[jj] = t;
                acc = __builtin_amdgcn_mfma_f32_16x16x4f32(t.x, wv.x, acc, 0, 0, 0); acc = __builtin_amdgcn_mfma_f32_16x16x4f32(t.y, wv.y, acc, 0, 0, 0);
                acc = __builtin_amdgcn_mfma_f32_16x16x4f32(t.z, wv.z, acc, 0, 0, 0); acc = __builtin_amdgcn_mfma_f32_16x16x4f32(t.w, wv.w, acc, 0, 0, 0); }
            ss += shx(ss, 16); ss += shx(ss, 32);
            *(LAS f32x4*)(PART + (((par * 2 + grp) * 4 + q) * 64 + lane) * 4) = acc;
            if (kq == 0) SSP[((par * 2 + grp) * 4 + q) * 16 + r] = ss;
        }
        __syncthreads();
        if (act) {
            const LAS float* sp = SSP + (par * 2 + grp) * 64 + r;
            const float rstd = rsqrtf(((sp[0] + sp[16]) + (sp[32] + sp[48])) * (1.f / D) + EPS);
            if (q == 0) {
                const LAS float* pp = PART + ((par * 2 + grp) * 4 * 64 + lane) * 4;
                const f32x4 acc = (*(const LAS f32x4*)(pp) + *(const LAS f32x4*)(pp + 256)) + (*(const LAS f32x4*)(pp + 512) + *(const LAS f32x4*)(pp + 768));
                const float be = biasl[set * 16 + r]; float lg[4], mx[4], se[4];
#pragma unroll
                for (int g = 0; g < 4; ++g) { lg[g] = acc[g] * shl(rstd, 4 * kq + g) + be; mx[g] = lg[g]; }
#pragma unroll
                for (int o = 1; o < 16; o <<= 1)
#pragma unroll
                    for (int g = 0; g < 4; ++g) mx[g] = fmaxf(mx[g], shx(mx[g], o));
#pragma unroll
                for (int g = 0; g < 4; ++g) { lg[g] = expf(lg[g] - mx[g]); se[g] = lg[g]; }
#pragma unroll
                for (int o = 1; o < 16; o <<= 1)
#pragma unroll
                    for (int g = 0; g < 4; ++g) se[g] += shx(se[g], o);
                f32x4 af; af.x = lg[0] / se[0]; af.y = lg[1] / se[1]; af.z = lg[2] / se[2]; af.w = lg[3] / se[3];
                size_t off;
                if (m0 < NLAT) off = ((size_t)((m0 >> 14) * 16 + r)) * SEQ + (m0 & (SEQ - 1)) + 4 * kq;
                else { const int c = m0 - NLAT; off = (size_t)2 * 16 * SEQ + ((size_t)((c >> 8) * 16 + r)) * CTXL + (c & 255) + 4 * kq; }
                *(f32x4*)(AFF + off) = af;
            }
            if (!PV(0)) {
            const LAS float* shp = SHl + set * 1024 + 256 * q + 4 * kq; bf16* hp = H2 + (size_t)(m0 + r) * D + 256 * q + 4 * kq;
#pragma unroll
            for (int jj = 0; jj < 16; ++jj) { const f32x4 h = xa[jj] * rstd + *(const LAS f32x4*)(shp + 16 * jj);
                u32x2 o; o.x = pk2(h.x, h.y); o.y = pk2(h.z, h.w); *(u32x2*)(hp + 16 * jj) = o; }
            }
        }
#pragma unroll
        for (int jj = 0; jj < 16; ++jj) xa[jj] = xb[jj];
        tI = tN;
    }
    }
#undef RT_LOADT
    __syncthreads();
}

__device__ __forceinline__ void topk_phase(const Args& a, int l, LAS unsigned char* lds, int tid, int lane, int wave, int bid, int G) {
    LAS unsigned* red = (LAS unsigned*)lds;
    LAS unsigned* cg = red + 64;
    LAS unsigned* ce = cg + 256;
    const int ngroups = (l == 0) ? 64 : 32;
    const float* AFF = (const float*)(a.ws + WS_AFF); int* SEL = (int*)(a.ws + WS_SEL); int* SRCROW = (int*)(a.ws + WS_SRCROW); float* GATEV = (float*)(a.ws + WS_GATEV);
    for (int g = bid; g < ngroups; g += G) {
        const int set4 = g >> 4, e = g & 15; const int n = set4 < 2 ? SEQ : CTXL, cap = n >> 3;
        const float* af = set4 < 2 ? AFF + (size_t)(set4 * 16 + e) * SEQ : AFF + (size_t)2 * 16 * SEQ + (size_t)((set4 - 2) * 16 + e) * CTXL;
        const int tokbase = set4 < 2 ? set4 * SEQ : NLAT + (set4 - 2) * CTXL; const int rowbase = xe_rowbase(set4, e);
        unsigned v[32];
#pragma unroll
        for (int j = 0; j < 32; ++j) { const int idx = tid + 512 * j; v[j] = idx < n ? __float_as_uint(af[idx]) : 0u; }
        unsigned T = 0u;
        for (int sft = 30; sft >= 0; sft -= 2) {
            const unsigned c1v = T | (1u << sft), c2v = T | (2u << sft), c3v = T | (3u << sft); unsigned c12 = 0, c3 = 0;
#pragma unroll
            for (int j = 0; j < 32; ++j) { c12 += (v[j] >= c1v ? 1u : 0u) + (v[j] >= c2v ? 0x10000u : 0u); c3 += (v[j] >= c3v) ? 1u : 0u; }
#pragma unroll
            for (int o = 1; o < 64; o <<= 1) { c12 += (unsigned)shx_i((int)c12, o); c3 += (unsigned)shx_i((int)c3, o); }
            LAS unsigned* rb = red + ((sft >> 1) & 1) * 16;
            if (lane == 0) { rb[wave] = c12; rb[8 + wave] = c3; }
            __syncthreads();
            unsigned t12 = 0, t3 = 0;
#pragma unroll
            for (int w = 0; w < 8; ++w) { t12 += rb[w]; t3 += rb[8 + w]; }
            const unsigned n1 = t12 & 0xffffu, n2 = t12 >> 16;
            if (t3 >= (unsigned)cap) T = c3v; else if (n2 >= (unsigned)cap) T = c2v; else if (n1 >= (unsigned)cap) T = c1v;
        }
#pragma unroll
        for (int j = 0; j < 32; ++j) { const unsigned long long mgj = __ballot(v[j] > T), mej = __ballot(v[j] == T && (tid + 512 * j) < n);
            if (lane == 0) { cg[j * 8 + wave] = (unsigned)__popcll(mgj); ce[j * 8 + wave] = (unsigned)__popcll(mej); } }
        __syncthreads();
        if (tid == 0) { unsigned sg = 0, se = 0; for (int i = 0; i < 256; ++i) { const unsigned x = cg[i], y = ce[i]; cg[i] = sg; ce[i] = se; sg += x; se += y; } red[32] = sg; }
        __syncthreads();
        const unsigned ngt = red[32]; const unsigned need_eq = (unsigned)cap - ngt;
        const unsigned long long lt = (lane == 0) ? 0ull : (~0ull >> (64 - lane));
#pragma unroll
        for (int j = 0; j < 32; ++j) { const int idx = tid + 512 * j;
            const unsigned long long mgj = __ballot(v[j] > T), mej = __ballot(v[j] == T && idx < n);
            if (idx < n) {
                const unsigned gb = cg[j * 8 + wave] + (unsigned)__popcll(mgj & lt), eb = ce[j * 8 + wave] + (unsigned)__popcll(mej & lt);
                const bool isg = v[j] > T, ise = v[j] == T; const bool selc = isg || (ise && eb < need_eq);
                const unsigned slot = gb + (eb < need_eq ? eb : need_eq);
                if (selc) { SRCROW[rowbase + slot] = tokbase + idx; GATEV[rowbase + slot] = __uint_as_float(v[j]); }
                SEL[(size_t)(tokbase + idx) * 16 + e] = selc ? (int)slot : -1;
            } }
        if (set4 == 2 && tid >= 64 && tid < 256) { SRCROW[XE_LAT + e * 256 + tid] = NLAT; GATEV[XE_LAT + e * 256 + tid] = 0.f; }
        __syncthreads();
    }
}


constexpr int NPH_LAYER = 11;
constexpr int NPHASES = 1 + 2 * NPH_LAYER + 1;
constexpr bool PER_PHASE_LAUNCH = (MK_N_LAUNCHES != 1);
#ifndef MK_PHASE_MASK
#define MK_PHASE_MASK 0xffffu
#endif
#define EN(k) (((MK_PHASE_MASK) >> (k)) & 1u)

#ifndef MK_CVS
#define MK_CVS 0, 0, 4000, 4000, 4000, 66400, 66400
#endif
__device__ __forceinline__ constexpr int CVS_AT(int s) { constexpr int t[7] = {MK_CVS}; return s <= 0 ? 0 : (s >= 8 ? CV_ALL : t[s - 1]); }
typedef const __attribute__((address_space(4))) Args* KArgPtr;
__device__ __forceinline__ Args load_args(KArgPtr p) { Args a;
#pragma unroll
    for (int i = 0; i < 30; ++i) a.in[i] = p->in[i];
    a.out = p->out; a.ws = p->ws; a.ph_lo = p->ph_lo; a.ph_hi = p->ph_hi; a.li = p->li;
#if defined(MK_PROBE_KIND) && MK_PROBE_KIND >= 0
    a.pad = p->pad;
#else
    a.pad = 0;
#endif
    return a; }
__global__ void __launch_bounds__(512, 2) mk_fwd(Args args) {
    extern __shared__ __attribute__((aligned(16))) unsigned char lds_raw[];
    LAS unsigned char* lds = (LAS unsigned char*)lds_raw;
    const int wave0 = __builtin_amdgcn_readfirstlane((int)threadIdx.x >> 6);
#define MK_TID() (wave0 * 64 + lane_now())
#define LAUNDER() KArgPtr ap_ = kap; asm volatile("" : "+s"(ap_)); const Args A = load_args(ap_); unsigned char* ws = A.ws; (void)ws; int tid = MK_TID(); const int lane = tid & 63, wave = __builtin_amdgcn_readfirstlane(tid >> 6); (void)lane; (void)wave
    const int G = gridDim.x, bid = blockIdx.x; const int vcu = (G % 8 == 0) ? (bid % 8) * (G / 8) + bid / 8 : bid;
    volatile LAS unsigned* MISC = (volatile LAS unsigned*)(lds + MISC_OFF);
    for (int u = MK_TID(); u < (LDS_BYTES - RING_BYTES) / 4; u += 512) ((LAS unsigned*)(lds + RING_BYTES))[u] = 0u;
    __syncthreads();
    KArgPtr kap = (KArgPtr)__builtin_amdgcn_kernarg_segment_ptr();
    unsigned* ctl = (unsigned*)(args.ws + WS_CTL);
    unsigned* barw = ctl + CW_BAR + args.li * XCD_BAR_WORDS;
    XcdBarrier bar; bar.bar = barw; bar.x = 0; bar.st = nullptr;
    if (!PER_PHASE_LAUNCH) bar = xcd_barrier_post(barw, MISC + 8, MK_TID() == 0);
    const int lo = args.ph_lo, hi = args.ph_hi;
#define IN(k) (lo <= (k) && (k) < hi)
#define SEAM(k) do { if (IN(k) && IN((k) + 1)) { if (PER_PHASE_LAUNCH) { if (MK_TID() == 0) __hip_atomic_store(ctl + CW_TMO, 0xBADBA0u, __ATOMIC_RELAXED, __HIP_MEMORY_SCOPE_AGENT); } else { xcd_barrier(bar, MK_TID() == 0); } } } while (0)

#define PH(kind, id, ...) do { if constexpr (EN(kind)) { if (IN(id)) { __VA_ARGS__ } } } while (0)
#define TAIL_CONV(busy_, s_) do { const int busy__ = (busy_) % G; if (bid >= busy__ && CVS_AT(s_) < CVS_AT((s_) + 1)) { __syncthreads(); conv_items(A, 1, CVS_AT(s_), CVS_AT((s_) + 1), lds, lane, wave, (bid - busy__) * 8 + wave, (G - busy__) * 8); } } while (0)
    PH(0, 0, LAUNDER(); pro_phase(A, lds, tid, bid, G); conv_items(A, 0, 0, CV_ALL, lds + 16384, lane, wave, vcu * 8 + wave, G * 8););
    SEAM(0);
#pragma unroll 1
    for (int l = 0; l < 2; ++l) {
        const int pb = 1 + NPH_LAYER * l;
        const int nrow_attn = (l == 0) ? NROW : NLAT;
        PH(1, pb + 0, LAUNDER(); modul_phase(A, l, lane, wave, vcu, G); if (l == 1) { TAIL_CONV(0, 5); });
        SEAM(pb + 0);
        PH(2, pb + 1, LAUNDER(); pg8::Gemm g{(const bf16*)(ws + WS_H), w_in(A, l), NROW, NP, D}; pg8::StaticOrder S; S.init(NROW, NP, G, bid);
            EpiPTile E{(bf16*)(ws + WS_P)};
            pg8::gemm_phase<EpiPTile, pg8::StaticOrder, true, true, false, true>(lds, g, S, E, tid);
            if (l == 0) { TAIL_CONV((NROW / 256) * (NP / 256), 0); } else { TAIL_CONV((NROW / 256) * (NP / 256), 6); });
        SEAM(pb + 1);
        PH(3, pb + 2, LAUNDER(); prep1_phase(A, l, lds, lane, wave, vcu, G););
        SEAM(pb + 2);
        PH(5, pb + 4, LAUNDER(); up2_phase(A, l, lane, wave, vcu, G););
        SEAM(pb + 4);
        PH(6, pb + 5, LAUNDER(); attn_phase(A, l, lds, tid, vcu, G););
        SEAM(pb + 5);
        PH(7, pb + 6, LAUNDER(); pg8::Gemm g{(const bf16*)(ws + WS_O), w_out(A, l), nrow_attn, D, D}; pg8::StaticOrder S; S.init(nrow_attn, D, G, bid);
            EpiRes E{l == 0 ? A.in[I_X] : (const float*)x2_of(A), l == 0 ? A.in[I_CTX] : (const float*)x2_of(A) + (size_t)NLAT * D, (float*)(ws + WS_X1), (const float*)(ws + WS_MOD) + (size_t)l * 3 * 6144};
            pg8::gemm_phase<EpiRes, pg8::StaticOrder, true, true, false, true>(lds, g, S, E, tid);
            if (l == 0) { TAIL_CONV((NROW / 256) * (D / 256), 1); });
        SEAM(pb + 6);
        PH(8, pb + 7, LAUNDER(); router_phase(A, l, lds, tid, lane, wave, vcu, G););
        SEAM(pb + 7);
        PH(9, pb + 8, LAUNDER(); topk_phase(A, l, lds, tid, lane, wave, bid, G); if (l == 0) { TAIL_CONV(64, 2); } else { TAIL_CONV(32, 7); });
        SEAM(pb + 8);
        PH(11, pb + 9, LAUNDER(); pg8::Gemm g{(const bf16*)(ws + WS_H2), w_gu(A, l), XE_LAT, 5632, D}; const int gap = l == 0 ? 0 : GU_GAP_TILES; EpiSwiglu E{(bf16*)(ws + WS_ACT), false}; EpiSwiglu Eh{(bf16*)(ws + WS_ACT), true};
            { ExpertGatherOrder S; S.init(XE_LAT, 5632, G, bid, 0, gap); S.srcrow = (const int*)(ws + WS_SRCROW);
              pg8::gemm_phase<EpiSwiglu, ExpertGatherOrder, true, true, false, true>(lds, g, S, E, tid); }
            if (l == 0) { __syncthreads(); ExpertGatherOrder S; S.init(XE_ALL - XE_LAT, 5632, G, bid, 256); S.srcrow = (const int*)(ws + WS_SRCROW);
              pg8::gemm_phase<EpiSwiglu, ExpertGatherOrder, true, true, true, true>(lds, g, S, Eh, tid);
              TAIL_CONV(((XE_ALL - XE_LAT) / 256) * 22, 3); });
        SEAM(pb + 9);
        PH(12, pb + 10, LAUNDER(); pg8::Gemm g{(const bf16*)(ws + WS_ACT), w_d(A, l), XE_LAT, D, DFF}; EpiDown E{(bf16*)(ws + WS_Y), (const float*)(ws + WS_GATEV), false}; EpiDown Eh{(bf16*)(ws + WS_Y), (const float*)(ws + WS_GATEV), true};
            { ExpertOrder S; S.init(XE_LAT, D, G, bid);
              pg8::gemm_phase<EpiDown, ExpertOrder, true, true, false, true, true>(lds, g, S, E, tid); }
            if (l == 0) { __syncthreads(); ExpertOrder S; S.init(XE_ALL - XE_LAT, D, G, bid, 256);
              pg8::gemm_phase<EpiDown, ExpertOrder, true, true, true, true, true>(lds, g, S, Eh, tid);
              TAIL_CONV(((XE_ALL - XE_LAT) / 256) * 4, 4); });
        SEAM(pb + 10);
    }
    PH(13, NPHASES - 1, LAUNDER(); final_phase(A, lane, wave, vcu, G););
#undef IN
#undef SEAM
}
}

extern "C" void kernel_launch(void* const* d_in, const int* in_sizes, int n_in, void* d_out, int out_size, void* d_ws, size_t ws_size, hipStream_t stream) {
    using namespace mk;
    static int grid = 0;
    if (grid == 0) {
        if (n_in != 30 || out_size != NLAT * D || ws_size < WS_NEED) { fprintf(stderr, "kernel_launch: unexpected shapes: n_in %d out %d ws %zu (need %zu)\n", n_in, out_size, ws_size, (size_t)WS_NEED); grid = -1; return; }
        int dev = 0, cus = 0, per_cu = 0;
        if (hipGetDevice(&dev) != hipSuccess || hipDeviceGetAttribute(&cus, hipDeviceAttributeMultiprocessorCount, dev) != hipSuccess) { grid = -1; return; }
        if (hipFuncSetAttribute((const void*)mk_fwd, hipFuncAttributeMaxDynamicSharedMemorySize, LDS_BYTES) != hipSuccess) { fprintf(stderr, "kernel_launch: hipFuncSetAttribute failed\n"); grid = -1; return; }
        if (hipOccupancyMaxActiveBlocksPerMultiprocessor(&per_cu, (const void*)mk_fwd, 512, LDS_BYTES) != hipSuccess || per_cu < 1) fprintf(stderr, "kernel_launch: occupancy query reports %d\n", per_cu);
        (void)hipGetLastError();
        grid = cus;
    }
    if (grid < 0) return;
    if (hipMemsetAsync((char*)d_ws + WS_CTL, 0, CTL_ZERO_BYTES, stream) != hipSuccess) return;
    Args a{};
    for (int i = 0; i < 30; ++i) a.in[i] = (const float*)d_in[i];
    a.out = (float*)d_out; a.ws = (unsigned char*)d_ws;
    if (PER_PHASE_LAUNCH) {
        for (int p = 0; p < NPHASES; ++p) { a.ph_lo = p; a.ph_hi = p + 1; a.li = 0; hipLaunchKernelGGL(mk_fwd, dim3(grid), dim3(512), LDS_BYTES, stream, a); }
    } else {
#if defined(MK_PROBE_KIND) && MK_PROBE_KIND >= 0
        int cuts[16]; int nc = 0; cuts[nc++] = 0;
        const int k0 = (MK_PROBE_KIND == 0) ? 0 : MK_PROBE_KIND, k1 = (MK_PROBE_KIND == 0 || MK_PROBE_KIND == 13) ? -1 : MK_PROBE_KIND + NPH_LAYER;
        const int kk0 = (MK_PROBE_KIND == 13) ? NPHASES - 1 : k0;
        int li = 0;
        auto launch = [&](int lo, int hi) { a.ph_lo = lo; a.ph_hi = hi; a.li = li++; a.pad = (hi == lo + 1 && li > 1) ? MK_PROBE_VAR : 0; hipLaunchKernelGGL(mk_fwd, dim3(grid), dim3(512), LDS_BYTES, stream, a); };
        launch(0, kk0 + 1); launch(kk0, kk0 + 1);
        if (k1 >= 0) { launch(kk0 + 1, k1 + 1); launch(k1, k1 + 1); if (k1 + 1 < NPHASES) launch(k1 + 1, NPHASES); }
        else if (kk0 + 1 < NPHASES) launch(kk0 + 1, NPHASES);
        (void)cuts; (void)nc;
#else
        a.ph_lo = 0; a.ph_hi = NPHASES; a.li = 0; hipLaunchKernelGGL(mk_fwd, dim3(grid), dim3(512), LDS_BYTES, stream, a);
#endif
    }
}
```

```cpp
#include <hip/hip_runtime.h>
#include <cstdio>
#include <cstdint>
#ifndef MK_N_LAUNCHES
#define MK_N_LAUNCHES 1
#endif
#define MK_PROBE_KIND -1
#define MK_XPROBE 0
#define MK_PROBE_VAR 0
namespace pg8 {
#define PG8_LAS __attribute__((address_space(3)))
typedef unsigned short bf16_t;
typedef short bf16x8 __attribute__((ext_vector_type(8)));
typedef float f32x4 __attribute__((ext_vector_type(4)));
typedef unsigned u32x4 __attribute__((ext_vector_type(4)));
constexpr int BM = 256, BK = 64, HALF = 128, HTB = HALF * BK * 2  , STAGE_BYTES = 8 * HTB, NXCD = 8, WGM = 8;

__host__ __device__ __forceinline__ int lds_byte(int r, int c) { const int st = (r >> 4) * 2 + (c >> 5), rr = r & 15, cc = c & 31, ob = rr * 64 + cc * 2; return st * 1024 + (ob ^ (((ob >> 9) & 1) << 5)); }
__host__ __device__ __forceinline__ void stage_rc(int b, int& R, int& C) { const int st = b / 1024, sb = b % 1024, swz = sb ^ (((sb >> 9) & 1) << 5); R = (st >> 1) * 16 + swz / 64; C = (st & 1) * 32 + (swz % 64) / 2; }
__host__ __device__ __forceinline__ int perm32(int rho) { const int n = rho >> 4, i = rho & 15; return 8 * (i >> 2) + 4 * n + (i & 3); }

struct Unit { int pm, pn; };
struct Gemm { const bf16_t* A; const bf16_t* Bt; int M, N, K; };

struct StaticOrder {
    int nM, nN, nwg, G, c;
    __host__ __device__ void init(int M, int N, int G_, int c_) { nM = M / BM; nN = N / BM; nwg = nM * nN; G = G_; c = c_; }
    __host__ __device__ bool next(int i, Unit& u) const {
        const long L = (long)i * G + c; if (L >= nwg) return false;
        int wgid = (int)L; { const int q = nwg / NXCD, r = nwg % NXCD, xcd = wgid % NXCD, off = wgid / NXCD; wgid = (xcd < r ? xcd * (q + 1) : r * (q + 1) + (xcd - r) * q) + off; }
        const int nig = WGM * nN, gid = wgid / nig, fm = gid * WGM, gsz = (nM - fm) < WGM ? (nM - fm) : WGM;
        u.pm = fm + ((wgid % nig) % gsz); u.pn = (wgid % nig) / gsz; return true;
    }
    __device__ __forceinline__ void a_ready(const Unit&) const {}
    __device__ __forceinline__ void done(const Unit&) const {}
};

__device__ __forceinline__ unsigned cvt_pk_bf16(float lo, float hi) { unsigned r; asm volatile("v_cvt_pk_bf16_f32 %0, %1, %2" : "=v"(r) : "v"(lo), "v"(hi)); return r; }
typedef float f32x2 __attribute__((ext_vector_type(2)));
__device__ __forceinline__ f32x2 gelu_pk(f32x2 v) {
    const f32x2 av = __builtin_elementwise_abs(v), d = av * 0.2316418882f + 1.0f;
    f32x2 t; t.x = __builtin_amdgcn_rcpf(d.x); t.y = __builtin_amdgcn_rcpf(d.y);
    f32x2 q = t * 0.5307027145f + (-0.7265760135f); q = q * t + 0.7107068705f; q = q * t + (-0.142248368f); q = q * t + 0.127414796f; q = q * t;
    const f32x2 s = (v * v) * (-0.72134752044f);
    f32x2 e; e.x = __builtin_amdgcn_exp2f(s.x); e.y = __builtin_amdgcn_exp2f(s.y);
    const f32x2 m = v * (q * e), r = v - m;
    f32x2 o; o.x = v.x < 0.f ? m.x : r.x; o.y = v.y < 0.f ? m.y : r.y; return o;
}

template <int ACT  > struct EpiBf16 {
    static constexpr bool PERM = true, AFTER_DRAIN = false; static_assert(ACT == 0 || ACT == 1, "EpiBf16: ACT is 0 (none) or 1 (gelu_pk)");
    bf16_t* O; int ldc; const float* bias; int split_cols; size_t split_stride; float scale0;
    __device__ __forceinline__ void operator()(const f32x4 (&acc)[2][2][4][2], const Unit& u, int wr, int wc, int fr, int fq) const {
        const int row0 = u.pm * BM + wr * 64 + fr; int colt = u.pn * BM; bf16_t* base = O;
        float sc = 1.f; if (split_cols) { const int t = colt / split_cols; base += (size_t)t * split_stride; colt -= t * split_cols; if (t == 0) sc = scale0; }
        const int col0 = colt + wc * 32 + 8 * fq, bcol0 = u.pn * BM + wc * 32 + 8 * fq;
        f32x4 bv[2][2];
#pragma unroll
        for (int bj = 0; bj < 2; ++bj)
#pragma unroll
            for (int n = 0; n < 2; ++n) bv[bj][n] = bias ? *(const f32x4*)(bias + bcol0 + bj * HALF + 4 * n) : (f32x4){0.f, 0.f, 0.f, 0.f};
#pragma unroll
        for (int ai = 0; ai < 2; ++ai)
#pragma unroll
            for (int m = 0; m < 4; ++m) { bf16_t* rowp = base + (size_t)(row0 + ai * HALF + m * 16) * ldc + col0;
#pragma unroll
                for (int bj = 0; bj < 2; ++bj) { f32x4 v0 = acc[ai][bj][m][0] + bv[bj][0], v1 = acc[ai][bj][m][1] + bv[bj][1];
                    if (ACT == 1) { f32x2 a = gelu_pk((f32x2){v0[0], v0[1]}), b = gelu_pk((f32x2){v0[2], v0[3]}), c = gelu_pk((f32x2){v1[0], v1[1]}), d = gelu_pk((f32x2){v1[2], v1[3]});
                        v0 = (f32x4){a.x, a.y, b.x, b.y}; v1 = (f32x4){c.x, c.y, d.x, d.y}; }
                    v0 = v0 * sc; v1 = v1 * sc; u32x4 w; w.x = cvt_pk_bf16(v0[0], v0[1]); w.y = cvt_pk_bf16(v0[2], v0[3]); w.z = cvt_pk_bf16(v1[0], v1[1]); w.w = cvt_pk_bf16(v1[2], v1[3]);
                    *(u32x4*)(rowp + bj * HALF) = w; } }
    }
};
template <class S> constexpr bool sched_gather_v = false;
template <class Epi, class Sched, bool ALIGN_EPI = false, bool SP2 = false, bool HALF_ROWS = false, bool BTILED = false, bool ATILED = false>
__device__ __forceinline__ void gemm_phase(PG8_LAS unsigned char* lds, const Gemm g, const Sched& S, const Epi& E, int tid_in) {
    int tid_l = tid_in; asm volatile("" : "+v"(tid_l));
    const int tid = tid_l, wid = __builtin_amdgcn_readfirstlane(tid >> 6), lane = tid & 63, wr = wid >> 2, wc = wid & 3, fr = lane & 15, fq = lane >> 4;
    const int K = g.K, nt = K / BK;
    unsigned voffA[2], voffB[2];
#pragma unroll
    for (int i = 0; i < 2; ++i) { int R, C; stage_rc(tid * 16 + i * 8192, R, C); const int Rb = Epi::PERM ? ((R & ~31) + perm32(R & 31)) : R;
        voffA[i] = ATILED ? (unsigned)((R >> 5) * (K / 64) * 2048 + (R & 31) * 64 + C) * 2u : (unsigned)(R * K + C) * 2u; voffB[i] = BTILED ? (unsigned)((Rb >> 5) * (K / 64) * 2048 + (Rb & 31) * 64 + C) * 2u : (unsigned)(Rb * K + C) * 2u; }
    const size_t kstep = (size_t)(BK * 2);
    const size_t kstepA = ATILED ? (size_t)4096 : kstep;
    const size_t kstepB = BTILED ? (size_t)4096 : kstep;
    const size_t hstep = (size_t)HALF * K * 2;
    const size_t tstep = 2 * hstep;
    constexpr bool GATHER = sched_gather_v<Sched>;
    const size_t hstepA = GATHER ? (size_t)0 : hstep;
    const unsigned ldsw = (unsigned)wid * 1024u;
    const int aoff = lds_byte(wr * 64 + fr, fq * 8), boff = lds_byte(wc * 32 + fr, fq * 8);
#define PG8_SA(b, h) (((b) * 2 + (h)) * HTB)
#define PG8_SB(b, h) ((4 + (b) * 2 + (h)) * HTB)
#define PG8_STAGE(bufoff, gbase, voff) do { _Pragma("unroll") for (int _i = 0; _i < 2; ++_i) \
        __builtin_amdgcn_global_load_lds((const unsigned*)((const char*)(gbase) + (voff)[_i]), (PG8_LAS unsigned*)(lds + (bufoff) + ldsw + _i * 8192), 16, 0, 0); } while (0)
#define PG8_LDA(dst, b, h) do { _Pragma("unroll") for (int m = 0; m < 4; ++m) _Pragma("unroll") for (int k = 0; k < 2; ++k) dst[m][k] = *(const PG8_LAS bf16x8*)(lds + PG8_SA(b, h) + aoff + m * 2048 + k * 1024); } while (0)
#define PG8_LDB(dst, b, h) do { _Pragma("unroll") for (int n = 0; n < 2; ++n) _Pragma("unroll") for (int k = 0; k < 2; ++k) dst[n][k] = *(const PG8_LAS bf16x8*)(lds + PG8_SB(b, h) + boff + n * 2048 + k * 1024); } while (0)
#define PG8_MMA(ai, bj, At, Bt) do { __builtin_amdgcn_s_setprio(1); _Pragma("unroll") for (int m = 0; m < 4; ++m) _Pragma("unroll") for (int n = 0; n < 2; ++n) _Pragma("unroll") for (int k = 0; k < 2; ++k) \
        acc[ai][bj][m][n] = __builtin_amdgcn_mfma_f32_16x16x32_bf16(Bt[n][k], At[m][k], acc[ai][bj][m][n], 0, 0, 0); __builtin_amdgcn_s_setprio(0); } while (0)
#define PG8_WAIT_V(n) asm volatile("s_waitcnt vmcnt(" #n ")" ::: "memory")
#define PG8_WAIT_L(n) asm volatile("s_waitcnt lgkmcnt(" #n ")" ::: "memory")
#define PG8_BAR __builtin_amdgcn_s_barrier()
#define PG8_SCHED __builtin_amdgcn_sched_barrier(0)
    Unit cur, nxt; int ui = 0;
    if (!S.next(0, cur)) return;
    f32x4 acc[2][2][4][2];
#pragma unroll
    for (int a = 0; a < 2; ++a)
#pragma unroll
        for (int b = 0; b < 2; ++b)
#pragma unroll
            for (int m = 0; m < 4; ++m)
#pragma unroll
                for (int n = 0; n < 2; ++n) acc[a][b][m][n] = (f32x4){0.f, 0.f, 0.f, 0.f};
    bf16x8 At[4][2], B0[2][2], B1[2][2];
    const char* cA = GATHER ? (const char*)g.A : (const char*)g.A + (size_t)cur.pm * tstep; const char* cB = (const char*)g.Bt + (size_t)cur.pn * tstep;
    unsigned vA[2][2], nvA[2][2];
#define PG8_AOFF(dst, u) do { _Pragma("unroll") for (int _h = 0; _h < 2; ++_h) _Pragma("unroll") for (int _i = 0; _i < 2; ++_i) { \
        if constexpr (GATHER) { int R_, C_; stage_rc(tid * 16 + _i * 8192, R_, C_); dst[_h][_i] = (unsigned)S.aoff(u, _h * HALF + R_) * (unsigned)(K * 2) + (unsigned)(C_ * 2); } else dst[_h][_i] = voffA[_i]; } } while (0)
    PG8_AOFF(vA, cur);
#pragma unroll
    for (int _h = 0; _h < 2; ++_h)
#pragma unroll
        for (int _i = 0; _i < 2; ++_i) nvA[_h][_i] = vA[_h][_i];
    S.a_ready(cur);
    if constexpr (SP2) {
        PG8_STAGE(PG8_SB(0, 0), cB, voffB); PG8_STAGE(PG8_SB(0, 1), cB + hstep, voffB); PG8_STAGE(PG8_SA(0, 0), cA, vA[0]); PG8_STAGE(PG8_SA(0, 1), cA + hstepA, vA[1]);
        if (wr == 1) PG8_BAR;
        PG8_WAIT_V(2); PG8_BAR;
        PG8_STAGE(PG8_SB(1, 0), cB + kstepB, voffB); PG8_STAGE(PG8_SA(1, 0), cA + kstepA, vA[0]); PG8_STAGE(PG8_SB(1, 1), cB + hstep + kstepB, voffB);
        PG8_WAIT_V(6); PG8_BAR;
    } else {
        PG8_STAGE(PG8_SB(0, 0), cB, voffB); PG8_STAGE(PG8_SA(0, 0), cA, vA[0]); PG8_STAGE(PG8_SB(0, 1), cB + hstep, voffB); PG8_STAGE(PG8_SA(0, 1), cA + hstepA, vA[1]);
        if (wr == 1) PG8_BAR;
        PG8_WAIT_V(4); PG8_BAR;
        PG8_STAGE(PG8_SB(1, 0), cB + kstepB, voffB); PG8_STAGE(PG8_SA(1, 0), cA + kstepA, vA[0]); PG8_STAGE(PG8_SB(1, 1), cB + hstep + kstepB, voffB);
        PG8_WAIT_V(6); PG8_BAR;
    }
    for (;;) {
        const bool has_next = S.next(ui + 1, nxt);
        const char* nA = (has_next && !GATHER) ? (const char*)g.A + (size_t)nxt.pm * tstep : cA;
        if constexpr (GATHER) { if (has_next) PG8_AOFF(nvA, nxt); } const char* nB = has_next ? (const char*)g.Bt + (size_t)nxt.pn * tstep : cB;
#pragma unroll 1
        for (int t = 0; t < nt; t += 2) {
            const bool last = (t == nt - 2);
            const char* a1 = cA + (size_t)(t + 1) * kstepA;
            const char* a2 = last ? nA : cA + (size_t)(t + 2) * kstepA; const char* b2 = last ? nB : cB + (size_t)(t + 2) * kstepB;
            const char* a3 = a2 + kstepA; const char* b3 = b2 + kstepB;
            unsigned sA0[2], sA1[2]; sA0[0] = last ? nvA[0][0] : vA[0][0]; sA0[1] = last ? nvA[0][1] : vA[0][1]; sA1[0] = last ? nvA[1][0] : vA[1][0]; sA1[1] = last ? nvA[1][1] : vA[1][1];
            if (last && has_next) S.a_ready(nxt);
            if constexpr (SP2) {
            PG8_LDB(B0, 0, 0); PG8_LDB(B1, 0, 1); PG8_SCHED; PG8_LDA(At, 0, 0); PG8_STAGE(PG8_SA(1, 1), a1 + hstepA, vA[1]);
            PG8_WAIT_V(8); PG8_WAIT_L(0); PG8_BAR; if (!HALF_ROWS || wr == 0) { PG8_MMA(0, 0, At, B0); PG8_MMA(0, 1, At, B1); } PG8_BAR; PG8_SCHED;
            PG8_LDA(At, 0, 1); PG8_STAGE(PG8_SB(0, 0), b2, voffB); PG8_STAGE(PG8_SB(0, 1), b2 + hstep, voffB); PG8_STAGE(PG8_SA(0, 0), a2, sA0);
            PG8_WAIT_V(8); PG8_WAIT_L(0); PG8_BAR; if constexpr (!HALF_ROWS) { PG8_MMA(1, 0, At, B0); PG8_MMA(1, 1, At, B1); } PG8_BAR; PG8_SCHED;
            PG8_LDB(B0, 1, 0); PG8_LDB(B1, 1, 1); PG8_SCHED; PG8_LDA(At, 1, 0); PG8_STAGE(PG8_SA(0, 1), a2 + hstepA, sA1);
            PG8_WAIT_V(8); PG8_WAIT_L(0); PG8_BAR; if (!HALF_ROWS || wr == 0) { PG8_MMA(0, 0, At, B0); PG8_MMA(0, 1, At, B1); } PG8_BAR; PG8_SCHED;
            PG8_LDA(At, 1, 1); PG8_STAGE(PG8_SB(1, 0), b3, voffB); PG8_STAGE(PG8_SB(1, 1), b3 + hstep, voffB); PG8_STAGE(PG8_SA(1, 0), a3, sA0);
            PG8_WAIT_V(8); PG8_WAIT_L(0); PG8_BAR; if constexpr (!HALF_ROWS) { PG8_MMA(1, 0, At, B0); PG8_MMA(1, 1, At, B1); } PG8_BAR; PG8_SCHED;
            } else {
            PG8_LDB(B0, 0, 0); PG8_SCHED; PG8_LDA(At, 0, 0); PG8_STAGE(PG8_SA(1, 1), a1 + hstepA, vA[1]);
            PG8_WAIT_L(8); PG8_BAR; PG8_WAIT_L(0); PG8_MMA(0, 0, At, B0); PG8_BAR; PG8_SCHED;
            PG8_LDB(B1, 0, 1); PG8_STAGE(PG8_SB(0, 0), b2, voffB);
            PG8_BAR; PG8_WAIT_L(0); PG8_MMA(0, 1, At, B1); PG8_BAR;
            PG8_LDA(At, 0, 1); PG8_STAGE(PG8_SA(0, 0), a2, sA0);
            PG8_BAR; PG8_WAIT_L(0); PG8_MMA(1, 0, At, B0); PG8_BAR; PG8_SCHED;
            PG8_STAGE(PG8_SB(0, 1), b2 + hstep, voffB);
            PG8_WAIT_V(6); PG8_BAR; PG8_MMA(1, 1, At, B1); PG8_BAR;
            PG8_LDB(B0, 1, 0); PG8_SCHED; PG8_LDA(At, 1, 0); PG8_STAGE(PG8_SA(0, 1), a2 + hstepA, sA1);
            PG8_WAIT_L(8); PG8_BAR; PG8_WAIT_L(0); PG8_MMA(0, 0, At, B0); PG8_BAR; PG8_SCHED;
            PG8_LDB(B1, 1, 1); PG8_STAGE(PG8_SB(1, 0), b3, voffB);
            PG8_BAR; PG8_WAIT_L(0); PG8_MMA(0, 1, At, B1); PG8_BAR;
            PG8_LDA(At, 1, 1); PG8_STAGE(PG8_SA(1, 0), a3, sA0);
            PG8_BAR; PG8_WAIT_L(0); PG8_MMA(1, 0, At, B0); PG8_BAR; PG8_SCHED;
            PG8_STAGE(PG8_SB(1, 1), b3 + hstep, voffB);
            PG8_WAIT_V(6); PG8_BAR; PG8_MMA(1, 1, At, B1); PG8_BAR;
            }
        }
        if constexpr (ALIGN_EPI) { if (wr == 0) PG8_BAR; }
        if constexpr (!Epi::AFTER_DRAIN) { E(acc, cur, wr, wc, fr, fq); S.done(cur); }
        if (!has_next) break;
#pragma unroll
        for (int a = 0; a < 2; ++a)
#pragma unroll
            for (int b = 0; b < 2; ++b)
#pragma unroll
                for (int m = 0; m < 4; ++m)
#pragma unroll
                    for (int n = 0; n < 2; ++n) acc[a][b][m][n] = (f32x4){0.f, 0.f, 0.f, 0.f};
        cur = nxt; cA = nA; cB = nB; ++ui;
#pragma unroll
        for (int _h = 0; _h < 2; ++_h) { vA[_h][0] = nvA[_h][0]; vA[_h][1] = nvA[_h][1]; }
        if constexpr (ALIGN_EPI) { if (wr == 1) PG8_BAR; }
    }
    PG8_WAIT_V(0);
    if constexpr (!ALIGN_EPI) { if (wr == 0) PG8_BAR; }
    PG8_BAR;
    if constexpr (Epi::AFTER_DRAIN) { E.fused(acc, cur, wr, wc, fr, fq, lds, wid, lane); S.done(cur); }
#undef PG8_AOFF
#undef PG8_SA
#undef PG8_SB
#undef PG8_STAGE
#undef PG8_LDA
#undef PG8_LDB
#undef PG8_MMA
#undef PG8_WAIT_V
#undef PG8_WAIT_L
#undef PG8_BAR
#undef PG8_SCHED
}
}

namespace mk {
typedef unsigned short bf16;
typedef short bf16x8 __attribute__((ext_vector_type(8)));
typedef float f32x4 __attribute__((ext_vector_type(4)));
typedef float f32x16 __attribute__((ext_vector_type(16)));
typedef unsigned u32x4 __attribute__((ext_vector_type(4)));
typedef unsigned u32x2 __attribute__((ext_vector_type(2)));
#define LAS __attribute__((address_space(3)))
#define GAS __attribute__((address_space(1)))

constexpr int D = 1024, NB = 2, SEQ = 16384, CTXL = 256;
constexpr int NLAT = NB * SEQ, NCTX = NB * CTXL, NROW = NLAT + NCTX;
constexpr int NP = 2560;
constexpr int NTILE = 260;
constexpr int DFF = 2816, NE = 16;
constexpr int XE_LAT = 65536, XE_ALL = 69632;
constexpr float EPS = 1e-6f;
constexpr float LOG2E = 1.4426950408889634f;

constexpr size_t MiB = (size_t)1 << 20;
constexpr size_t WS_CTL = 0, CTL_ZERO_BYTES = 1 * MiB;
constexpr size_t WS_MOD = 1 * MiB;
constexpr size_t WS_LAM = WS_MOD + 160 * 1024;
constexpr size_t WS_ROPE = WS_MOD + 256 * 1024;
constexpr size_t WS_WIN = 2 * MiB, WS_W2 = 7 * MiB, WS_WOUT = 8 * MiB, WS_WGU = 16 * MiB, WS_WD = 192 * MiB;
constexpr size_t WS_X1 = 280 * MiB, WS_X2 = 410 * MiB, WS_H2 = 540 * MiB, WS_Y = 605 * MiB;
constexpr size_t WS_AFF = 741 * MiB, WS_SEL = 744 * MiB, WS_SRCROW = 747 * MiB, WS_GATEV = 747 * MiB + 512 * 1024;
constexpr size_t WS_H = 748 * MiB, WS_P = 813 * MiB, WS_A2 = 976 * MiB, WS_U = 1001 * MiB;
constexpr size_t WS_QNA = 1066 * MiB, WS_QMLA = 1083 * MiB, WS_QDIFF = 1108 * MiB, WS_QGQA = 1125 * MiB;
constexpr size_t WS_KNA = 1142 * MiB, WS_KMLA = 1159 * MiB, WS_KDIFF = 1184 * MiB, WS_KGQA = 1201 * MiB;
constexpr size_t WS_VNA = 1210 * MiB, WS_VMLA = 1227 * MiB, WS_VDIFF = 1244 * MiB, WS_VGQA = 1261 * MiB;
constexpr size_t WS_O = 1270 * MiB;
constexpr size_t WS_XE = 748 * MiB, WS_ACT = 884 * MiB;
constexpr size_t WS_END = 1336 * MiB;
constexpr size_t WS_X2B = 16 * MiB, WS_WGU1 = 410 * MiB, WS_WGU1B = 1345 * MiB, WS_NEED = 1400 * MiB;
constexpr int GU_SPLIT_E = 11, GU_GAP_TILES = (int)((WS_WGU1B - WS_WGU1 - (size_t)GU_SPLIT_E * 11 * MiB) / (512 * 1024));
static_assert(GU_GAP_TILES % 22 == 0 && GU_GAP_TILES > 0, "gate/up split");
constexpr size_t OUT_WD1 = 0, OUT_WIN1 = 88 * MiB, OUT_W21 = 93 * MiB, OUT_WOUT1 = 94 * MiB;
static_assert(WS_ACT + (size_t)XE_ALL * DFF * 2 <= WS_O + (size_t)NROW * D * 2 && WS_O + (size_t)NROW * D * 2 <= WS_END, "ws map");
static_assert(WS_XE + (size_t)XE_ALL * D * 2 <= WS_ACT && WS_P + (size_t)NROW * NP * 2 <= WS_A2 && WS_Y + (size_t)XE_ALL * D * 2 <= WS_AFF, "ws map");

constexpr int CW_TMO = 0, CW_BAR = 4096;

constexpr int RING_BYTES = 131072;
constexpr int MISC_OFF = RING_BYTES + 320;
constexpr int LDS_BYTES = 147456;

struct Args { const float* in[30]; float* out; unsigned char* ws; int ph_lo, ph_hi, li, pad; };
enum { I_X = 0, I_C, I_CTX, I_CCTX, I_WMOD, I_BMOD, I_GATTN, I_GFFN, I_WIN, I_GNAQ, I_GNAK, I_RPB, I_GCQ, I_WUQ, I_GMQ, I_GCKV, I_WUKV, I_GKN, I_GKR,
       I_GDQ, I_GDK, I_DLAM, I_GDSUB, I_GGQ, I_GGK, I_WOUT, I_WROUTER, I_WGATE, I_WUP, I_WDOWN };

__device__ __forceinline__ bf16* w_in(const Args& a, int l) { return (bf16*)(l == 0 ? a.ws + WS_WIN : (unsigned char*)a.out + OUT_WIN1); }
__device__ __forceinline__ bf16* w_2(const Args& a, int l) { return (bf16*)(l == 0 ? a.ws + WS_W2 : (unsigned char*)a.out + OUT_W21); }
__device__ __forceinline__ bf16* w_out(const Args& a, int l) { return (bf16*)(l == 0 ? a.ws + WS_WOUT : (unsigned char*)a.out + OUT_WOUT1); }
__device__ __forceinline__ bf16* w_gu(const Args& a, int l) { return (bf16*)(a.ws + (l == 0 ? WS_WGU : WS_WGU1)); }
__device__ __forceinline__ bf16* w_d(const Args& a, int l) { return (bf16*)(l == 0 ? a.ws + WS_WD : (unsigned char*)a.out + OUT_WD1); }
__device__ __forceinline__ float* x2_of(const Args& a) { return (float*)(a.ws + WS_X2B); }
#if defined(MK_PROBE_KIND) && MK_PROBE_KIND >= 0
#define PV(bit) ((a.pad >> (bit)) & 1)
#else
#define PV(bit) 0
#endif
__device__ __forceinline__ float bf2f(unsigned short h) { return __uint_as_float((unsigned)h << 16); }
typedef float f32x2_t __attribute__((ext_vector_type(2))); typedef __bf16 bf16x2_t __attribute__((ext_vector_type(2)));
__device__ __forceinline__ unsigned pk2(float lo, float hi) { f32x2_t v = {lo, hi}; bf16x2_t b = __builtin_convertvector(v, bf16x2_t); return __builtin_bit_cast(unsigned, b); }
__device__ __forceinline__ int lane_now() { int l; asm volatile("v_mbcnt_lo_u32_b32 %0, -1, 0\n\tv_mbcnt_hi_u32_b32 %0, -1, %0" : "=v"(l)); return l; }
__device__ __forceinline__ int shx_i(int v, int m) { return __builtin_amdgcn_ds_bpermute((lane_now() ^ m) << 2, v); }
__device__ __forceinline__ float shx(float v, int m) { return __int_as_float(shx_i(__float_as_int(v), m)); }
__device__ __forceinline__ float shl(float v, int src_lane) { return __int_as_float(__builtin_amdgcn_ds_bpermute(src_lane << 2, __float_as_int(v))); }
__device__ __forceinline__ float wave_sum(float v) {
#pragma unroll
    for (int o = 1; o < 64; o <<= 1) v += shx(v, o);
    return v;
}
__device__ __forceinline__ int mset_of_row(int m) { return m < SEQ ? 0 : (m < NLAT ? 1 : 2); }
#define LDS_WAIT() asm volatile("s_waitcnt lgkmcnt(0)" ::: "memory")
#define VM_WAIT() asm volatile("s_waitcnt vmcnt(0)" ::: "memory")

__device__ __forceinline__ void pro_phase(const Args& a, LAS unsigned char* lds, int tid, int bid, int G) {
    LAS float* sc = (LAS float*)lds;
    LAS float* part = sc + 3 * 1024;
    float* MOD = (float*)(a.ws + WS_MOD);
    for (int u = bid; u < 96; u += G) {
        const int l = u / 48, cb = (u % 48) * 128;
        for (int i = tid; i < 3 * 1024; i += 512) { const int s = i >> 10, k = i & 1023; const float cv = s < 2 ? a.in[I_C][s * 1024 + k] : a.in[I_CCTX][k]; sc[i] = cv / (1.f + expf(-cv)); }
        __syncthreads();
        const int col = tid & 127, kq = tid >> 7;
        const float* w = a.in[I_WMOD] + (size_t)l * 1024 * 6144 + cb + col;
        float a0 = 0.f, a1 = 0.f, a2 = 0.f;
#pragma unroll 2
        for (int k0 = kq * 256; k0 < kq * 256 + 256; k0 += 32) {
            float wv[32];
#pragma unroll
            for (int i = 0; i < 32; ++i) wv[i] = w[(size_t)(k0 + i) * 6144];
            __builtin_amdgcn_sched_barrier(0);
#pragma unroll
            for (int i = 0; i < 32; ++i) { a0 += sc[k0 + i] * wv[i]; a1 += sc[1024 + k0 + i] * wv[i]; a2 += sc[2048 + k0 + i] * wv[i]; }
        }
        part[(kq * 3 + 0) * 128 + col] = a0; part[(kq * 3 + 1) * 128 + col] = a1; part[(kq * 3 + 2) * 128 + col] = a2;
        __syncthreads();
        if (tid < 384) { const int s = tid >> 7, c = tid & 127;
            const float r = ((part[(0 * 3 + s) * 128 + c] + part[(1 * 3 + s) * 128 + c]) + (part[(2 * 3 + s) * 128 + c] + part[(3 * 3 + s) * 128 + c])) + a.in[I_BMOD][l * 6144 + cb + c];
            MOD[(l * 3 + s) * 6144 + cb + c] = r; }
        __syncthreads();
    }
    if (bid == 0 && tid < 2) {
        const float* lp = a.in[I_DLAM] + tid * 128; float s0 = 0.f, s1 = 0.f;
        for (int i = 0; i < 32; ++i) { s0 += lp[i] * lp[32 + i]; s1 += lp[64 + i] * lp[96 + i]; }
        const float lam_init = 0.8f - 0.6f * expf(-0.3f * (float)tid);
        ((float*)(a.ws + WS_LAM))[2 * tid] = expf(s0) - expf(s1) + lam_init; ((float*)(a.ws + WS_LAM))[2 * tid + 1] = 1.f - lam_init;
    }
}

__device__ __forceinline__ void conv_item(const float* src, size_t sld, bf16* dst, size_t dld, bool zero, LAS float* scr, int lane) {
    const int c = lane & 7;
    if (zero) {
#pragma unroll
        for (int j = 0; j < 4; ++j) { const int n = (lane >> 3) + 8 * j; *(u32x4*)(dst + (size_t)n * dld + 8 * c) = (u32x4){0u, 0u, 0u, 0u}; }
        return;
    }
    f32x4 v[8];
#pragma unroll
    for (int i = 0; i < 8; ++i) { const int kk = 8 * i + (lane >> 3), c4 = 4 * (lane & 7); v[i] = *(const f32x4*)(src + (size_t)kk * sld + c4); }
    __builtin_amdgcn_sched_barrier(0);
#pragma unroll
    for (int i = 0; i < 8; ++i) { const int kk = 8 * i + (lane >> 3), c4 = 4 * (lane & 7); LAS float* d = scr + kk * 33 + c4; d[0] = v[i].x; d[1] = v[i].y; d[2] = v[i].z; d[3] = v[i].w; }
    LDS_WAIT(); asm volatile("" ::: "memory");
#pragma unroll
    for (int j = 0; j < 4; ++j) { const int n = (lane >> 3) + 8 * j; const LAS float* s = scr + (8 * c) * 33 + n;
        u32x4 o; o.x = pk2(s[0 * 33], s[1 * 33]); o.y = pk2(s[2 * 33], s[3 * 33]); o.z = pk2(s[4 * 33], s[5 * 33]); o.w = pk2(s[6 * 33], s[7 * 33]);
        *(u32x4*)(dst + (size_t)n * dld + 8 * c) = o; }
    LDS_WAIT(); asm volatile("" ::: "memory");
}
constexpr int CV_WIN = 1280, CV_WOUT = 512, CV_W2 = 1024, CV_GU = 16 * 2816, CV_D = 16 * 1408, CV_ALL = CV_WIN + CV_WOUT + CV_W2 + CV_GU + CV_D;
__device__ __forceinline__ void conv_items(const Args& a, int l, int lo, int hi, LAS unsigned char* lds, int lane, int wave, int gw, int NGW) {
    LAS float* scr = (LAS float*)(lds + wave * 8704);
    bf16* WIN = w_in(a, l); bf16* W2 = w_2(a, l); bf16* WOUT = w_out(a, l); bf16* WGU = w_gu(a, l); bf16* WD = w_d(a, l);
    for (int it0 = lo + gw; it0 < hi; it0 += NGW) {
        int it = it0;
        if (it < CV_WIN) { const int kb = it / 80, nb = it % 80, n0 = 32 * nb, k0 = 64 * kb; const bool zero = n0 >= 2464;
            const int sc = n0 < 1152 ? n0 : (n0 < 2432 ? n0 + 32 : n0 - 2432 + 1152);
            conv_item(a.in[I_WIN] + (size_t)l * 1024 * 2464 + (size_t)k0 * 2464 + (zero ? 0 : sc), 2464, WIN + ((size_t)(n0 >> 5) * 16 + kb) * 2048, 64, zero, scr, lane); continue; }
        it -= CV_WIN;
        if (it < CV_WOUT) { const int kb = it / 32, nb = it % 32, n0 = 32 * nb, k0 = 64 * kb;
            conv_item(a.in[I_WOUT] + (size_t)l * 1024 * 1024 + (size_t)k0 * 1024 + n0, 1024, WOUT + ((size_t)(n0 >> 5) * 16 + kb) * 2048, 64, false, scr, lane); continue; }
        it -= CV_WOUT;
        if (it < CV_W2) { const int n = it;
#pragma unroll
            for (int i = 0; i < 6; ++i) { const int k = lane + 64 * i; float v = 0.f;
                if (n < 512) { const int h = n >> 7, j = n & 127; if (j < 96 && k < 256) v = a.in[I_WUQ][(size_t)l * 256 * 384 + (size_t)k * 384 + 96 * h + j] * a.in[I_GCQ][l * 256 + k]; }
                else { if (k >= 256) v = a.in[I_WUKV][(size_t)l * 128 * 512 + (size_t)(k - 256) * 512 + (n - 512)] * a.in[I_GCKV][l * 128 + (k - 256)]; }
                W2[((((size_t)(n >> 5) * 24 + (k >> 4)) * 64) + ((k >> 3) & 1) * 32 + (n & 31)) * 8 + (k & 7)] = (bf16)(pk2(v, 0.f) & 0xffffu); }
            continue; }
        it -= CV_W2;
        if (it < CV_GU) { const int e = it / 2816, r = it % 2816, kb = r / 176, nb = r % 176, n0 = 32 * nb, k0 = 64 * kb, pn = n0 >> 8, half = (n0 >> 7) & 1, j0 = n0 & 127;
            const float* src = (half ? a.in[I_WUP] : a.in[I_WGATE]) + ((size_t)(l * 16 + e) * 1024 + k0) * 2816 + 128 * pn + j0;
            const size_t gap = (l == 1 && e >= GU_SPLIT_E) ? (size_t)GU_GAP_TILES * 256 * 1024 : 0;
            conv_item(src, 2816, WGU + ((size_t)((e * 5632 + n0) >> 5) * 16 + kb) * 2048 + gap, 64, false, scr, lane); continue; }
        it -= CV_GU;
        { const int e = it / 1408, r = it % 1408, kb = r / 32, nb = r % 32, n0 = 32 * nb, k0 = 64 * kb;
            conv_item(a.in[I_WDOWN] + ((size_t)(l * 16 + e) * 2816 + k0) * 1024 + n0, 1024, WD + ((size_t)((e * 1024 + n0) >> 5) * 44 + kb) * 2048, 64, false, scr, lane); }
    }
}

__device__ __forceinline__ int xe_rowbase(int set4, int e) { return set4 < 2 ? (set4 * 16 + e) * 2048 : XE_LAT + e * 256 + (set4 - 2) * 32; }
__device__ __forceinline__ void combine_row(const Args& a, int l, int m, int lane, f32x4 (&v)[4], const f32x4 (&g2)[4]) {
    const float* X1 = (const float*)(a.ws + WS_X1); const bf16* Y = (const bf16*)(a.ws + WS_Y); const int* SEL = (const int*)(a.ws + WS_SEL);
    const int set4 = m < SEQ ? 0 : (m < NLAT ? 1 : (m < NLAT + CTXL ? 2 : 3));
    f32x4 s[4];
#pragma unroll
    for (int j = 0; j < 4; ++j) s[j] = (f32x4){0.f, 0.f, 0.f, 0.f};
    f32x4 xr[4];
#pragma unroll
    for (int j = 0; j < 4; ++j) xr[j] = *(const f32x4*)(X1 + (size_t)m * D + 4 * lane + 256 * j);
#define ACC_Y(w_) do { _Pragma("unroll") for (int j = 0; j < 4; ++j) { s[j].x += __uint_as_float(w_[j].x << 16); s[j].y += __uint_as_float(w_[j].x & 0xffff0000u); s[j].z += __uint_as_float(w_[j].y << 16); s[j].w += __uint_as_float(w_[j].y & 0xffff0000u); } } while (0)
    const int myslot = (lane < 16) ? SEL[(size_t)m * 16 + lane] : -1;
    unsigned mask = (unsigned)__ballot(myslot >= 0);
    while (mask) {
        const int ea = __builtin_ctz(mask); mask &= mask - 1u;
        const bf16* ya = Y + (size_t)(xe_rowbase(set4, ea) + __builtin_amdgcn_readlane(myslot, ea)) * D + 4 * lane;
        u32x2 wa[4];
#pragma unroll
        for (int j = 0; j < 4; ++j) wa[j] = *(const u32x2*)(ya + 256 * j);
        if (mask) {
            const int eb = __builtin_ctz(mask); mask &= mask - 1u;
            const bf16* yb = Y + (size_t)(xe_rowbase(set4, eb) + __builtin_amdgcn_readlane(myslot, eb)) * D + 4 * lane;
            u32x2 wb[4];
#pragma unroll
            for (int j = 0; j < 4; ++j) wb[j] = *(const u32x2*)(yb + 256 * j);
            ACC_Y(wa); ACC_Y(wb);
        } else { ACC_Y(wa); }
    }
#undef ACC_Y
#pragma unroll
    for (int j = 0; j < 4; ++j) v[j] = xr[j] + g2[j] * s[j];
}
__device__ __forceinline__ void ld_gate2(const Args& a, int l, int set, int lane, f32x4 (&g2)[4]) {
    const float* MOD = (const float*)(a.ws + WS_MOD) + (size_t)(l * 3 + set) * 6144;
#pragma unroll
    for (int j = 0; j < 4; ++j) g2[j] = *(const f32x4*)(MOD + 5 * 1024 + 4 * lane + 256 * j);
}
__device__ __forceinline__ void modul_phase(const Args& a, int l, int lane, int wave, int vcu, int G) {
    const int gw = vcu * 8 + wave, NGW = G * 8;
    bf16* H = (bf16*)(a.ws + WS_H); float* X2 = x2_of(a);
    const float* gat = a.in[I_GATTN] + l * D;
    int cset = -1; f32x4 gg[4], sh[4], g2[4];
#pragma unroll
    for (int j = 0; j < 4; ++j) { gg[j] = (f32x4){0.f, 0.f, 0.f, 0.f}; sh[j] = gg[j]; g2[j] = gg[j]; }
    f32x4 vn[4];
#define MD_SRC(m_) ((m_) < NLAT ? a.in[I_X] + (size_t)(m_) * D : a.in[I_CTX] + (size_t)((m_) - NLAT) * D)
    if (l == 0 && gw < NROW) { const float* src = MD_SRC(gw);
#pragma unroll
        for (int j = 0; j < 4; ++j) vn[j] = *(const f32x4*)(src + 4 * lane + 256 * j); }
    for (int m = gw; m < NROW; m += NGW) {
        const int set = mset_of_row(m);
        if (set != cset) { cset = set; const float* MOD = (const float*)(a.ws + WS_MOD) + (size_t)(l * 3 + set) * 6144;
#pragma unroll
            for (int j = 0; j < 4; ++j) { const int c = 4 * lane + 256 * j; const f32x4 g = *(const f32x4*)(gat + c), scl = *(const f32x4*)(MOD + 1024 + c); sh[j] = *(const f32x4*)(MOD + c); gg[j] = g * (scl + 1.f); }
            if (l == 1) ld_gate2(a, 0, set, lane, g2); }
        f32x4 v[4];
        if (l == 0) {
#pragma unroll
            for (int j = 0; j < 4; ++j) v[j] = vn[j];
            if (m + NGW < NROW) { const float* src = MD_SRC(m + NGW);
#pragma unroll
                for (int j = 0; j < 4; ++j) vn[j] = *(const f32x4*)(src + 4 * lane + 256 * j); }
            __builtin_amdgcn_sched_barrier(0); }
        else { combine_row(a, 0, m, lane, v, g2);
#pragma unroll
            for (int j = 0; j < 4; ++j) *(f32x4*)(X2 + (size_t)m * D + 4 * lane + 256 * j) = v[j]; }
        float ss = 0.f;
#pragma unroll
        for (int j = 0; j < 4; ++j) ss += (v[j].x * v[j].x + v[j].y * v[j].y) + (v[j].z * v[j].z + v[j].w * v[j].w);
        const float rstd = rsqrtf(wave_sum(ss) * (1.f / D) + EPS);
#pragma unroll
        for (int j = 0; j < 4; ++j) { const int c = 4 * lane + 256 * j; const f32x4 h = v[j] * rstd * gg[j] + sh[j];
            u32x2 o; o.x = pk2(h.x, h.y); o.y = pk2(h.z, h.w); *(u32x2*)(H + (size_t)m * D + c) = o; }
    }
#undef MD_SRC
}
__device__ __forceinline__ void final_phase(const Args& a, int lane, int wave, int vcu, int G) {
    const int gw = vcu * 8 + wave, NGW = G * 8;
    int cset = -1; f32x4 g2[4];
#pragma unroll
    for (int j = 0; j < 4; ++j) g2[j] = (f32x4){0.f, 0.f, 0.f, 0.f};
    for (int m = gw; m < NLAT; m += NGW) {
        const int set = mset_of_row(m);
        if (set != cset) { cset = set; ld_gate2(a, 1, set, lane, g2); }
        f32x4 v[4]; combine_row(a, 1, m, lane, v, g2);
#pragma unroll
        for (int j = 0; j < 4; ++j) *(f32x4*)(a.out + (size_t)m * D + 4 * lane + 256 * j) = v[j];
    }
}
#define XB_TMO      128
#define XB_XCNT(j)  (256  + 64 * (j))
#define XB_XSUB(j)  (1280 + 64 * (j))
#define XB_XGEN(j)  (2304 + 64 * (j))
#define XB_TOP      3328
#define XB_TOPGEN   3392
#define XCD_BAR_WORDS 3456
#define XB_SPIN_CAP (1u << 18)

__device__ __forceinline__ unsigned xb_ld(unsigned* p)              { return __hip_atomic_load(p, __ATOMIC_RELAXED, __HIP_MEMORY_SCOPE_AGENT); }
__device__ __forceinline__ unsigned xb_add(unsigned* p, unsigned v) { return __hip_atomic_fetch_add(p, v, __ATOMIC_RELAXED, __HIP_MEMORY_SCOPE_AGENT); }
__device__ __forceinline__ unsigned xb_xcc_id() { return (unsigned)__builtin_amdgcn_s_getreg((3 << 11) | 20) & 0xFu; }
#define XB_SPIN(cond, bar) do { unsigned _sp = 0; while (cond) { __builtin_amdgcn_s_sleep(1); \
    if ((++_sp & 255u) == 0u) { if (xb_ld(&(bar)[XB_TMO])) break; if (_sp > XB_SPIN_CAP) { atomicAdd(&(bar)[XB_TMO], 1u); break; } } } } while (0)

struct XcdBarrier {
    unsigned* bar; unsigned x;
    volatile LAS unsigned* st;
};

__device__ __forceinline__ XcdBarrier xcd_barrier_post(unsigned* bar, volatile LAS unsigned* st, bool t0  ) {
    XcdBarrier b; b.bar = bar; b.x = xb_xcc_id(); b.st = st;
    if (t0) (void)xb_add(&bar[XB_XCNT(b.x)], 1u);
    return b;
}
__device__ __forceinline__ void xcd_barrier_complete(unsigned* bar, unsigned x, unsigned& nloc, unsigned& nx) {
    const unsigned G = gridDim.x * gridDim.y * gridDim.z;
    unsigned sum, cnt, mine, sp = 0u;
    for (;;) {
        sum = 0u; cnt = 0u; mine = 0u;
#pragma unroll
        for (unsigned j = 0; j < 16; ++j) { const unsigned c = xb_ld(&bar[XB_XCNT(j)]); sum += c; cnt += (c > 0u) ? 1u : 0u; mine = (j == x) ? c : mine; }
        if (sum == G) break;
        __builtin_amdgcn_s_sleep(1);
        if ((++sp & 255u) == 0u) { if (xb_ld(&bar[XB_TMO])) break; if (sp > XB_SPIN_CAP) { atomicAdd(&bar[XB_TMO], 1u); break; } }
    }
    nloc = mine > 0u ? mine : 1u; nx = cnt > 0u ? cnt : 1u;
}

__device__ __forceinline__ void xcd_barrier(const XcdBarrier& b, bool t0  ) {
    asm volatile("s_waitcnt vmcnt(0)" ::: "memory");
    __syncthreads();
    if (t0) {
        unsigned* bar = b.bar;
        __builtin_amdgcn_s_waitcnt(0);
        unsigned nloc = b.st[0], nx = b.st[1];
        if (nloc == 0u) { xcd_barrier_complete(bar, b.x, nloc, nx); b.st[0] = nloc; b.st[1] = nx; }
        const unsigned old = xb_add(&bar[XB_XSUB(b.x)], 1u);
        const unsigned gen = old / nloc;
        if (old + 1u == (gen + 1u) * nloc) {
            __builtin_amdgcn_fence(__ATOMIC_RELEASE, "agent");
            asm volatile("s_waitcnt vmcnt(0)" ::: "memory");
            const unsigned og = xb_add(&bar[XB_TOP], 1u);
            const unsigned tg = og / nx;
            if (og + 1u == (tg + 1u) * nx) xb_add(&bar[XB_TOPGEN], 1u);
            else XB_SPIN(xb_ld(&bar[XB_TOPGEN]) == tg, bar);
            __builtin_amdgcn_fence(__ATOMIC_ACQUIRE, "agent");
            xb_add(&bar[XB_XGEN(b.x)], 1u);
            asm volatile("s_waitcnt vmcnt(0)" ::: "memory");
        } else {
            XB_SPIN(xb_ld(&bar[XB_XGEN(b.x)]) == gen, bar);
            __builtin_amdgcn_fence(__ATOMIC_ACQUIRE, "agent");
            asm volatile("s_waitcnt vmcnt(0)" ::: "memory");
        }
    }
    __syncthreads();
}

struct TokTile { int m0; int b; int ktile; int prow; bool lat; };
__device__ __forceinline__ TokTile tok_tile(int T) {
    TokTile t; t.m0 = 64 * T;
    if (T < 512) { t.b = T >> 8; t.prow = T & 255; t.ktile = 4 + t.prow; t.lat = true; }
    else { const int c = T - 512; t.b = c >> 2; t.ktile = c & 3; t.prow = 0; t.lat = false; }
    return t;
}
template <int N> __device__ __forceinline__ void ld_row(const bf16* p, float (&v)[N]) {
#pragma unroll
    for (int i = 0; i < N / 8; ++i) { const u32x4 w = *(const u32x4*)(p + 8 * i);
        v[8 * i + 0] = __uint_as_float(w.x << 16); v[8 * i + 1] = __uint_as_float(w.x & 0xffff0000u); v[8 * i + 2] = __uint_as_float(w.y << 16); v[8 * i + 3] = __uint_as_float(w.y & 0xffff0000u);
        v[8 * i + 4] = __uint_as_float(w.z << 16); v[8 * i + 5] = __uint_as_float(w.z & 0xffff0000u); v[8 * i + 6] = __uint_as_float(w.w << 16); v[8 * i + 7] = __uint_as_float(w.w & 0xffff0000u); }
}
template <int N> __device__ __forceinline__ void up_row(const u32x4 (&raw)[8], float (&v)[N]) {
#pragma unroll
    for (int i = 0; i < N / 8; ++i) { const u32x4 w = raw[i];
        v[8 * i + 0] = __uint_as_float(w.x << 16); v[8 * i + 1] = __uint_as_float(w.x & 0xffff0000u); v[8 * i + 2] = __uint_as_float(w.y << 16); v[8 * i + 3] = __uint_as_float(w.y & 0xffff0000u);
        v[8 * i + 4] = __uint_as_float(w.z << 16); v[8 * i + 5] = __uint_as_float(w.z & 0xffff0000u); v[8 * i + 6] = __uint_as_float(w.w << 16); v[8 * i + 7] = __uint_as_float(w.w & 0xffff0000u); }
}
template <int N> __device__ __forceinline__ void rms_gain(float (&v)[N], const float* g) {
    float ss = 0.f;
#pragma unroll
    for (int i = 0; i < N; ++i) ss += v[i] * v[i];
    const float r = rsqrtf(ss * (1.f / N) + EPS);
#pragma unroll
    for (int i = 0; i < N; ++i) v[i] = v[i] * r * g[i];
}
constexpr float ROPE_INVR[16] = {1.591549431e-01f, 8.949940161e-02f, 5.032921210e-02f, 2.830219583e-02f, 1.591549431e-02f, 8.949940161e-03f, 5.032921210e-03f, 2.830219583e-03f,
                                 1.591549431e-03f, 8.949940161e-04f, 5.032921210e-04f, 2.830219583e-04f, 1.591549431e-04f, 8.949940161e-05f, 5.032921210e-05f, 2.830219583e-05f};
template <int OFF, int NR, int N> __device__ __forceinline__ void rope2d(float (&v)[N], float tr, float tc) {
    constexpr int Q = NR / 4, FS = 64 / NR;
#pragma unroll
    for (int d = 0; d < Q; ++d) {
        { const float t = __builtin_amdgcn_fractf(tr * ROPE_INVR[FS * d]); const float c = __builtin_amdgcn_cosf(t), s = __builtin_amdgcn_sinf(t); const float x1 = v[OFF + d], x2 = v[OFF + Q + d]; v[OFF + d] = x1 * c - x2 * s; v[OFF + Q + d] = x1 * s + x2 * c; }
        { const float t = __builtin_amdgcn_fractf(tc * ROPE_INVR[FS * d]); const float c = __builtin_amdgcn_cosf(t), s = __builtin_amdgcn_sinf(t); const float x1 = v[OFF + 2 * Q + d], x2 = v[OFF + 3 * Q + d]; v[OFF + 2 * Q + d] = x1 * c - x2 * s; v[OFF + 3 * Q + d] = x1 * s + x2 * c; }
    }
}
template <int N> __device__ __forceinline__ void st_row(bf16* p, const float (&v)[N], float sc) {
#pragma unroll
    for (int i = 0; i < N / 8; ++i) { u32x4 w; w.x = pk2(v[8 * i] * sc, v[8 * i + 1] * sc); w.y = pk2(v[8 * i + 2] * sc, v[8 * i + 3] * sc); w.z = pk2(v[8 * i + 4] * sc, v[8 * i + 5] * sc); w.w = pk2(v[8 * i + 6] * sc, v[8 * i + 7] * sc);
        *(u32x4*)(p + 8 * i) = w; }
}
template <int N> __device__ __forceinline__ void st_ktile(bf16* tile, int chunk0, const float (&v)[N], int lane) {
#pragma unroll
    for (int i = 0; i < N / 8; ++i) { u32x4 w; w.x = pk2(v[8 * i], v[8 * i + 1]); w.y = pk2(v[8 * i + 2], v[8 * i + 3]); w.z = pk2(v[8 * i + 4], v[8 * i + 5]); w.w = pk2(v[8 * i + 6], v[8 * i + 7]);
        *(u32x4*)(tile + (size_t)(chunk0 + i) * 512 + lane * 8) = w; }
}
__device__ __forceinline__ void st_vtile(bf16* tile, const float (&v)[64], LAS bf16* scr, int lane) {
#pragma unroll
    for (int dv = 0; dv < 64; dv += 2) { const unsigned w = pk2(v[dv], v[dv + 1]); scr[dv * 72 + lane] = (bf16)(w & 0xffffu); scr[(dv + 1) * 72 + lane] = (bf16)(w >> 16); }
    LDS_WAIT(); asm volatile("" ::: "memory");
#pragma unroll
    for (int kc = 0; kc < 8; ++kc) { const u32x4 w = *(const LAS u32x4*)(scr + lane * 72 + kc * 8); *(u32x4*)(tile + (size_t)kc * 512 + lane * 8) = w; }
    LDS_WAIT(); asm volatile("" ::: "memory");
}
template <int N> __device__ __forceinline__ void ld_row_oct(const bf16* p, float (&v)[N]) {
#pragma unroll
    for (int i = 0; i < N / 8; ++i) { const u32x4 w = *(const u32x4*)(p + 512 * i);
        v[8 * i + 0] = __uint_as_float(w.x << 16); v[8 * i + 1] = __uint_as_float(w.x & 0xffff0000u); v[8 * i + 2] = __uint_as_float(w.y << 16); v[8 * i + 3] = __uint_as_float(w.y & 0xffff0000u);
        v[8 * i + 4] = __uint_as_float(w.z << 16); v[8 * i + 5] = __uint_as_float(w.z & 0xffff0000u); v[8 * i + 6] = __uint_as_float(w.w << 16); v[8 * i + 7] = __uint_as_float(w.w & 0xffff0000u); }
}
template <int NCH> __device__ __forceinline__ void norm_wide(const bf16* src, const float* g, bf16* a2f, int m, int k0) {
    float ss = 0.f;
#pragma unroll
    for (int c = 0; c < NCH; ++c) { asm volatile("" ::: "memory"); float v[64]; ld_row_oct<64>(src + 4096 * c, v);
#pragma unroll
        for (int i = 0; i < 64; ++i) ss += v[i] * v[i]; }
    const float r = rsqrtf(ss * (1.f / (64 * NCH)) + EPS);
    asm volatile("" ::: "memory");
#pragma unroll
    for (int c = 0; c < NCH; ++c) { asm volatile("" ::: "memory"); float v[64]; ld_row_oct<64>(src + 4096 * c, v);
#pragma unroll
        for (int i = 0; i < 64; ++i) v[i] = v[i] * r * g[64 * c + i];
#pragma unroll
        for (int i = 0; i < 8; ++i) { const int k = k0 + 64 * c + 8 * i; u32x4 w; w.x = pk2(v[8 * i], v[8 * i + 1]); w.y = pk2(v[8 * i + 2], v[8 * i + 3]); w.z = pk2(v[8 * i + 4], v[8 * i + 5]); w.w = pk2(v[8 * i + 6], v[8 * i + 7]);
            *(u32x4*)(a2f + ((((size_t)(m >> 5) * 24 + (k >> 4)) * 64) + ((k >> 3) & 1) * 32 + (m & 31)) * 8) = w; } }
}
constexpr int NJ1 = 43, NJ2 = 12, NTT = NROW / 64;
constexpr float C2_64 = 0.125f * LOG2E, C2_32 = 0.17677669529663687f * LOG2E, C2_96 = 0.10206207261596575f * LOG2E;
__device__ __forceinline__ bf16* ktile_ptr(unsigned char* ws, size_t off, int nheads, int dk, int b, int h, int kt) { return (bf16*)(ws + off) + ((size_t)(b * nheads + h) * NTILE + kt) * (size_t)(64 * dk); }

__device__ __forceinline__ int job1_col(int j) {
    if (j < 4) return 64 * j; if (j < 8) return 256 + 64 * (j - 4); if (j < 12) return 512 + 64 * (j - 8); if (j == 12) return 768; if (j == 13) return 1024; if (j == 14) return 2432;
    if (j < 23) return 1152 + 32 * (j - 15); if (j < 31) return 1408 + 32 * (j - 23); if (j < 35) return 1664 + 64 * (j - 31); if (j < 39) return 1920 + 64 * (j - 35); if (j < 41) return 2176 + 64 * (j - 39);
    return 2304 + 64 * (j - 41);
}
__device__ __forceinline__ void prep1_phase(const Args& a, int l, LAS unsigned char* lds, int lane_in, int wave, int vcu, int G) {
    LAS bf16* scr = (LAS bf16*)(lds + wave * 9216);
    const int gw = vcu * 8 + wave, NGW = G * 8;
    const bf16* P = (const bf16*)(a.ws + WS_P);
    u32x4 raw[8];
#define P1_LOAD(it_, lane_) do { const int T_ = (it_) / NJ1, j_ = (it_) % NJ1; const bf16* p_ = P + (((size_t)T_ * (NP / 8) + (job1_col(j_) >> 3)) * 64 + (lane_)) * 8; _Pragma("unroll") for (int i_ = 0; i_ < 8; ++i_) raw[i_] = *(const u32x4*)(p_ + 512 * i_); } while (0)
#define P1_NEXT() do { if (it + NGW < NTT * NJ1) P1_LOAD(it + NGW, lane); __builtin_amdgcn_sched_barrier(0); } while (0)
    if (gw < NTT * NJ1) P1_LOAD(gw, lane_in);
    for (int it = gw; it < NTT * NJ1; it += NGW) {
        int lane = lane_in; asm volatile("" : "+v"(lane));
        const int T = it / NJ1, j = it % NJ1; const TokTile tt = tok_tile(T); const int m = tt.m0 + lane;
        const float tr = (float)tt.prow, tc = (float)lane;
        if (j < 4) { float v[64]; up_row<64>(raw, v); P1_NEXT(); rms_gain<64>(v, a.in[I_GNAQ] + l * 64); st_row<64>((bf16*)(a.ws + WS_QNA) + (size_t)m * 256 + 64 * j, v, C2_64); }
        else if (j < 8) { const int h = j - 4; float v[64]; up_row<64>(raw, v); P1_NEXT(); rms_gain<64>(v, a.in[I_GNAK] + l * 64); st_ktile<64>(ktile_ptr(a.ws, WS_KNA, 4, 64, tt.b, h, tt.ktile), 0, v, lane); }
        else if (j < 12) { const int h = j - 8; float v[64]; up_row<64>(raw, v); P1_NEXT(); st_vtile(ktile_ptr(a.ws, WS_VNA, 4, 64, tt.b, h, tt.ktile), v, scr, lane); }
        else if (j < 14) { P1_NEXT(); }
        else if (j == 14) { float v[32]; up_row<32>(raw, v); P1_NEXT(); rms_gain<32>(v, a.in[I_GKR] + l * 32); if (tt.lat) rope2d<0, 32, 32>(v, tr, tc);
#pragma unroll
            for (int h = 0; h < 4; ++h) st_ktile<32>(ktile_ptr(a.ws, WS_KMLA, 4, 96, tt.b, h, tt.ktile), 8, v, lane); }
        else if (j < 23) { const int h = (j - 15) >> 1, c = (j - 15) & 1; float v[32]; up_row<32>(raw, v); P1_NEXT(); rms_gain<32>(v, a.in[I_GDQ] + l * 64 + 32 * c); if (tt.lat) rope2d<0, 32, 32>(v, tr, tc);
            st_row<32>((bf16*)(a.ws + WS_QDIFF) + (size_t)m * 256 + 64 * h + 32 * c, v, C2_32); }
        else if (j < 31) { const int h = (j - 23) >> 1, c = (j - 23) & 1; float v[32]; up_row<32>(raw, v); P1_NEXT(); rms_gain<32>(v, a.in[I_GDK] + l * 64 + 32 * c); if (tt.lat) rope2d<0, 32, 32>(v, tr, tc);
            st_ktile<32>(ktile_ptr(a.ws, WS_KDIFF, 4, 64, tt.b, h, tt.ktile), 4 * c, v, lane); }
        else if (j < 35) { const int h = j - 31; float v[64]; up_row<64>(raw, v); P1_NEXT(); st_vtile(ktile_ptr(a.ws, WS_VDIFF, 4, 64, tt.b, h, tt.ktile), v, scr, lane); }
        else if (j < 39) { const int h = j - 35; float v[64]; up_row<64>(raw, v); P1_NEXT(); rms_gain<64>(v, a.in[I_GGQ] + l * 64); if (tt.lat) rope2d<0, 64, 64>(v, tr, tc);
            st_row<64>((bf16*)(a.ws + WS_QGQA) + (size_t)m * 256 + 64 * h, v, C2_64); }
        else if (j < 41) { const int h = j - 39; float v[64]; up_row<64>(raw, v); P1_NEXT(); rms_gain<64>(v, a.in[I_GGK] + l * 64); if (tt.lat) rope2d<0, 64, 64>(v, tr, tc);
            st_ktile<64>(ktile_ptr(a.ws, WS_KGQA, 2, 64, tt.b, h, tt.ktile), 0, v, lane); }
        else { const int h = j - 41; float v[64]; up_row<64>(raw, v); P1_NEXT(); st_vtile(ktile_ptr(a.ws, WS_VGQA, 2, 64, tt.b, h, tt.ktile), v, scr, lane); }
    }
#undef P1_LOAD
#undef P1_NEXT
}
__device__ __forceinline__ void prep2_phase(const Args& a, int l, LAS unsigned char* lds, int lane_in, int wave, int vcu, int G) {
    LAS bf16* scr = (LAS bf16*)(lds + wave * 9216);
    const int gw = vcu * 8 + wave, NGW = G * 8;
    const bf16* U = (const bf16*)(a.ws + WS_U);
    u32x4 raw[8];
#define P2_LOAD(it_, lane_) do { const int T_ = (it_) / NJ2, j_ = (it_) % NJ2; const bf16* p_ = U + (size_t)(64 * T_ + (lane_)) * D + (j_ < 4 ? 128 * j_ : (j_ < 8 ? 512 + 128 * (j_ - 4) : 512 + 128 * (j_ - 8) + 64)); \
        _Pragma("unroll") for (int i_ = 0; i_ < 8; ++i_) raw[i_] = *(const u32x4*)(p_ + 8 * i_); } while (0)
#define P2_NEXT() do { if (it + NGW < NTT * NJ2) P2_LOAD(it + NGW, lane); __builtin_amdgcn_sched_barrier(0); } while (0)
    if (gw < NTT * NJ2) P2_LOAD(gw, lane_in);
    for (int it = gw; it < NTT * NJ2; it += NGW) {
        int lane = lane_in; asm volatile("" : "+v"(lane));
        const int T = it / NJ2, j = it % NJ2; const TokTile tt = tok_tile(T); const int m = tt.m0 + lane;
        const bf16* urow = U + (size_t)m * D; const float tr = (float)tt.prow, tc = (float)lane;
        if (j < 4) { const bf16* src = urow + 128 * j; const float* g = a.in[I_GMQ] + l * 96; bf16* dst = (bf16*)(a.ws + WS_QMLA) + (size_t)m * 384 + 96 * j; float ss = 0.f;
            P2_NEXT();
#pragma unroll
            for (int c = 0; c < 3; ++c) { asm volatile("" ::: "memory"); float v[32]; ld_row<32>(src + 32 * c, v);
#pragma unroll
                for (int i = 0; i < 32; ++i) ss += v[i] * v[i]; }
            const float r = rsqrtf(ss * (1.f / 96.f) + EPS);
#pragma unroll
            for (int c = 0; c < 3; ++c) { asm volatile("" ::: "memory"); float v[32]; ld_row<32>(src + 32 * c, v);
#pragma unroll
                for (int i = 0; i < 32; ++i) v[i] = v[i] * r * g[32 * c + i];
                if (c == 2 && tt.lat) rope2d<0, 32, 32>(v, tr, tc);
                st_row<32>(dst + 32 * c, v, C2_96); } }
        else if (j < 8) { const int h = j - 4; float v[64]; up_row<64>(raw, v); P2_NEXT(); rms_gain<64>(v, a.in[I_GKN] + l * 64); st_ktile<64>(ktile_ptr(a.ws, WS_KMLA, 4, 96, tt.b, h, tt.ktile), 0, v, lane); }
        else { const int h = j - 8; float v[64]; up_row<64>(raw, v); P2_NEXT(); st_vtile(ktile_ptr(a.ws, WS_VMLA, 4, 64, tt.b, h, tt.ktile), v, scr, lane); }
    }
#undef P2_LOAD
#undef P2_NEXT
}

__device__ __forceinline__ int pi32(int r) { return (r & 0x13) | ((r & 4) << 1) | ((r & 8) >> 1); }
__device__ __forceinline__ bf16x8 pack8(const f32x16& p, int base) {
    u32x4 w; w.x = pk2(p[base], p[base + 1]); w.y = pk2(p[base + 2], p[base + 3]); w.z = pk2(p[base + 4], p[base + 5]); w.w = pk2(p[base + 6], p[base + 7]);
    return __builtin_bit_cast(bf16x8, w);
}
#define MFMA32(A, B, C) __builtin_amdgcn_mfma_f32_32x32x16_bf16((A), (B), (C), 0, 0, 0)
__device__ __forceinline__ void store_ot(bf16* orow, const f32x16& o0, const f32x16& o1, int hi) {
#pragma unroll
    for (int g = 0; g < 4; ++g) {
        u32x2 w0, w1; w0.x = pk2(o0[4 * g], o0[4 * g + 1]); w0.y = pk2(o0[4 * g + 2], o0[4 * g + 3]); w1.x = pk2(o1[4 * g], o1[4 * g + 1]); w1.y = pk2(o1[4 * g + 2], o1[4 * g + 3]);
        *(u32x2*)(orow + 8 * g + 4 * hi) = w0; *(u32x2*)(orow + 32 + 8 * g + 4 * hi) = w1;
    }
}
#define SBAR() __builtin_amdgcn_sched_barrier(0)
#define EX2(x) __builtin_amdgcn_exp2f(x)
#define ZERO16 ((f32x16){})
__device__ __forceinline__ float fadd_s(float a, float b) { float r; asm("v_add_f32_e32 %0, %1, %2" : "=v"(r) : "v"(a), "v"(b)); return r; }
#define FADD(a, b) fadd_s((a), (b))
#if defined(MK_XPROBE) && MK_XPROBE == 2
#define XPROBE(x) do { float d0_, d1_; asm volatile("v_exp_f32 %0, %2\n\tv_exp_f32 %1, %2" : "=&v"(d0_), "=&v"(d1_) : "v"(x)); } while (0)
#else
#define XPROBE(x) do { } while (0)
#endif
#define ATT_GQA_PRE(KCUR1) do { \
        kf0 = *(const LAS bf16x8*)(KCUR1 + 0); \
        kf1 = *(const LAS bf16x8*)(KCUR1 + 2048); \
    } while (0)
#define ATT_GQA_ITER(KCUR1, KNEXT0, KNEXT1, VPREV1, VCUR0) do { \
        kf2 = *(const LAS bf16x8*)(KCUR1 + 4096); \
        SB_a = MFMA32(kf0, qa[0], ZERO16); \
        SA_a[0] = EX2(SA_a[0]); SA_a[1] = EX2(SA_a[1]); \
        SBAR(); \
        SB_b = MFMA32(kf0, qb[0], ZERO16); \
        la += SA_a[0]; la += SA_a[1]; PA_a_lo[0] = pk2(SA_a[0], SA_a[1]); XPROBE(SA_a[0]); \
        SA_a[2] = EX2(SA_a[2]); SA_a[3] = EX2(SA_a[3]); \
        SBAR(); \
        kf3 = *(const LAS bf16x8*)(KCUR1 + 6144); \
        SB_a = MFMA32(kf1, qa[1], SB_a); \
        la += SA_a[2]; la += SA_a[3]; PA_a_lo[1] = pk2(SA_a[2], SA_a[3]); XPROBE(SA_a[2]); \
        SA_a[4] = EX2(SA_a[4]); SA_a[5] = EX2(SA_a[5]); \
        SBAR(); \
        SB_b = MFMA32(kf1, qb[1], SB_b); \
        la += SA_a[4]; la += SA_a[5]; PA_a_lo[2] = pk2(SA_a[4], SA_a[5]); XPROBE(SA_a[4]); \
        SA_a[6] = EX2(SA_a[6]); SA_a[7] = EX2(SA_a[7]); \
        SBAR(); \
        vf0 = *(const LAS bf16x8*)(VPREV1 + 0); \
        SB_a = MFMA32(kf2, qa[2], SB_a); \
        la += SA_a[6]; la += SA_a[7]; PA_a_lo[3] = pk2(SA_a[6], SA_a[7]); XPROBE(SA_a[6]); \
        SA_a[8] = EX2(SA_a[8]); SA_a[9] = EX2(SA_a[9]); \
        SBAR(); \
        vf1 = *(const LAS bf16x8*)(VPREV1 + 512); \
        SB_b = MFMA32(kf2, qb[2], SB_b); \
        la += SA_a[8]; la += SA_a[9]; PA_a_hi[0] = pk2(SA_a[8], SA_a[9]); XPROBE(SA_a[8]); \
        SA_a[10] = EX2(SA_a[10]); SA_a[11] = EX2(SA_a[11]); \
        SBAR(); \
        SB_a = MFMA32(kf3, qa[3], SB_a); \
        la += SA_a[10]; la += SA_a[11]; PA_a_hi[1] = pk2(SA_a[10], SA_a[11]); XPROBE(SA_a[10]); \
        SA_a[12] = EX2(SA_a[12]); SA_a[13] = EX2(SA_a[13]); \
        SBAR(); \
        SB_b = MFMA32(kf3, qb[3], SB_b); \
        la += SA_a[12]; la += SA_a[13]; PA_a_hi[2] = pk2(SA_a[12], SA_a[13]); XPROBE(SA_a[12]); \
        SA_a[14] = EX2(SA_a[14]); SA_a[15] = EX2(SA_a[15]); \
        SBAR(); \
        vf2 = *(const LAS bf16x8*)(VPREV1 + 2048); \
        oa0 = MFMA32(vf0, PB_a_lo, oa0); \
        la += SA_a[14]; la += SA_a[15]; PA_a_hi[3] = pk2(SA_a[14], SA_a[15]); XPROBE(SA_a[14]); \
        SA_b[0] = EX2(SA_b[0]); SA_b[1] = EX2(SA_b[1]); \
        SBAR(); \
        vf3 = *(const LAS bf16x8*)(VPREV1 + 2560); \
        oa1 = MFMA32(vf1, PB_a_lo, oa1); \
        lb += SA_b[0]; lb += SA_b[1]; PA_b_lo[0] = pk2(SA_b[0], SA_b[1]); XPROBE(SA_b[0]); \
        SA_b[2] = EX2(SA_b[2]); SA_b[3] = EX2(SA_b[3]); \
        SBAR(); \
        ob0 = MFMA32(vf0, PB_b_lo, ob0); \
        lb += SA_b[2]; lb += SA_b[3]; PA_b_lo[1] = pk2(SA_b[2], SA_b[3]); XPROBE(SA_b[2]); \
        SA_b[4] = EX2(SA_b[4]); SA_b[5] = EX2(SA_b[5]); \
        SBAR(); \
        ob1 = MFMA32(vf1, PB_b_lo, ob1); \
        lb += SA_b[4]; lb += SA_b[5]; PA_b_lo[2] = pk2(SA_b[4], SA_b[5]); XPROBE(SA_b[4]); \
        SA_b[6] = EX2(SA_b[6]); SA_b[7] = EX2(SA_b[7]); \
        SBAR(); \
        kf0 = *(const LAS bf16x8*)(KNEXT0 + 0); \
        oa0 = MFMA32(vf2, PB_a_hi, oa0); \
        lb += SA_b[6]; lb += SA_b[7]; PA_b_lo[3] = pk2(SA_b[6], SA_b[7]); XPROBE(SA_b[6]); \
        SA_b[8] = EX2(SA_b[8]); SA_b[9] = EX2(SA_b[9]); \
        SBAR(); \
        oa1 = MFMA32(vf3, PB_a_hi, oa1); \
        lb += SA_b[8]; lb += SA_b[9]; PA_b_hi[0] = pk2(SA_b[8], SA_b[9]); XPROBE(SA_b[8]); \
        SA_b[10] = EX2(SA_b[10]); SA_b[11] = EX2(SA_b[11]); \
        SBAR(); \
        kf1 = *(const LAS bf16x8*)(KNEXT0 + 2048); \
        ob0 = MFMA32(vf2, PB_b_hi, ob0); \
        lb += SA_b[10]; lb += SA_b[11]; PA_b_hi[1] = pk2(SA_b[10], SA_b[11]); XPROBE(SA_b[10]); \
        SA_b[12] = EX2(SA_b[12]); SA_b[13] = EX2(SA_b[13]); \
        SBAR(); \
        ob1 = MFMA32(vf3, PB_b_hi, ob1); \
        lb += SA_b[12]; lb += SA_b[13]; PA_b_hi[2] = pk2(SA_b[12], SA_b[13]); XPROBE(SA_b[12]); \
        SA_b[14] = EX2(SA_b[14]); SA_b[15] = EX2(SA_b[15]); \
        lb += SA_b[14]; lb += SA_b[15]; PA_b_hi[3] = pk2(SA_b[14], SA_b[15]); XPROBE(SA_b[14]); \
        SBAR(); \
        kf2 = *(const LAS bf16x8*)(KNEXT0 + 4096); \
        SA_a = MFMA32(kf0, qa[0], ZERO16); \
        SB_a[0] = EX2(SB_a[0]); SB_a[1] = EX2(SB_a[1]); \
        SBAR(); \
        SA_b = MFMA32(kf0, qb[0], ZERO16); \
        la += SB_a[0]; la += SB_a[1]; PB_a_lo[0] = pk2(SB_a[0], SB_a[1]); XPROBE(SB_a[0]); \
        SB_a[2] = EX2(SB_a[2]); SB_a[3] = EX2(SB_a[3]); \
        SBAR(); \
        kf3 = *(const LAS bf16x8*)(KNEXT0 + 6144); \
        SA_a = MFMA32(kf1, qa[1], SA_a); \
        la += SB_a[2]; la += SB_a[3]; PB_a_lo[1] = pk2(SB_a[2], SB_a[3]); XPROBE(SB_a[2]); \
        SB_a[4] = EX2(SB_a[4]); SB_a[5] = EX2(SB_a[5]); \
        SBAR(); \
        SA_b = MFMA32(kf1, qb[1], SA_b); \
        la += SB_a[4]; la += SB_a[5]; PB_a_lo[2] = pk2(SB_a[4], SB_a[5]); XPROBE(SB_a[4]); \
        SB_a[6] = EX2(SB_a[6]); SB_a[7] = EX2(SB_a[7]); \
        SBAR(); \
        vf0 = *(const LAS bf16x8*)(VCUR0 + 0); \
        SA_a = MFMA32(kf2, qa[2], SA_a); \
        la += SB_a[6]; la += SB_a[7]; PB_a_lo[3] = pk2(SB_a[6], SB_a[7]); XPROBE(SB_a[6]); \
        SB_a[8] = EX2(SB_a[8]); SB_a[9] = EX2(SB_a[9]); \
        SBAR(); \
        vf1 = *(const LAS bf16x8*)(VCUR0 + 512); \
        SA_b = MFMA32(kf2, qb[2], SA_b); \
        la += SB_a[8]; la += SB_a[9]; PB_a_hi[0] = pk2(SB_a[8], SB_a[9]); XPROBE(SB_a[8]); \
        SB_a[10] = EX2(SB_a[10]); SB_a[11] = EX2(SB_a[11]); \
        SBAR(); \
        SA_a = MFMA32(kf3, qa[3], SA_a); \
        la += SB_a[10]; la += SB_a[11]; PB_a_hi[1] = pk2(SB_a[10], SB_a[11]); XPROBE(SB_a[10]); \
        SB_a[12] = EX2(SB_a[12]); SB_a[13] = EX2(SB_a[13]); \
        SBAR(); \
        SA_b = MFMA32(kf3, qb[3], SA_b); \
        la += SB_a[12]; la += SB_a[13]; PB_a_hi[2] = pk2(SB_a[12], SB_a[13]); XPROBE(SB_a[12]); \
        SB_a[14] = EX2(SB_a[14]); SB_a[15] = EX2(SB_a[15]); \
        SBAR(); \
        vf2 = *(const LAS bf16x8*)(VCUR0 + 2048); \
        oa0 = MFMA32(vf0, PA_a_lo, oa0); \
        la += SB_a[14]; la += SB_a[15]; PB_a_hi[3] = pk2(SB_a[14], SB_a[15]); XPROBE(SB_a[14]); \
        SB_b[0] = EX2(SB_b[0]); SB_b[1] = EX2(SB_b[1]); \
        SBAR(); \
        vf3 = *(const LAS bf16x8*)(VCUR0 + 2560); \
        oa1 = MFMA32(vf1, PA_a_lo, oa1); \
        lb += SB_b[0]; lb += SB_b[1]; PB_b_lo[0] = pk2(SB_b[0], SB_b[1]); XPROBE(SB_b[0]); \
        SB_b[2] = EX2(SB_b[2]); SB_b[3] = EX2(SB_b[3]); \
        SBAR(); \
        ob0 = MFMA32(vf0, PA_b_lo, ob0); \
        lb += SB_b[2]; lb += SB_b[3]; PB_b_lo[1] = pk2(SB_b[2], SB_b[3]); XPROBE(SB_b[2]); \
        SB_b[4] = EX2(SB_b[4]); SB_b[5] = EX2(SB_b[5]); \
        SBAR(); \
        ob1 = MFMA32(vf1, PA_b_lo, ob1); \
        lb += SB_b[4]; lb += SB_b[5]; PB_b_lo[2] = pk2(SB_b[4], SB_b[5]); XPROBE(SB_b[4]); \
        SB_b[6] = EX2(SB_b[6]); SB_b[7] = EX2(SB_b[7]); \
        SBAR(); \
        kf0 = *(const LAS bf16x8*)(KNEXT1 + 0); \
        oa0 = MFMA32(vf2, PA_a_hi, oa0); \
        lb += SB_b[6]; lb += SB_b[7]; PB_b_lo[3] = pk2(SB_b[6], SB_b[7]); XPROBE(SB_b[6]); \
        SB_b[8] = EX2(SB_b[8]); SB_b[9] = EX2(SB_b[9]); \
        SBAR(); \
        oa1 = MFMA32(vf3, PA_a_hi, oa1); \
        lb += SB_b[8]; lb += SB_b[9]; PB_b_hi[0] = pk2(SB_b[8], SB_b[9]); XPROBE(SB_b[8]); \
        SB_b[10] = EX2(SB_b[10]); SB_b[11] = EX2(SB_b[11]); \
        SBAR(); \
        kf1 = *(const LAS bf16x8*)(KNEXT1 + 2048); \
        ob0 = MFMA32(vf2, PA_b_hi, ob0); \
        lb += SB_b[10]; lb += SB_b[11]; PB_b_hi[1] = pk2(SB_b[10], SB_b[11]); XPROBE(SB_b[10]); \
        SB_b[12] = EX2(SB_b[12]); SB_b[13] = EX2(SB_b[13]); \
        SBAR(); \
        ob1 = MFMA32(vf3, PA_b_hi, ob1); \
        lb += SB_b[12]; lb += SB_b[13]; PB_b_hi[2] = pk2(SB_b[12], SB_b[13]); XPROBE(SB_b[12]); \
        SB_b[14] = EX2(SB_b[14]); SB_b[15] = EX2(SB_b[15]); \
        lb += SB_b[14]; lb += SB_b[15]; PB_b_hi[3] = pk2(SB_b[14], SB_b[15]); XPROBE(SB_b[14]); \
        SBAR(); \
    } while (0)

#define ATT_MLA_PRE(KCUR1) do { \
        kf0 = *(const LAS bf16x8*)(KCUR1 + 0); \
        kf1 = *(const LAS bf16x8*)(KCUR1 + 2048); \
    } while (0)
#define ATT_MLA_ITER(KCUR1, KNEXT0, KNEXT1, VPREV1, VCUR0) do { \
        kf2 = *(const LAS bf16x8*)(KCUR1 + 4096); \
        SB_a = MFMA32(kf0, qa[0], ZERO16); \
        SA_a[0] = EX2(SA_a[0]); SA_a[1] = EX2(SA_a[1]); \
        SBAR(); \
        SB_b = MFMA32(kf0, qb[0], ZERO16); \
        la += SA_a[0]; la += SA_a[1]; PA_a_lo[0] = pk2(SA_a[0], SA_a[1]); XPROBE(SA_a[0]); \
        SA_a[2] = EX2(SA_a[2]); SA_a[3] = EX2(SA_a[3]); \
        SBAR(); \
        kf3 = *(const LAS bf16x8*)(KCUR1 + 6144); \
        SB_a = MFMA32(kf1, qa[1], SB_a); \
        la += SA_a[2]; la += SA_a[3]; PA_a_lo[1] = pk2(SA_a[2], SA_a[3]); XPROBE(SA_a[2]); \
        SA_a[4] = EX2(SA_a[4]); SA_a[5] = EX2(SA_a[5]); \
        SBAR(); \
        SB_b = MFMA32(kf1, qb[1], SB_b); \
        la += SA_a[4]; la += SA_a[5]; PA_a_lo[2] = pk2(SA_a[4], SA_a[5]); XPROBE(SA_a[4]); \
        SA_a[6] = EX2(SA_a[6]); SA_a[7] = EX2(SA_a[7]); \
        SBAR(); \
        kf0 = *(const LAS bf16x8*)(KCUR1 + 8192); \
        SB_a = MFMA32(kf2, qa[2], SB_a); \
        la += SA_a[6]; la += SA_a[7]; PA_a_lo[3] = pk2(SA_a[6], SA_a[7]); XPROBE(SA_a[6]); \
        SBAR(); \
        SB_b = MFMA32(kf2, qb[2], SB_b); \
        SA_a[8] = EX2(SA_a[8]); SA_a[9] = EX2(SA_a[9]); \
        SBAR(); \
        kf1 = *(const LAS bf16x8*)(KCUR1 + 10240); \
        SB_a = MFMA32(kf3, qa[3], SB_a); \
        la += SA_a[8]; la += SA_a[9]; PA_a_hi[0] = pk2(SA_a[8], SA_a[9]); XPROBE(SA_a[8]); \
        SA_a[10] = EX2(SA_a[10]); SA_a[11] = EX2(SA_a[11]); \
        SBAR(); \
        SB_b = MFMA32(kf3, qb[3], SB_b); \
        la += SA_a[10]; la += SA_a[11]; PA_a_hi[1] = pk2(SA_a[10], SA_a[11]); XPROBE(SA_a[10]); \
        SA_a[12] = EX2(SA_a[12]); SA_a[13] = EX2(SA_a[13]); \
        SBAR(); \
        vf0 = *(const LAS bf16x8*)(VPREV1 + 0); \
        SB_a = MFMA32(kf0, qa[4], SB_a); \
        la += SA_a[12]; la += SA_a[13]; PA_a_hi[2] = pk2(SA_a[12], SA_a[13]); XPROBE(SA_a[12]); \
        SA_a[14] = EX2(SA_a[14]); SA_a[15] = EX2(SA_a[15]); \
        SBAR(); \
        vf1 = *(const LAS bf16x8*)(VPREV1 + 512); \
        SB_b = MFMA32(kf0, qb[4], SB_b); \
        la += SA_a[14]; la += SA_a[15]; PA_a_hi[3] = pk2(SA_a[14], SA_a[15]); XPROBE(SA_a[14]); \
        SBAR(); \
        SB_a = MFMA32(kf1, qa[5], SB_a); \
        SA_b[0] = EX2(SA_b[0]); SA_b[1] = EX2(SA_b[1]); \
        SBAR(); \
        SB_b = MFMA32(kf1, qb[5], SB_b); \
        lb += SA_b[0]; lb += SA_b[1]; PA_b_lo[0] = pk2(SA_b[0], SA_b[1]); XPROBE(SA_b[0]); \
        SA_b[2] = EX2(SA_b[2]); SA_b[3] = EX2(SA_b[3]); \
        SBAR(); \
        vf2 = *(const LAS bf16x8*)(VPREV1 + 2048); \
        oa0 = MFMA32(vf0, PB_a_lo, oa0); \
        lb += SA_b[2]; lb += SA_b[3]; PA_b_lo[1] = pk2(SA_b[2], SA_b[3]); XPROBE(SA_b[2]); \
        SA_b[4] = EX2(SA_b[4]); SA_b[5] = EX2(SA_b[5]); \
        SBAR(); \
        vf3 = *(const LAS bf16x8*)(VPREV1 + 2560); \
        oa1 = MFMA32(vf1, PB_a_lo, oa1); \
        lb += SA_b[4]; lb += SA_b[5]; PA_b_lo[2] = pk2(SA_b[4], SA_b[5]); XPROBE(SA_b[4]); \
        SA_b[6] = EX2(SA_b[6]); SA_b[7] = EX2(SA_b[7]); \
        SBAR(); \
        ob0 = MFMA32(vf0, PB_b_lo, ob0); \
        lb += SA_b[6]; lb += SA_b[7]; PA_b_lo[3] = pk2(SA_b[6], SA_b[7]); XPROBE(SA_b[6]); \
        SBAR(); \
        ob1 = MFMA32(vf1, PB_b_lo, ob1); \
        SA_b[8] = EX2(SA_b[8]); SA_b[9] = EX2(SA_b[9]); \
        SBAR(); \
        kf0 = *(const LAS bf16x8*)(KNEXT0 + 0); \
        oa0 = MFMA32(vf2, PB_a_hi, oa0); \
        lb += SA_b[8]; lb += SA_b[9]; PA_b_hi[0] = pk2(SA_b[8], SA_b[9]); XPROBE(SA_b[8]); \
        SA_b[10] = EX2(SA_b[10]); SA_b[11] = EX2(SA_b[11]); \
        SBAR(); \
        oa1 = MFMA32(vf3, PB_a_hi, oa1); \
        lb += SA_b[10]; lb += SA_b[11]; PA_b_hi[1] = pk2(SA_b[10], SA_b[11]); XPROBE(SA_b[10]); \
        SA_b[12] = EX2(SA_b[12]); SA_b[13] = EX2(SA_b[13]); \
        SBAR(); \
        kf1 = *(const LAS bf16x8*)(KNEXT0 + 2048); \
        ob0 = MFMA32(vf2, PB_b_hi, ob0); \
        lb += SA_b[12]; lb += SA_b[13]; PA_b_hi[2] = pk2(SA_b[12], SA_b[13]); XPROBE(SA_b[12]); \
        SA_b[14] = EX2(SA_b[14]); SA_b[15] = EX2(SA_b[15]); \
        SBAR(); \
        ob1 = MFMA32(vf3, PB_b_hi, ob1); \
        lb += SA_b[14]; lb += SA_b[15]; PA_b_hi[3] = pk2(SA_b[14], SA_b[15]); XPROBE(SA_b[14]); \
        SBAR(); \
        kf2 = *(const LAS bf16x8*)(KNEXT0 + 4096); \
        SA_a = MFMA32(kf0, qa[0], ZERO16); \
        SB_a[0] = EX2(SB_a[0]); SB_a[1] = EX2(SB_a[1]); \
        SBAR(); \
        SA_b = MFMA32(kf0, qb[0], ZERO16); \
        la += SB_a[0]; la += SB_a[1]; PB_a_lo[0] = pk2(SB_a[0], SB_a[1]); XPROBE(SB_a[0]); \
        SB_a[2] = EX2(SB_a[2]); SB_a[3] = EX2(SB_a[3]); \
        SBAR(); \
        kf3 = *(const LAS bf16x8*)(KNEXT0 + 6144); \
        SA_a = MFMA32(kf1, qa[1], SA_a); \
        la += SB_a[2]; la += SB_a[3]; PB_a_lo[1] = pk2(SB_a[2], SB_a[3]); XPROBE(SB_a[2]); \
        SB_a[4] = EX2(SB_a[4]); SB_a[5] = EX2(SB_a[5]); \
        SBAR(); \
        SA_b = MFMA32(kf1, qb[1], SA_b); \
        la += SB_a[4]; la += SB_a[5]; PB_a_lo[2] = pk2(SB_a[4], SB_a[5]); XPROBE(SB_a[4]); \
        SB_a[6] = EX2(SB_a[6]); SB_a[7] = EX2(SB_a[7]); \
        SBAR(); \
        kf0 = *(const LAS bf16x8*)(KNEXT0 + 8192); \
        SA_a = MFMA32(kf2, qa[2], SA_a); \
        la += SB_a[6]; la += SB_a[7]; PB_a_lo[3] = pk2(SB_a[6], SB_a[7]); XPROBE(SB_a[6]); \
        SBAR(); \
        SA_b = MFMA32(kf2, qb[2], SA_b); \
        SB_a[8] = EX2(SB_a[8]); SB_a[9] = EX2(SB_a[9]); \
        SBAR(); \
        kf1 = *(const LAS bf16x8*)(KNEXT0 + 10240); \
        SA_a = MFMA32(kf3, qa[3], SA_a); \
        la += SB_a[8]; la += SB_a[9]; PB_a_hi[0] = pk2(SB_a[8], SB_a[9]); XPROBE(SB_a[8]); \
        SB_a[10] = EX2(SB_a[10]); SB_a[11] = EX2(SB_a[11]); \
        SBAR(); \
        SA_b = MFMA32(kf3, qb[3], SA_b); \
        la += SB_a[10]; la += SB_a[11]; PB_a_hi[1] = pk2(SB_a[10], SB_a[11]); XPROBE(SB_a[10]); \
        SB_a[12] = EX2(SB_a[12]); SB_a[13] = EX2(SB_a[13]); \
        SBAR(); \
        vf0 = *(const LAS bf16x8*)(VCUR0 + 0); \
        SA_a = MFMA32(kf0, qa[4], SA_a); \
        la += SB_a[12]; la += SB_a[13]; PB_a_hi[2] = pk2(SB_a[12], SB_a[13]); XPROBE(SB_a[12]); \
        SB_a[14] = EX2(SB_a[14]); SB_a[15] = EX2(SB_a[15]); \
        SBAR(); \
        vf1 = *(const LAS bf16x8*)(VCUR0 + 512); \
        SA_b = MFMA32(kf0, qb[4], SA_b); \
        la += SB_a[14]; la += SB_a[15]; PB_a_hi[3] = pk2(SB_a[14], SB_a[15]); XPROBE(SB_a[14]); \
        SBAR(); \
        SA_a = MFMA32(kf1, qa[5], SA_a); \
        SB_b[0] = EX2(SB_b[0]); SB_b[1] = EX2(SB_b[1]); \
        SBAR(); \
        SA_b = MFMA32(kf1, qb[5], SA_b); \
        lb += SB_b[0]; lb += SB_b[1]; PB_b_lo[0] = pk2(SB_b[0], SB_b[1]); XPROBE(SB_b[0]); \
        SB_b[2] = EX2(SB_b[2]); SB_b[3] = EX2(SB_b[3]); \
        SBAR(); \
        vf2 = *(const LAS bf16x8*)(VCUR0 + 2048); \
        oa0 = MFMA32(vf0, PA_a_lo, oa0); \
        lb += SB_b[2]; lb += SB_b[3]; PB_b_lo[1] = pk2(SB_b[2], SB_b[3]); XPROBE(SB_b[2]); \
        SB_b[4] = EX2(SB_b[4]); SB_b[5] = EX2(SB_b[5]); \
        SBAR(); \
        vf3 = *(const LAS bf16x8*)(VCUR0 + 2560); \
        oa1 = MFMA32(vf1, PA_a_lo, oa1); \
        lb += SB_b[4]; lb += SB_b[5]; PB_b_lo[2] = pk2(SB_b[4], SB_b[5]); XPROBE(SB_b[4]); \
        SB_b[6] = EX2(SB_b[6]); SB_b[7] = EX2(SB_b[7]); \
        SBAR(); \
        ob0 = MFMA32(vf0, PA_b_lo, ob0); \
        lb += SB_b[6]; lb += SB_b[7]; PB_b_lo[3] = pk2(SB_b[6], SB_b[7]); XPROBE(SB_b[6]); \
        SBAR(); \
        ob1 = MFMA32(vf1, PA_b_lo, ob1); \
        SB_b[8] = EX2(SB_b[8]); SB_b[9] = EX2(SB_b[9]); \
        SBAR(); \
        kf0 = *(const LAS bf16x8*)(KNEXT1 + 0); \
        oa0 = MFMA32(vf2, PA_a_hi, oa0); \
        lb += SB_b[8]; lb += SB_b[9]; PB_b_hi[0] = pk2(SB_b[8], SB_b[9]); XPROBE(SB_b[8]); \
        SB_b[10] = EX2(SB_b[10]); SB_b[11] = EX2(SB_b[11]); \
        SBAR(); \
        oa1 = MFMA32(vf3, PA_a_hi, oa1); \
        lb += SB_b[10]; lb += SB_b[11]; PB_b_hi[1] = pk2(SB_b[10], SB_b[11]); XPROBE(SB_b[10]); \
        SB_b[12] = EX2(SB_b[12]); SB_b[13] = EX2(SB_b[13]); \
        SBAR(); \
        kf1 = *(const LAS bf16x8*)(KNEXT1 + 2048); \
        ob0 = MFMA32(vf2, PA_b_hi, ob0); \
        lb += SB_b[12]; lb += SB_b[13]; PB_b_hi[2] = pk2(SB_b[12], SB_b[13]); XPROBE(SB_b[12]); \
        SB_b[14] = EX2(SB_b[14]); SB_b[15] = EX2(SB_b[15]); \
        SBAR(); \
        ob1 = MFMA32(vf3, PA_b_hi, ob1); \
        lb += SB_b[14]; lb += SB_b[15]; PB_b_hi[3] = pk2(SB_b[14], SB_b[15]); XPROBE(SB_b[14]); \
        SBAR(); \
    } while (0)

#define ATT_DIFF_PRE(KCUR1) do { \
        kf0 = *(const LAS bf16x8*)(KCUR1 + 0); \
        kf1 = *(const LAS bf16x8*)(KCUR1 + 4096); \
        kf2 = *(const LAS bf16x8*)(KCUR1 + 2048); \
        kf3 = *(const LAS bf16x8*)(KCUR1 + 6144); \
    } while (0)
#define ATT_DIFF_ITER(KCUR1, KNEXT0, KNEXT1, VPREV1, VCUR0) do { \
        vf0 = *(const LAS bf16x8*)(VPREV1 + 0); \
        SB_a = MFMA32(kf0, qa[0], ZERO16); \
        SA_a[0] = EX2(SA_a[0]); SA_a[1] = EX2(SA_a[1]); \
        SA_a[2] = EX2(SA_a[2]); SA_a[3] = EX2(SA_a[3]); \
        SBAR(); \
        vf1 = *(const LAS bf16x8*)(VPREV1 + 512); \
        SB_b = MFMA32(kf1, qb[0], ZERO16); \
        la += SA_a[0]; la += SA_a[1]; PA_a_lo[0] = pk2(SA_a[0], SA_a[1]); XPROBE(SA_a[0]); \
        la += SA_a[2]; la += SA_a[3]; PA_a_lo[1] = pk2(SA_a[2], SA_a[3]); XPROBE(SA_a[2]); \
        SA_a[4] = EX2(SA_a[4]); SA_a[5] = EX2(SA_a[5]); \
        SBAR(); \
        SB_a = MFMA32(kf2, qa[1], SB_a); \
        la += SA_a[4]; la += SA_a[5]; PA_a_lo[2] = pk2(SA_a[4], SA_a[5]); XPROBE(SA_a[4]); \
        SA_a[6] = EX2(SA_a[6]); SA_a[7] = EX2(SA_a[7]); \
        SBAR(); \
        SB_b = MFMA32(kf3, qb[1], SB_b); \
        la += SA_a[6]; la += SA_a[7]; PA_a_lo[3] = pk2(SA_a[6], SA_a[7]); XPROBE(SA_a[6]); \
        SA_a[8] = EX2(SA_a[8]); SA_a[9] = EX2(SA_a[9]); \
        SA_a[10] = EX2(SA_a[10]); SA_a[11] = EX2(SA_a[11]); \
        SBAR(); \
        vf2 = *(const LAS bf16x8*)(VPREV1 + 2048); \
        oa0 = MFMA32(vf0, PB_a_lo, oa0); \
        la += SA_a[8]; la += SA_a[9]; PA_a_hi[0] = pk2(SA_a[8], SA_a[9]); XPROBE(SA_a[8]); \
        la += SA_a[10]; la += SA_a[11]; PA_a_hi[1] = pk2(SA_a[10], SA_a[11]); XPROBE(SA_a[10]); \
        SA_a[12] = EX2(SA_a[12]); SA_a[13] = EX2(SA_a[13]); \
        SBAR(); \
        vf3 = *(const LAS bf16x8*)(VPREV1 + 2560); \
        oa1 = MFMA32(vf1, PB_a_lo, oa1); \
        la += SA_a[12]; la += SA_a[13]; PA_a_hi[2] = pk2(SA_a[12], SA_a[13]); XPROBE(SA_a[12]); \
        SA_a[14] = EX2(SA_a[14]); SA_a[15] = EX2(SA_a[15]); \
        SBAR(); \
        ob0 = MFMA32(vf0, PB_b_lo, ob0); \
        la += SA_a[14]; la += SA_a[15]; PA_a_hi[3] = pk2(SA_a[14], SA_a[15]); XPROBE(SA_a[14]); \
        SA_b[0] = EX2(SA_b[0]); SA_b[1] = EX2(SA_b[1]); \
        SA_b[2] = EX2(SA_b[2]); SA_b[3] = EX2(SA_b[3]); \
        SBAR(); \
        ob1 = MFMA32(vf1, PB_b_lo, ob1); \
        lb += SA_b[0]; lb += SA_b[1]; PA_b_lo[0] = pk2(SA_b[0], SA_b[1]); XPROBE(SA_b[0]); \
        lb += SA_b[2]; lb += SA_b[3]; PA_b_lo[1] = pk2(SA_b[2], SA_b[3]); XPROBE(SA_b[2]); \
        SA_b[4] = EX2(SA_b[4]); SA_b[5] = EX2(SA_b[5]); \
        SBAR(); \
        kf0 = *(const LAS bf16x8*)(KNEXT0 + 0); \
        oa0 = MFMA32(vf2, PB_a_hi, oa0); \
        lb += SA_b[4]; lb += SA_b[5]; PA_b_lo[2] = pk2(SA_b[4], SA_b[5]); XPROBE(SA_b[4]); \
        SA_b[6] = EX2(SA_b[6]); SA_b[7] = EX2(SA_b[7]); \
        SBAR(); \
        kf1 = *(const LAS bf16x8*)(KNEXT0 + 4096); \
        oa1 = MFMA32(vf3, PB_a_hi, oa1); \
        lb += SA_b[6]; lb += SA_b[7]; PA_b_lo[3] = pk2(SA_b[6], SA_b[7]); XPROBE(SA_b[6]); \
        SA_b[8] = EX2(SA_b[8]); SA_b[9] = EX2(SA_b[9]); \
        SA_b[10] = EX2(SA_b[10]); SA_b[11] = EX2(SA_b[11]); \
        SBAR(); \
        kf2 = *(const LAS bf16x8*)(KNEXT0 + 2048); \
        ob0 = MFMA32(vf2, PB_b_hi, ob0); \
        lb += SA_b[8]; lb += SA_b[9]; PA_b_hi[0] = pk2(SA_b[8], SA_b[9]); XPROBE(SA_b[8]); \
        lb += SA_b[10]; lb += SA_b[11]; PA_b_hi[1] = pk2(SA_b[10], SA_b[11]); XPROBE(SA_b[10]); \
        SA_b[12] = EX2(SA_b[12]); SA_b[13] = EX2(SA_b[13]); \
        SBAR(); \
        kf3 = *(const LAS bf16x8*)(KNEXT0 + 6144); \
        ob1 = MFMA32(vf3, PB_b_hi, ob1); \
        lb += SA_b[12]; lb += SA_b[13]; PA_b_hi[2] = pk2(SA_b[12], SA_b[13]); XPROBE(SA_b[12]); \
        SA_b[14] = EX2(SA_b[14]); SA_b[15] = EX2(SA_b[15]); \
        lb += SA_b[14]; lb += SA_b[15]; PA_b_hi[3] = pk2(SA_b[14], SA_b[15]); XPROBE(SA_b[14]); \
        SBAR(); \
        vf0 = *(const LAS bf16x8*)(VCUR0 + 0); \
        SA_a = MFMA32(kf0, qa[0], ZERO16); \
        SB_a[0] = EX2(SB_a[0]); SB_a[1] = EX2(SB_a[1]); \
        SB_a[2] = EX2(SB_a[2]); SB_a[3] = EX2(SB_a[3]); \
        SBAR(); \
        vf1 = *(const LAS bf16x8*)(VCUR0 + 512); \
        SA_b = MFMA32(kf1, qb[0], ZERO16); \
        la += SB_a[0]; la += SB_a[1]; PB_a_lo[0] = pk2(SB_a[0], SB_a[1]); XPROBE(SB_a[0]); \
        la += SB_a[2]; la += SB_a[3]; PB_a_lo[1] = pk2(SB_a[2], SB_a[3]); XPROBE(SB_a[2]); \
        SB_a[4] = EX2(SB_a[4]); SB_a[5] = EX2(SB_a[5]); \
        SBAR(); \
        SA_a = MFMA32(kf2, qa[1], SA_a); \
        la += SB_a[4]; la += SB_a[5]; PB_a_lo[2] = pk2(SB_a[4], SB_a[5]); XPROBE(SB_a[4]); \
        SB_a[6] = EX2(SB_a[6]); SB_a[7] = EX2(SB_a[7]); \
        SBAR(); \
        SA_b = MFMA32(kf3, qb[1], SA_b); \
        la += SB_a[6]; la += SB_a[7]; PB_a_lo[3] = pk2(SB_a[6], SB_a[7]); XPROBE(SB_a[6]); \
        SB_a[8] = EX2(SB_a[8]); SB_a[9] = EX2(SB_a[9]); \
        SB_a[10] = EX2(SB_a[10]); SB_a[11] = EX2(SB_a[11]); \
        SBAR(); \
        vf2 = *(const LAS bf16x8*)(VCUR0 + 2048); \
        oa0 = MFMA32(vf0, PA_a_lo, oa0); \
        la += SB_a[8]; la += SB_a[9]; PB_a_hi[0] = pk2(SB_a[8], SB_a[9]); XPROBE(SB_a[8]); \
        la += SB_a[10]; la += SB_a[11]; PB_a_hi[1] = pk2(SB_a[10], SB_a[11]); XPROBE(SB_a[10]); \
        SB_a[12] = EX2(SB_a[12]); SB_a[13] = EX2(SB_a[13]); \
        SBAR(); \
        vf3 = *(const LAS bf16x8*)(VCUR0 + 2560); \
        oa1 = MFMA32(vf1, PA_a_lo, oa1); \
        la += SB_a[12]; la += SB_a[13]; PB_a_hi[2] = pk2(SB_a[12], SB_a[13]); XPROBE(SB_a[12]); \
        SB_a[14] = EX2(SB_a[14]); SB_a[15] = EX2(SB_a[15]); \
        SBAR(); \
        ob0 = MFMA32(vf0, PA_b_lo, ob0); \
        la += SB_a[14]; la += SB_a[15]; PB_a_hi[3] = pk2(SB_a[14], SB_a[15]); XPROBE(SB_a[14]); \
        SB_b[0] = EX2(SB_b[0]); SB_b[1] = EX2(SB_b[1]); \
        SB_b[2] = EX2(SB_b[2]); SB_b[3] = EX2(SB_b[3]); \
        SBAR(); \
        ob1 = MFMA32(vf1, PA_b_lo, ob1); \
        lb += SB_b[0]; lb += SB_b[1]; PB_b_lo[0] = pk2(SB_b[0], SB_b[1]); XPROBE(SB_b[0]); \
        lb += SB_b[2]; lb += SB_b[3]; PB_b_lo[1] = pk2(SB_b[2], SB_b[3]); XPROBE(SB_b[2]); \
        SB_b[4] = EX2(SB_b[4]); SB_b[5] = EX2(SB_b[5]); \
        SBAR(); \
        kf0 = *(const LAS bf16x8*)(KNEXT1 + 0); \
        oa0 = MFMA32(vf2, PA_a_hi, oa0); \
        lb += SB_b[4]; lb += SB_b[5]; PB_b_lo[2] = pk2(SB_b[4], SB_b[5]); XPROBE(SB_b[4]); \
        SB_b[6] = EX2(SB_b[6]); SB_b[7] = EX2(SB_b[7]); \
        SBAR(); \
        kf1 = *(const LAS bf16x8*)(KNEXT1 + 4096); \
        oa1 = MFMA32(vf3, PA_a_hi, oa1); \
        lb += SB_b[6]; lb += SB_b[7]; PB_b_lo[3] = pk2(SB_b[6], SB_b[7]); XPROBE(SB_b[6]); \
        SB_b[8] = EX2(SB_b[8]); SB_b[9] = EX2(SB_b[9]); \
        SB_b[10] = EX2(SB_b[10]); SB_b[11] = EX2(SB_b[11]); \
        SBAR(); \
        kf2 = *(const LAS bf16x8*)(KNEXT1 + 2048); \
        ob0 = MFMA32(vf2, PA_b_hi, ob0); \
        lb += SB_b[8]; lb += SB_b[9]; PB_b_hi[0] = pk2(SB_b[8], SB_b[9]); XPROBE(SB_b[8]); \
        lb += SB_b[10]; lb += SB_b[11]; PB_b_hi[1] = pk2(SB_b[10], SB_b[11]); XPROBE(SB_b[10]); \
        SB_b[12] = EX2(SB_b[12]); SB_b[13] = EX2(SB_b[13]); \
        SBAR(); \
        kf3 = *(const LAS bf16x8*)(KNEXT1 + 6144); \
        ob1 = MFMA32(vf3, PA_b_hi, ob1); \
        lb += SB_b[12]; lb += SB_b[13]; PB_b_hi[2] = pk2(SB_b[12], SB_b[13]); XPROBE(SB_b[12]); \
        SB_b[14] = EX2(SB_b[14]); SB_b[15] = EX2(SB_b[15]); \
        lb += SB_b[14]; lb += SB_b[15]; PB_b_hi[3] = pk2(SB_b[14], SB_b[15]); XPROBE(SB_b[14]); \
        SBAR(); \
    } while (0)

template <int DK, bool DIFF>
__device__ __forceinline__ void attn_dense_unit(const bf16* Q, int qp, int wave_rows, int nrows, size_t q_off1, const bf16* Kt, const bf16* Vt, int ntiles, bf16* O, size_t o_off1,
                                                LAS unsigned char* lds, int tid_in, const float* lamp, const float* gsub) {
    int tid = tid_in; asm volatile("" : "+v"(tid));
    constexpr int KB = 128 * DK;
    constexpr int KPIECES = DK / 8;
    constexpr int BUF = KB + 8192;
    constexpr int NS = DIFF ? 2 : DK / 16;
    const int lane = tid & 63, r = lane & 31, hi = lane >> 5; const int wid = __builtin_amdgcn_readfirstlane(tid >> 6);
    const bool valid = wave_rows * wid < nrows;
    const size_t wrow = valid ? (size_t)(wave_rows * wid + r) : (size_t)r;
    const bf16* qrow = Q + wrow * qp;
    bf16x8 qa[NS], qb[NS];
#pragma unroll
    for (int s = 0; s < NS; ++s) { qa[s] = *(const bf16x8*)(qrow + 16 * s + 8 * hi); qb[s] = *(const bf16x8*)(qrow + (DIFF ? 32 : q_off1) + 16 * s + 8 * hi); }
    f32x16 oa0 = {}, oa1 = {}, ob0 = {}, ob1 = {}; float la = 0.f, lb = 0.f;
    const int koff = hi * 1024 + pi32(r) * 16, voff = hi * 1024 + r * 16;
#define ATT_STAGE(t, slot) do { \
        const char* kg = (const char*)Kt + (size_t)(t) * KB; const char* vg = (const char*)Vt + (size_t)(t) * 8192; \
        __builtin_amdgcn_global_load_lds((const unsigned*)(kg + wid * 1024 + lane * 16), (LAS unsigned*)(lds + (slot) * BUF + wid * 1024), 16, 0, 0); \
        if (KPIECES > 8 && wid < KPIECES - 8) __builtin_amdgcn_global_load_lds((const unsigned*)(kg + (wid + 8) * 1024 + lane * 16), (LAS unsigned*)(lds + (slot) * BUF + (wid + 8) * 1024), 16, 0, 0); \
        __builtin_amdgcn_global_load_lds((const unsigned*)(vg + wid * 1024 + lane * 16), (LAS unsigned*)(lds + (slot) * BUF + KB + wid * 1024), 16, 0, 0); } while (0)
    ATT_STAGE(0, 0); ATT_STAGE(1, 1);
    VM_WAIT(); __syncthreads();
    f32x16 SA_a = {}, SA_b = {}, SB_a, SB_b;
    u32x4 PA_a_lo_, PA_a_hi_, PA_b_lo_, PA_b_hi_, PB_a_lo_, PB_a_hi_, PB_b_lo_, PB_b_hi_;
    { unsigned z = 0u; asm volatile("" : "+v"(z)); PB_a_lo_ = (u32x4){z, z, z, z}; PB_a_hi_ = PB_a_lo_; PB_b_lo_ = PB_a_lo_; PB_b_hi_ = PB_a_lo_; }
    bf16x8 kf0, kf1, kf2, kf3, vf0, vf1, vf2, vf3;
#define PA_a_lo PA_a_lo_
#define PA_a_hi PA_a_hi_
#define PA_b_lo PA_b_lo_
#define PA_b_hi PA_b_hi_
#define PB_a_lo PB_a_lo_
#define PB_a_hi PB_a_hi_
#define PB_b_lo PB_b_lo_
#define PB_b_hi PB_b_hi_
#undef MFMA32
#define MFMA32(A, B, C) __builtin_amdgcn_mfma_f32_32x32x16_bf16(__builtin_bit_cast(bf16x8, (A)), __builtin_bit_cast(bf16x8, (B)), (C), 0, 0, 0)
    {
        const LAS unsigned char* kp_ = lds + koff;
#pragma unroll
        for (int st = 0; st < NS; ++st) {
            if constexpr (!DIFF) { const bf16x8 kf = *(const LAS bf16x8*)(kp_ + st * 2048); SA_a = MFMA32(kf, qa[st], SA_a); SA_b = MFMA32(kf, qb[st], SA_b); }
            else { const bf16x8 k1 = *(const LAS bf16x8*)(kp_ + st * 2048), k2 = *(const LAS bf16x8*)(kp_ + (st + 2) * 2048); SA_a = MFMA32(k1, qa[st], SA_a); SA_b = MFMA32(k2, qb[st], SA_b); } }
    }
    if constexpr (DIFF) { ATT_DIFF_PRE(lds + 512 + koff); } else if constexpr (DK == 96) { ATT_MLA_PRE(lds + 512 + koff); } else { ATT_GQA_PRE(lds + 512 + koff); }
    int sp = 0, s0 = 0, s1 = 1, s2 = 2;
#pragma unroll 1
    for (int t = 0; t < ntiles; ++t) {
        { const int tn = min(t + 2, ntiles - 1); ATT_STAGE(tn, s2); }
        const LAS unsigned char* kcur1 = lds + s0 * BUF + 512 + koff; const LAS unsigned char* knext0 = lds + s1 * BUF + koff; const LAS unsigned char* knext1 = knext0 + 512;
        const LAS unsigned char* vprev1 = lds + sp * BUF + KB + 4096 + voff; const LAS unsigned char* vcur0 = lds + s0 * BUF + KB + voff;
        if constexpr (DIFF) { ATT_DIFF_ITER(kcur1, knext0, knext1, vprev1, vcur0); }
        else if constexpr (DK == 96) { ATT_MLA_ITER(kcur1, knext0, knext1, vprev1, vcur0); }
        else { ATT_GQA_ITER(kcur1, knext0, knext1, vprev1, vcur0); }
        sp = s0; s0 = s1; s1 = s2; s2 = (s2 + 1) & 3;
        VM_WAIT(); __syncthreads();
    }
    {
        const LAS unsigned char* vp_ = lds + sp * BUF + KB + 4096 + voff;
        const bf16x8 v00 = *(const LAS bf16x8*)(vp_), v01 = *(const LAS bf16x8*)(vp_ + 512), v10 = *(const LAS bf16x8*)(vp_ + 2048), v11 = *(const LAS bf16x8*)(vp_ + 2560);
        oa0 = MFMA32(v00, PB_a_lo, oa0); oa1 = MFMA32(v01, PB_a_lo, oa1); ob0 = MFMA32(v00, PB_b_lo, ob0); ob1 = MFMA32(v01, PB_b_lo, ob1);
        oa0 = MFMA32(v10, PB_a_hi, oa0); oa1 = MFMA32(v11, PB_a_hi, oa1); ob0 = MFMA32(v10, PB_b_hi, ob0); ob1 = MFMA32(v11, PB_b_hi, ob1);
    }
#undef MFMA32
#define MFMA32(A, B, C) __builtin_amdgcn_mfma_f32_32x32x16_bf16((A), (B), (C), 0, 0, 0)
#undef PA_a_lo
#undef PA_a_hi
#undef PA_b_lo
#undef PA_b_hi
#undef PB_a_lo
#undef PB_a_hi
#undef PB_b_lo
#undef PB_b_hi
#undef ATT_STAGE
    int tid2 = tid_in; asm volatile("" : "+v"(tid2));
    const int lane2 = tid2 & 63, r2 = lane2 & 31, hi2 = lane2 >> 5; const int wid2 = __builtin_amdgcn_readfirstlane(tid2 >> 6);
    const bool valid2 = wave_rows * wid2 < nrows;
    bf16* orow = O + (valid2 ? (size_t)(wave_rows * wid2 + r2) : (size_t)r2) * D;
    la += shx(la, 32); lb += shx(lb, 32);
    if constexpr (!DIFF) {
        const float ia = __builtin_amdgcn_rcpf(la), ib = __builtin_amdgcn_rcpf(lb);
#pragma unroll
        for (int i = 0; i < 16; ++i) { oa0[i] *= ia; oa1[i] *= ia; ob0[i] *= ib; ob1[i] *= ib; }
        if (valid2) { store_ot(orow, oa0, oa1, hi2); store_ot(orow + o_off1, ob0, ob1, hi2); }
    } else {
        const float lam = lamp[0], lam_scale = lamp[1]; const float ia = __builtin_amdgcn_rcpf(la), ib = lam * __builtin_amdgcn_rcpf(lb); float ss = 0.f;
#pragma unroll
        for (int i = 0; i < 16; ++i) { oa0[i] = oa0[i] * ia - ob0[i] * ib; oa1[i] = oa1[i] * ia - ob1[i] * ib; ss += oa0[i] * oa0[i] + oa1[i] * oa1[i]; }
        ss += shx(ss, 32);
        const float rr = rsqrtf(ss * (1.f / 64.f) + EPS) * lam_scale;
#pragma unroll
        for (int i = 0; i < 16; ++i) { const int dv = 8 * (i >> 2) + 4 * hi2 + (i & 3); oa0[i] *= rr * gsub[dv]; oa1[i] *= rr * gsub[32 + dv]; }
        if (valid2) store_ot(orow, oa0, oa1, hi2);
    }
    __syncthreads();
}
__device__ __forceinline__ void attn_na_unit(const Args& a, int b, int h, int g, LAS unsigned char* lds, const LAS float* bias_l, int tid_in) {
    int tid = tid_in; asm volatile("" : "+v"(tid));
    const int lane = tid & 63, r = lane & 31, hi = lane >> 5; const int wid = __builtin_amdgcn_readfirstlane(tid >> 6);
    const int wr = wid >> 1, qb = wid & 1, gr = 4 * g + wr;
    const int m = b * SEQ + gr * 64 + 32 * qb + r;
    const bf16* qrow = (const bf16*)(a.ws + WS_QNA) + (size_t)m * 256 + 64 * h;
    bf16x8 qf[4];
#pragma unroll
    for (int s = 0; s < 4; ++s) qf[s] = *(const bf16x8*)(qrow + 16 * s + 8 * hi);
    const int c = 32 * qb + r, c0 = min(max(c - 8, 0), 48), r0 = min(max(gr - 4, 0), 248);
    const int lo = min(max(4 * g - 4, 0), 248), hiw = min(max(4 * g - 1, 0), 248) + 7, ntile = 4 + (hiw - lo + 1);
    const bf16* Kt = ktile_ptr(a.ws, WS_KNA, 4, 64, b, h, 0); const bf16* Vt = ktile_ptr(a.ws, WS_VNA, 4, 64, b, h, 0);
    f32x16 o0 = {}, o1 = {}; float l0 = 0.f;
    const int koff = hi * 1024 + pi32(r) * 16, voff = hi * 1024 + r * 16;
    int boff[2][16];
#pragma unroll
    for (int kb = 0; kb < 2; ++kb)
#pragma unroll
        for (int i = 0; i < 16; ++i) { const int kc = 32 * kb + 16 * (i >> 3) + 8 * hi + (i & 7); const bool ok = (kc >= c0) && (kc < c0 + 16);
            boff[kb][i] = 4 * (ok ? min(max(kc - c + 15, 0), 30) : 31); }
#define NA_STAGE(t, buf) do { const int kt_ = (t) < 4 ? (t) : 4 + lo + ((t) - 4); \
        const char* kg = (const char*)Kt + (size_t)kt_ * 8192; const char* vg = (const char*)Vt + (size_t)kt_ * 8192; \
        __builtin_amdgcn_global_load_lds((const unsigned*)(kg + wid * 1024 + lane * 16), (LAS unsigned*)(lds + (buf) * 16384 + wid * 1024), 16, 0, 0); \
        __builtin_amdgcn_global_load_lds((const unsigned*)(vg + wid * 1024 + lane * 16), (LAS unsigned*)(lds + (buf) * 16384 + 8192 + wid * 1024), 16, 0, 0); } while (0)
    NA_STAGE(0, 0); NA_STAGE(1, 1); NA_STAGE(2, 2);
#pragma unroll 1
    for (int t = 0; t < ntile; ++t) {
        if (t + 2 < ntile) asm volatile("s_waitcnt vmcnt(4)" ::: "memory"); else if (t + 1 < ntile) asm volatile("s_waitcnt vmcnt(2)" ::: "memory"); else VM_WAIT();
        __syncthreads();
        if (t + 3 < ntile) NA_STAGE(t + 3, (t + 3) & 3);
        const int wrow = lo + (t - 4);
        const bool win = t >= 4; const bool rel = !win || (wrow >= r0 && wrow < r0 + 8);
        if (rel) {
            const LAS unsigned char* kb_ = lds + (t & 3) * 16384; const LAS unsigned char* vb_ = kb_ + 8192;
            const LAS unsigned char* brow = (const LAS unsigned char*)bias_l + (win ? (wrow - gr + 7) * 128 : 0);
#pragma unroll
            for (int kb = 0; kb < 2; ++kb) {
                f32x16 s = {};
#pragma unroll
                for (int st = 0; st < 4; ++st) { const bf16x8 kf = *(const LAS bf16x8*)(kb_ + st * 2048 + kb * 512 + koff); s = MFMA32(kf, qf[st], s); }
                const bool dead0 = win && kb == 0 && qb == 1, dead1 = win && kb == 1 && qb == 0;
                if (win) {
#pragma unroll
                    for (int hf = 0; hf < 2; ++hf) {
                        if (hf == 0 ? dead0 : dead1) {
#pragma unroll
                            for (int i = 8 * hf; i < 8 * hf + 8; ++i) s[i] = 0.f;
                        } else {
#pragma unroll
                            for (int i = 8 * hf; i < 8 * hf + 8; ++i) { const float bias = *(const LAS float*)(brow + boff[kb][i]); s[i] = __builtin_amdgcn_exp2f(s[i] + bias); l0 += s[i]; }
                        }
                    }
                } else {
#pragma unroll
                    for (int i = 0; i < 16; ++i) { s[i] = __builtin_amdgcn_exp2f(s[i]); l0 += s[i]; }
                }
                const bf16x8 p0 = pack8(s, 0), p1 = pack8(s, 8);
                const bf16x8 v00 = *(const LAS bf16x8*)(vb_ + (4 * kb + 0) * 1024 + voff), v01 = *(const LAS bf16x8*)(vb_ + (4 * kb + 0) * 1024 + 512 + voff);
                const bf16x8 v10 = *(const LAS bf16x8*)(vb_ + (4 * kb + 2) * 1024 + voff), v11 = *(const LAS bf16x8*)(vb_ + (4 * kb + 2) * 1024 + 512 + voff);
                if (!dead0) { o0 = MFMA32(v00, p0, o0); o1 = MFMA32(v01, p0, o1); }
                if (!dead1) { o0 = MFMA32(v10, p1, o0); o1 = MFMA32(v11, p1, o1); }
            }
        }
    }
#undef NA_STAGE
    l0 += shx(l0, 32);
    const float i0 = __builtin_amdgcn_rcpf(l0);
#pragma unroll
    for (int i = 0; i < 16; ++i) { o0[i] *= i0; o1[i] *= i0; }
    store_ot((bf16*)(a.ws + WS_O) + (size_t)m * D + 64 * h, o0, o1, hi);
    __syncthreads();
}
__device__ __forceinline__ void attn_phase(const Args& a, int l, LAS unsigned char* lds, int tid, int vcu, int G) {
    unsigned char* ws = a.ws; bf16* O = (bf16*)(ws + WS_O);
    const float* lamp = (const float*)(ws + WS_LAM) + 2 * l; const float* gsub = a.in[I_GDSUB] + l * 64;
    const bool ctxq = (l == 0);
#define CTX_LOOP(c, coff, n) for (int c = (((vcu - (coff)) % G) + G) % G; c < (ctxq ? (n) : 0); c += G)
    for (int u = vcu; u < 256; u += G) { const int bh = u >> 5, b = bh >> 2, h = bh & 3; const size_t m0 = (size_t)b * SEQ + 512 * (u & 31);
        attn_dense_unit<96, false>((const bf16*)(ws + WS_QMLA) + m0 * 384 + 96 * h, 384, 64, 512, (size_t)32 * 384, ktile_ptr(ws, WS_KMLA, 4, 96, b, h, 0), ktile_ptr(ws, WS_VMLA, 4, 64, b, h, 0), NTILE,
                                   O + m0 * D + 256 + 64 * h, (size_t)32 * D, lds, tid, lamp, gsub); }
    CTX_LOOP(c, 0, 8) { const int b = c >> 2, h = c & 3; const size_t m0 = (size_t)NLAT + b * CTXL;
        attn_dense_unit<96, false>((const bf16*)(ws + WS_QMLA) + m0 * 384 + 96 * h, 384, 64, 256, (size_t)32 * 384, ktile_ptr(ws, WS_KMLA, 4, 96, b, h, 0), ktile_ptr(ws, WS_VMLA, 4, 64, b, h, 0), 4,
                                   O + m0 * D + 256 + 64 * h, (size_t)32 * D, lds, tid, lamp, gsub); }
    for (int u = vcu; u < 512; u += G) { const int bh = (u & 255) >> 5, qt = (u & 31) + 32 * (u >> 8), b = bh >> 2, h = bh & 3; const size_t m0 = (size_t)b * SEQ + 256 * qt;
        attn_dense_unit<64, true>((const bf16*)(ws + WS_QDIFF) + m0 * 256 + 64 * h, 256, 32, 256, 0, ktile_ptr(ws, WS_KDIFF, 4, 64, b, h, 0), ktile_ptr(ws, WS_VDIFF, 4, 64, b, h, 0), NTILE,
                                  O + m0 * D + 512 + 64 * h, 0, lds, tid, lamp, gsub); }
    CTX_LOOP(c, 8, 8) { const int b = c >> 2, h = c & 3; const size_t m0 = (size_t)NLAT + b * CTXL;
        attn_dense_unit<64, true>((const bf16*)(ws + WS_QDIFF) + m0 * 256 + 64 * h, 256, 32, 256, 0, ktile_ptr(ws, WS_KDIFF, 4, 64, b, h, 0), ktile_ptr(ws, WS_VDIFF, 4, 64, b, h, 0), 4,
                                  O + m0 * D + 512 + 64 * h, 0, lds, tid, lamp, gsub); }
    for (int u = vcu; u < 256; u += G) { const int bk = u >> 6, b = bk >> 1, kh = bk & 1; const size_t m0 = (size_t)b * SEQ + 256 * (u & 63);
        attn_dense_unit<64, false>((const bf16*)(ws + WS_QGQA) + m0 * 256 + 128 * kh, 256, 32, 256, 64, ktile_ptr(ws, WS_KGQA, 2, 64, b, kh, 0), ktile_ptr(ws, WS_VGQA, 2, 64, b, kh, 0), NTILE,
                                   O + m0 * D + 768 + 128 * kh, 64, lds, tid, lamp, gsub); }
    CTX_LOOP(c, 16, 4) { const int b = c >> 1, kh = c & 1; const size_t m0 = (size_t)NLAT + b * CTXL;
        attn_dense_unit<64, false>((const bf16*)(ws + WS_QGQA) + m0 * 256 + 128 * kh, 256, 32, 256, 64, ktile_ptr(ws, WS_KGQA, 2, 64, b, kh, 0), ktile_ptr(ws, WS_VGQA, 2, 64, b, kh, 0), 4,
                                   O + m0 * D + 768 + 128 * kh, 64, lds, tid, lamp, gsub); }
    { LAS float* bl = (LAS float*)(lds + 65536); const float* rpb = a.in[I_RPB] + (size_t)l * 4 * 465;
      for (int i = tid; i < 4 * 480; i += 512) { const int h = i / 480, rem = i % 480, dy = rem >> 5, dx = rem & 31; bl[i] = dx < 31 ? rpb[h * 465 + dy * 31 + dx] * LOG2E : -3.0e38f; }
      __syncthreads();
      for (int u = vcu; u < 512; u += G) { const int bh = u >> 6, b = bh >> 2, h = bh & 3; attn_na_unit(a, b, h, u & 63, lds, bl + h * 480, tid); } }
    CTX_LOOP(c, 24, 8) { const int b = c >> 2, h = c & 3; const size_t m0 = (size_t)NLAT + b * CTXL;
        attn_dense_unit<64, false>((const bf16*)(ws + WS_QNA) + m0 * 256 + 64 * h, 256, 64, 256, (size_t)32 * 256, ktile_ptr(ws, WS_KNA, 4, 64, b, h, 0), ktile_ptr(ws, WS_VNA, 4, 64, b, h, 0), 4,
                                   O + m0 * D + 64 * h, (size_t)32 * D, lds, tid, lamp, gsub); }
#undef CTX_LOOP
}

__device__ __forceinline__ void up2_phase(const Args& a, int l, int lane_in, int wave, int vcu, int G) {
    const int gw = vcu * 8 + wave, NGW = G * 8;
    const bf16* P = (const bf16*)(a.ws + WS_P); const bf16* W2 = w_2(a, l);
    for (int it = gw; it < NTT * NJ2; it += NGW) {
        int lane = lane_in; asm volatile("" : "+v"(lane));
        const int r = lane & 31, hi = lane >> 5, pr = pi32(r);
        const int T = it / NJ2, j = it % NJ2; const TokTile tt = tok_tile(T);
        if (j < 4) {
            const bf16* wrow0 = W2 + (size_t)(4 * j) * 24 * 512 + (hi * 32 + pr) * 8;
            const bf16* wrow2 = W2 + (size_t)(4 * j + 2) * 24 * 512 + (hi * 32 + r) * 8;
            const bf16* arow = P + (((size_t)T * (NP / 8) + 96 + hi) * 64 + r) * 8;
            f32x16 acc[3][2];
#pragma unroll
            for (int nb = 0; nb < 3; ++nb) { acc[nb][0] = (f32x16){}; acc[nb][1] = (f32x16){}; }
#pragma unroll 1
            for (int kg = 0; kg < 4; ++kg) {
                bf16x8 wf[4][3], af[4][2];
#pragma unroll
                for (int st = 0; st < 4; ++st) wf[st][0] = *(const bf16x8*)(wrow0 + (4 * kg + st) * 512);
#pragma unroll
                for (int st = 0; st < 4; ++st) wf[st][1] = *(const bf16x8*)(wrow0 + 24 * 512 + (4 * kg + st) * 512);
#pragma unroll
                for (int st = 0; st < 4; ++st) wf[st][2] = *(const bf16x8*)(wrow2 + (4 * kg + st) * 512);
#pragma unroll
                for (int st = 0; st < 4; ++st) af[st][0] = *(const bf16x8*)(arow + (4 * kg + st) * 1024);
#pragma unroll
                for (int st = 0; st < 4; ++st) af[st][1] = *(const bf16x8*)(arow + 256 + (4 * kg + st) * 1024);
                __builtin_amdgcn_sched_barrier(0);
#pragma unroll
                for (int st = 0; st < 4; ++st)
#pragma unroll
                    for (int nb = 0; nb < 3; ++nb) { acc[nb][0] = MFMA32(wf[st][nb], af[st][0], acc[nb][0]); acc[nb][1] = MFMA32(wf[st][nb], af[st][1], acc[nb][1]); }
            }
            const float* g = a.in[I_GMQ] + l * 96;
            f32x4 gv[12];
#pragma unroll
            for (int nb = 0; nb < 2; ++nb)
#pragma unroll
                for (int run = 0; run < 2; ++run) { const float* gp = g + 32 * nb + 16 * run + 8 * hi; gv[4 * nb + 2 * run] = *(const f32x4*)gp; gv[4 * nb + 2 * run + 1] = *(const f32x4*)(gp + 4); }
#pragma unroll
            for (int aa = 0; aa < 4; ++aa) gv[8 + aa] = *(const f32x4*)(g + 64 + 8 * aa + 4 * hi);
            __builtin_amdgcn_sched_barrier(0);
#pragma unroll
            for (int tb = 0; tb < 2; ++tb) {
                float ss = 0.f;
#pragma unroll
                for (int nb = 0; nb < 3; ++nb)
#pragma unroll
                    for (int i = 0; i < 16; ++i) ss += acc[nb][tb][i] * acc[nb][tb][i];
                ss += shx(ss, 32);
                const float rr = rsqrtf(ss * (1.f / 96.f) + EPS);
                bf16* dst = (bf16*)(a.ws + WS_QMLA) + (size_t)(tt.m0 + 32 * tb + r) * 384 + 96 * j;
#pragma unroll
                for (int nb = 0; nb < 2; ++nb)
#pragma unroll
                    for (int run = 0; run < 2; ++run) { const f32x4 g0 = gv[4 * nb + 2 * run], g1 = gv[4 * nb + 2 * run + 1]; const int b = 8 * run; const float sc = rr * C2_96;
                        u32x4 w; w.x = pk2(acc[nb][tb][b] * sc * g0.x, acc[nb][tb][b + 1] * sc * g0.y); w.y = pk2(acc[nb][tb][b + 2] * sc * g0.z, acc[nb][tb][b + 3] * sc * g0.w);
                        w.z = pk2(acc[nb][tb][b + 4] * sc * g1.x, acc[nb][tb][b + 5] * sc * g1.y); w.w = pk2(acc[nb][tb][b + 6] * sc * g1.z, acc[nb][tb][b + 7] * sc * g1.w);
                        *(u32x4*)(dst + 32 * nb + 16 * run + 8 * hi) = w; }
                float v[16];
#pragma unroll
                for (int aa = 0; aa < 4; ++aa) { v[4 * aa] = acc[2][tb][4 * aa] * rr * gv[8 + aa].x; v[4 * aa + 1] = acc[2][tb][4 * aa + 1] * rr * gv[8 + aa].y; v[4 * aa + 2] = acc[2][tb][4 * aa + 2] * rr * gv[8 + aa].z; v[4 * aa + 3] = acc[2][tb][4 * aa + 3] * rr * gv[8 + aa].w; }
                if (tt.lat) { const float tr = (float)tt.prow, tc = (float)(32 * tb + r);
#pragma unroll
                    for (int b = 0; b < 4; ++b) { const float inv = hi ? ROPE_INVR[2 * (4 + b)] : ROPE_INVR[2 * b];
                        { const float t = __builtin_amdgcn_fractf(tr * inv); const float c = __builtin_amdgcn_cosf(t), s = __builtin_amdgcn_sinf(t); const float x1 = v[b], x2 = v[4 + b]; v[b] = x1 * c - x2 * s; v[4 + b] = x1 * s + x2 * c; }
                        { const float t = __builtin_amdgcn_fractf(tc * inv); const float c = __builtin_amdgcn_cosf(t), s = __builtin_amdgcn_sinf(t); const float x1 = v[8 + b], x2 = v[12 + b]; v[8 + b] = x1 * c - x2 * s; v[12 + b] = x1 * s + x2 * c; } } }
#pragma unroll
                for (int aa = 0; aa < 4; ++aa) { u32x2 w; w.x = pk2(v[4 * aa] * C2_96, v[4 * aa + 1] * C2_96); w.y = pk2(v[4 * aa + 2] * C2_96, v[4 * aa + 3] * C2_96); *(u32x2*)(dst + 64 + 8 * aa + 4 * hi) = w; }
            }
        } else if (j < 8) {
            const int h = j - 4;
            const bf16* wrow = W2 + ((size_t)(16 + 4 * h) * 24 + 16) * 512 + (hi * 32 + pr) * 8;
            const bf16* arow = P + (((size_t)T * (NP / 8) + 128 + hi) * 64 + r) * 8;
            f32x16 acc[2][2];
#pragma unroll
            for (int nb = 0; nb < 2; ++nb) { acc[nb][0] = (f32x16){}; acc[nb][1] = (f32x16){}; }
#pragma unroll 1
            for (int kg = 0; kg < 2; ++kg) {
                bf16x8 wf[4][2], af[4][2];
#pragma unroll
                for (int st = 0; st < 4; ++st) wf[st][0] = *(const bf16x8*)(wrow + (4 * kg + st) * 512);
#pragma unroll
                for (int st = 0; st < 4; ++st) wf[st][1] = *(const bf16x8*)(wrow + 24 * 512 + (4 * kg + st) * 512);
#pragma unroll
                for (int st = 0; st < 4; ++st) af[st][0] = *(const bf16x8*)(arow + (4 * kg + st) * 1024);
#pragma unroll
                for (int st = 0; st < 4; ++st) af[st][1] = *(const bf16x8*)(arow + 256 + (4 * kg + st) * 1024);
                __builtin_amdgcn_sched_barrier(0);
#pragma unroll
                for (int st = 0; st < 4; ++st)
#pragma unroll
                    for (int nb = 0; nb < 2; ++nb) { acc[nb][0] = MFMA32(wf[st][nb], af[st][0], acc[nb][0]); acc[nb][1] = MFMA32(wf[st][nb], af[st][1], acc[nb][1]); }
            }
            const float* g = a.in[I_GKN] + l * 64;
            f32x4 gv[8];
#pragma unroll
            for (int nb = 0; nb < 2; ++nb)
#pragma unroll
                for (int run = 0; run < 2; ++run) { const float* gp = g + 32 * nb + 16 * run + 8 * hi; gv[4 * nb + 2 * run] = *(const f32x4*)gp; gv[4 * nb + 2 * run + 1] = *(const f32x4*)(gp + 4); }
            __builtin_amdgcn_sched_barrier(0);
            bf16* kt = ktile_ptr(a.ws, WS_KMLA, 4, 96, tt.b, h, tt.ktile);
#pragma unroll
            for (int tb = 0; tb < 2; ++tb) {
                float ss = 0.f;
#pragma unroll
                for (int nb = 0; nb < 2; ++nb)
#pragma unroll
                    for (int i = 0; i < 16; ++i) ss += acc[nb][tb][i] * acc[nb][tb][i];
                ss += shx(ss, 32);
                const float rr = rsqrtf(ss * (1.f / 64.f) + EPS);
#pragma unroll
                for (int nb = 0; nb < 2; ++nb)
#pragma unroll
                    for (int run = 0; run < 2; ++run) { const f32x4 g0 = gv[4 * nb + 2 * run], g1 = gv[4 * nb + 2 * run + 1]; const int b = 8 * run;
                        u32x4 w; w.x = pk2(acc[nb][tb][b] * rr * g0.x, acc[nb][tb][b + 1] * rr * g0.y); w.y = pk2(acc[nb][tb][b + 2] * rr * g0.z, acc[nb][tb][b + 3] * rr * g0.w);
                        w.z = pk2(acc[nb][tb][b + 4] * rr * g1.x, acc[nb][tb][b + 5] * rr * g1.y); w.w = pk2(acc[nb][tb][b + 6] * rr * g1.z, acc[nb][tb][b + 7] * rr * g1.w);
                        *(u32x4*)(kt + (size_t)(4 * nb + 2 * run + hi) * 512 + (32 * tb + r) * 8) = w; }
            }
        } else {
            const int h = j - 8;
            const bf16* wrow = W2 + ((size_t)(16 + 4 * h + 2) * 24 + 16) * 512 + (hi * 32 + r) * 8;
            const bf16* arow = P + (((size_t)T * (NP / 8) + 128 + hi) * 64 + pr) * 8;
            float ssv[2] = {0.f, 0.f};
            f32x16 acc[2][2];
#pragma unroll
            for (int tb = 0; tb < 2; ++tb) { acc[tb][0] = (f32x16){}; acc[tb][1] = (f32x16){}; }
#pragma unroll 1
            for (int kg = 0; kg < 2; ++kg) {
                bf16x8 wf[4][2], af[4][2];
#pragma unroll
                for (int st = 0; st < 4; ++st) wf[st][0] = *(const bf16x8*)(wrow + (4 * kg + st) * 512);
#pragma unroll
                for (int st = 0; st < 4; ++st) wf[st][1] = *(const bf16x8*)(wrow + 24 * 512 + (4 * kg + st) * 512);
#pragma unroll
                for (int st = 0; st < 4; ++st) af[st][0] = *(const bf16x8*)(arow + (4 * kg + st) * 1024);
#pragma unroll
                for (int st = 0; st < 4; ++st) af[st][1] = *(const bf16x8*)(arow + 256 + (4 * kg + st) * 1024);
                __builtin_amdgcn_sched_barrier(0);
#pragma unroll
                for (int st = 0; st < 4; ++st)
#pragma unroll
                    for (int tb = 0; tb < 2; ++tb) { acc[tb][0] = MFMA32(af[st][tb], wf[st][0], acc[tb][0]); acc[tb][1] = MFMA32(af[st][tb], wf[st][1], acc[tb][1]);
                        const u32x4 w = __builtin_bit_cast(u32x4, af[st][tb]);
                        const float a0 = __uint_as_float(w.x << 16), a1 = __uint_as_float(w.x & 0xffff0000u), a2 = __uint_as_float(w.y << 16), a3 = __uint_as_float(w.y & 0xffff0000u),
                                    a4 = __uint_as_float(w.z << 16), a5 = __uint_as_float(w.z & 0xffff0000u), a6 = __uint_as_float(w.w << 16), a7 = __uint_as_float(w.w & 0xffff0000u);
                        ssv[tb] += ((a0 * a0 + a1 * a1) + (a2 * a2 + a3 * a3)) + ((a4 * a4 + a5 * a5) + (a6 * a6 + a7 * a7)); }
            }
#pragma unroll
            for (int tb = 0; tb < 2; ++tb) { ssv[tb] += shx(ssv[tb], 32); const float rs = rsqrtf(ssv[tb] * (1.f / 128.f) + EPS);
#pragma unroll
                for (int i = 0; i < 16; ++i) { const float f = shl(rs, 8 * (i >> 2) + 4 * hi + (i & 3)); acc[tb][0][i] *= f; acc[tb][1][i] *= f; } }
            bf16* vt = ktile_ptr(a.ws, WS_VMLA, 4, 64, tt.b, h, tt.ktile);
#pragma unroll
            for (int tb = 0; tb < 2; ++tb)
#pragma unroll
                for (int nb = 0; nb < 2; ++nb)
#pragma unroll
                    for (int run = 0; run < 2; ++run) { const int b = 8 * run;
                        u32x4 w; w.x = pk2(acc[tb][nb][b], acc[tb][nb][b + 1]); w.y = pk2(acc[tb][nb][b + 2], acc[tb][nb][b + 3]); w.z = pk2(acc[tb][nb][b + 4], acc[tb][nb][b + 5]); w.w = pk2(acc[tb][nb][b + 6], acc[tb][nb][b + 7]);
                        *(u32x4*)(vt + (size_t)(4 * tb + 2 * run + hi) * 512 + (32 * nb + r) * 8) = w; }
        }
    }
}

using pg8::Unit; using pg8::BM; using pg8::HALF;
struct EpiRes {
    static constexpr bool PERM = false, AFTER_DRAIN = false;
    const float* xlat; const float* xctx; float* out; const float* mod;
    __device__ __forceinline__ void operator()(const f32x4 (&acc)[2][2][4][2], const Unit& u, int wr, int wc, int fr, int fq) const {
        const int row0 = u.pm * BM + wr * 64 + fr, col0 = u.pn * BM + wc * 32 + 4 * fq;
        const int set = u.pm < 64 ? 0 : (u.pm < 128 ? 1 : 2);
        const float* base = u.pm < 128 ? xlat : xctx - (size_t)NLAT * D;
        const float* g1 = mod + set * 6144 + 2048 + col0;
        f32x4 gv[2][2];
#pragma unroll
        for (int bj = 0; bj < 2; ++bj)
#pragma unroll
            for (int n = 0; n < 2; ++n) gv[bj][n] = *(const f32x4*)(g1 + bj * HALF + n * 16);
#pragma unroll
        for (int ai = 0; ai < 2; ++ai) {
            f32x4 bv[4][2][2];
#pragma unroll
            for (int m = 0; m < 4; ++m) { const size_t ro = (size_t)(row0 + ai * HALF + m * 16) * D + col0;
#pragma unroll
                for (int bj = 0; bj < 2; ++bj)
#pragma unroll
                    for (int n = 0; n < 2; ++n) bv[m][bj][n] = *(const f32x4*)(base + ro + bj * HALF + n * 16); }
            __builtin_amdgcn_sched_barrier(0);
#pragma unroll
            for (int m = 0; m < 4; ++m) { const size_t ro = (size_t)(row0 + ai * HALF + m * 16) * D + col0;
#pragma unroll
                for (int bj = 0; bj < 2; ++bj)
#pragma unroll
                    for (int n = 0; n < 2; ++n) *(f32x4*)(out + ro + bj * HALF + n * 16) = bv[m][bj][n] + gv[bj][n] * acc[ai][bj][m][n]; }
        }
    }
};
struct EpiPTile {
    static constexpr bool PERM = true, AFTER_DRAIN = false;
    bf16* P;
    __device__ __forceinline__ void operator()(const f32x4 (&acc)[2][2][4][2], const Unit& u, int wr, int wc, int fr, int fq) const {
        const int row0 = u.pm * BM + wr * 64 + fr, col0 = u.pn * BM + wc * 32 + 8 * fq;
#pragma unroll
        for (int ai = 0; ai < 2; ++ai)
#pragma unroll
            for (int m = 0; m < 4; ++m) { const int row = row0 + ai * HALF + m * 16; bf16* tp = P + ((size_t)(row >> 6) * (NP / 8) * 64 + (row & 63)) * 8;
#pragma unroll
                for (int bj = 0; bj < 2; ++bj) { const f32x4 v0 = acc[ai][bj][m][0], v1 = acc[ai][bj][m][1];
                    u32x4 w; w.x = pk2(v0[0], v0[1]); w.y = pk2(v0[2], v0[3]); w.z = pk2(v1[0], v1[1]); w.w = pk2(v1[2], v1[3]);
                    *(u32x4*)(tp + (size_t)((col0 + bj * HALF) >> 3) * 512) = w; } }
    }
};
struct ExpertOrder {
    pg8::StaticOrder base; int ntn, pm_off, gap;
    __device__ __forceinline__ void init(int nrows, int N, int G, int c, int pm_off_ = 0, int gap_ = 0) { base.init(nrows, N, G, c); ntn = N / BM; pm_off = pm_off_; gap = gap_; }
    __device__ __forceinline__ bool next(int i, Unit& u) const { if (!base.next(i, u)) return false; u.pm += pm_off; const int e = u.pm < 256 ? ((u.pm >> 3) & 15) : (u.pm - 256); u.pn += e * ntn + (e >= GU_SPLIT_E ? gap : 0); return true; }
    __device__ __forceinline__ void a_ready(const Unit&) const {}
    __device__ __forceinline__ void done(const Unit&) const {}
};
struct ExpertGatherOrder : ExpertOrder {
    const int* srcrow;
    __device__ __forceinline__ int aoff(const Unit& u, int r) const { return srcrow[u.pm * BM + r]; }
};
}
namespace pg8 { template <> constexpr bool sched_gather_v<mk::ExpertGatherOrder> = true; }
namespace mk {
struct EpiSwiglu {
    static constexpr bool PERM = true, AFTER_DRAIN = false;
    bf16* act; bool half;
    __device__ __forceinline__ void operator()(const f32x4 (&acc)[2][2][4][2], const Unit& u, int wr, int wc, int fr, int fq) const {
        const int pnl = u.pn % 22; const int row0 = u.pm * BM + wr * 64 + fr, col0 = pnl * 128 + wc * 32 + 8 * fq;
#pragma unroll
        for (int ai = 0; ai < 2; ++ai) if (!(half && ai == 1))
#pragma unroll
            for (int m = 0; m < 4; ++m) { float r[8];
#pragma unroll
                for (int n = 0; n < 2; ++n)
#pragma unroll
                    for (int c = 0; c < 4; ++c) { const float g = acc[ai][0][m][n][c], up = acc[ai][1][m][n][c]; r[4 * n + c] = g * __builtin_amdgcn_rcpf(1.f + __builtin_amdgcn_exp2f(-g * LOG2E)) * up; }
                u32x4 w; w.x = pk2(r[0], r[1]); w.y = pk2(r[2], r[3]); w.z = pk2(r[4], r[5]); w.w = pk2(r[6], r[7]);
                { const int row = row0 + ai * HALF + m * 16;
                  *(u32x4*)(act + ((size_t)(row >> 5) * (DFF / 64) + (col0 >> 6)) * 2048 + (row & 31) * 64 + (col0 & 63)) = w; } }
    }
};
struct EpiDown {
    static constexpr bool PERM = true, AFTER_DRAIN = false;
    bf16* y; const float* gatev; bool half;
    __device__ __forceinline__ void operator()(const f32x4 (&acc)[2][2][4][2], const Unit& u, int wr, int wc, int fr, int fq) const {
        const int pnl = u.pn & 3; const int row0 = u.pm * BM + wr * 64 + fr, col0 = pnl * BM + wc * 32 + 8 * fq;
        float gtv[2][4];
#pragma unroll
        for (int ai = 0; ai < 2; ++ai)
#pragma unroll
            for (int m = 0; m < 4; ++m) gtv[ai][m] = gatev[row0 + ai * HALF + m * 16];
        __builtin_amdgcn_sched_barrier(0);
#pragma unroll
        for (int ai = 0; ai < 2; ++ai) if (!(half && ai == 1))
#pragma unroll
            for (int m = 0; m < 4; ++m) { const int row = row0 + ai * HALF + m * 16; const float gt = gtv[ai][m];
#pragma unroll
                for (int bj = 0; bj < 2; ++bj) { const f32x4 v0 = acc[ai][bj][m][0] * gt, v1 = acc[ai][bj][m][1] * gt;
                    u32x4 w; w.x = pk2(v0[0], v0[1]); w.y = pk2(v0[2], v0[3]); w.z = pk2(v1[0], v1[1]); w.w = pk2(v1[2], v1[3]);
                    *(u32x4*)(y + (size_t)row * D + col0 + bj * HALF) = w; } }
    }
};

__device__ __forceinline__ void router_phase(const Args& a, int l, LAS unsigned char* lds, int tid, int lane, int wave, int vcu, int G) {
    LAS float* Wl = (LAS float*)lds;
    LAS float* A1l = Wl + 16384;
    LAS float* biasl = A1l + 3072;
    LAS float* SHl = biasl + 64;
    const float* wr = a.in[I_WROUTER] + (size_t)l * 1024 * 16; const float* gff = a.in[I_GFFN] + l * D;
    const float* MODL = (const float*)(a.ws + WS_MOD) + (size_t)l * 3 * 6144;
    { float wv[32];
#pragma unroll
      for (int i = 0; i < 32; ++i) wv[i] = wr[tid + 512 * i];
      float ag[6], am[6], as_[6];
#pragma unroll
      for (int i = 0; i < 6; ++i) { const int idx = tid + 512 * i, set = idx >> 10, c = idx & 1023; ag[i] = gff[c]; am[i] = MODL[set * 6144 + 4096 + c]; as_[i] = MODL[set * 6144 + 3072 + c]; }
      __builtin_amdgcn_sched_barrier(0);
#pragma unroll
      for (int i = 0; i < 32; ++i) { const int idx = tid + 512 * i, c = idx >> 4, e = idx & 15; Wl[(((c >> 4) * 4 + ((c >> 2) & 3)) * 16 + e) * 4 + (c & 3)] = wv[i]; }
#pragma unroll
      for (int i = 0; i < 6; ++i) { const int idx = tid + 512 * i; A1l[idx] = ag[i] * (1.f + am[i]); SHl[idx] = as_[i]; } }
    __syncthreads();
    if (tid < 384) { const int se = tid >> 3, part = tid & 7, set = se >> 4, e = se & 15; float sacc = 0.f;
        for (int c = part * 128; c < part * 128 + 128; ++c) sacc += SHl[set * 1024 + c] * Wl[(((c >> 4) * 4 + ((c >> 2) & 3)) * 16 + e) * 4 + (c & 3)];
        sacc += shx(sacc, 1); sacc += shx(sacc, 2); sacc += shx(sacc, 4);
        if (part == 0) biasl[se] = sacc; }
    __syncthreads();
    const int ntile = ((l == 0) ? NROW : NLAT) / 16, nround = (ntile + 2 * G - 1) / (2 * G);
    const float* X1 = (const float*)(a.ws + WS_X1); bf16* H2 = (bf16*)(a.ws + WS_H2); float* AFF = (float*)(a.ws + WS_AFF);
    const int r = lane & 15, kq = lane >> 4, grp = wave >> 2, q = wave & 3;
    LAS float* PART = SHl + 3072;
    LAS float* SSP = PART + 2 * 2 * 4 * 256;
    const LAS float* wp = Wl + lane * 4 + 256 * 16 * q;
    f32x4 xa[16], xb[16];
#define RT_LOADT(dst, tI_) do { const float* xr_ = X1 + (size_t)((tI_) * 16 + r) * D + 256 * q + 4 * kq; _Pragma("unroll") for (int jj = 0; jj < 16; ++jj) dst[jj] = *(const f32x4*)(xr_ + 16 * jj); __builtin_amdgcn_sched_barrier(0); } while (0)
    int tI = vcu * 2 + grp;
    if (!PV(1)) {
    if (tI < ntile) RT_LOADT(xa, tI);
#pragma unroll 1
    for (int i = 0; i < nround; ++i) {
        const int par = i & 1; const bool act = tI < ntile; const int tN = ((i + 1) * G + vcu) * 2 + grp;
        if (i + 1 < nround && tN < ntile) RT_LOADT(xb, tN);
        const int m0 = tI * 16; const int set = act ? mset_of_row(m0) : 0;
        const LAS float* a1p = A1l + set * 1024 + 256 * q + 4 * kq;
        if (act) {
            f32x4 acc = {0.f, 0.f, 0.f, 0.f}; float ss = 0.f;
#pragma unroll
            for (int jj = 0; jj < 16; ++jj) { const f32x4 xv = xa[jj]; const f32x4 av = *(const LAS f32x4*)(a1p + 16 * jj); const f32x4 wv = *(const LAS f32x4*)(wp + 256 * jj);
                ss += (xv.x * xv.x + xv.y * xv.y) + (xv.z * xv.z + xv.w * xv.w);
                const f32x4 t = xv * av; xa[jj] = t;
                acc = __builtin_amdgcn_mfma_f32_16x16x4f32(t.x, wv.x, acc, 0, 0, 0); acc = __builtin_amdgcn_mfma_f32_16x16x4f32(t.y, wv.y, acc, 0, 0, 0);
                acc = __builtin_amdgcn_mfma_f32_16x16x4f32(t.z, wv.z, acc, 0, 0, 0); acc = __builtin_amdgcn_mfma_f32_16x16x4f32(t.w, wv.w, acc, 0, 0, 0); }
            ss += shx(ss, 16); ss += shx(ss, 32);
            *(LAS f32x4*)(PART + (((par * 2 + grp) * 4 + q) * 64 + lane) * 4) = acc;
            if (kq == 0) SSP[((par * 2 + grp) * 4 + q) * 16 + r] = ss;
        }
        __syncthreads();
        if (act) {
            const LAS float* sp = SSP + (par * 2 + grp) * 64 + r;
            const float rstd = rsqrtf(((sp[0] + sp[16]) + (sp[32] + sp[48])) * (1.f / D) + EPS);
            if (q == 0) {
                const LAS float* pp = PART + ((par * 2 + grp) * 4 * 64 + lane) * 4;
                const f32x4 acc = (*(const LAS f32x4*)(pp) + *(const LAS f32x4*)(pp + 256)) + (*(const LAS f32x4*)(pp + 512) + *(const LAS f32x4*)(pp + 768));
                const float be = biasl[set * 16 + r]; float lg[4], mx[4], se[4];
#pragma unroll
                for (int g = 0; g < 4; ++g) { lg[g] = acc[g] * shl(rstd, 4 * kq + g) + be; mx[g] = lg[g]; }
#pragma unroll
                for (int o = 1; o < 16; o <<= 1)
#pragma unroll
                    for (int g = 0; g < 4; ++g) mx[g] = fmaxf(mx[g], shx(mx[g], o));
#pragma unroll
                for (int g = 0; g < 4; ++g) { lg[g] = expf(lg[g] - mx[g]); se[g] = lg[g]; }
#pragma unroll
                for (int o = 1; o < 16; o <<= 1)
#pragma unroll
                    for (int g = 0; g < 4; ++g) se[g] += shx(se[g], o);
                f32x4 af; af.x = lg[0] / se[0]; af.y = lg[1] / se[1]; af.z = lg[2] / se[2]; af.w = lg[3] / se[3];
                size_t off;
                if (m0 < NLAT) off = ((size_t)((m0 >> 14) * 16 + r)) * SEQ + (m0 & (SEQ - 1)) + 4 * kq;
                else { const int c = m0 - NLAT; off = (size_t)2 * 16 * SEQ + ((size_t)((c >> 8) * 16 + r)) * CTXL + (c & 255) + 4 * kq; }
                *(f32x4*)(AFF + off) = af;
            }
            if (!PV(0)) {
            const LAS float* shp = SHl + set * 1024 + 256 * q + 4 * kq; bf16* hp = H2 + (size_t)(m0 + r) * D + 256 * q + 4 * kq;
#pragma unroll
            for (int jj = 0; jj < 16; ++jj) { const f32x4 h = xa[jj] * rstd + *(const LAS f32x4*)(shp + 16 * jj);
                u32x2 o; o.x = pk2(h.x, h.y); o.y = pk2(h.z, h.w); *(u32x2*)(hp + 16 * jj) = o; }
            }
        }
#pragma unroll
        for (int jj = 0; jj < 16; ++jj) xa[jj] = xb[jj];
        tI = tN;
    }
    }
#undef RT_LOADT
    __syncthreads();
}

__device__ __forceinline__ void topk_phase(const Args& a, int l, LAS unsigned char* lds, int tid, int lane, int wave, int bid, int G) {
    LAS unsigned* red = (LAS unsigned*)lds;
    LAS unsigned* cg = red + 64;
    LAS unsigned* ce = cg + 256;
    const int ngroups = (l == 0) ? 64 : 32;
    const float* AFF = (const float*)(a.ws + WS_AFF); int* SEL = (int*)(a.ws + WS_SEL); int* SRCROW = (int*)(a.ws + WS_SRCROW); float* GATEV = (float*)(a.ws + WS_GATEV);
    for (int g = bid; g < ngroups; g += G) {
        const int set4 = g >> 4, e = g & 15; const int n = set4 < 2 ? SEQ : CTXL, cap = n >> 3;
        const float* af = set4 < 2 ? AFF + (size_t)(set4 * 16 + e) * SEQ : AFF + (size_t)2 * 16 * SEQ + (size_t)((set4 - 2) * 16 + e) * CTXL;
        const int tokbase = set4 < 2 ? set4 * SEQ : NLAT + (set4 - 2) * CTXL; const int rowbase = xe_rowbase(set4, e);
        unsigned v[32];
#pragma unroll
        for (int j = 0; j < 32; ++j) { const int idx = tid + 512 * j; v[j] = idx < n ? __float_as_uint(af[idx]) : 0u; }
        unsigned T = 0u;
        for (int sft = 30; sft >= 0; sft -= 2) {
            const unsigned c1v = T | (1u << sft), c2v = T | (2u << sft), c3v = T | (3u << sft); unsigned c12 = 0, c3 = 0;
#pragma unroll
            for (int j = 0; j < 32; ++j) { c12 += (v[j] >= c1v ? 1u : 0u) + (v[j] >= c2v ? 0x10000u : 0u); c3 += (v[j] >= c3v) ? 1u : 0u; }
#pragma unroll
            for (int o = 1; o < 64; o <<= 1) { c12 += (unsigned)shx_i((int)c12, o); c3 += (unsigned)shx_i((int)c3, o); }
            LAS unsigned* rb = red + ((sft >> 1) & 1) * 16;
            if (lane == 0) { rb[wave] = c12; rb[8 + wave] = c3; }
            __syncthreads();
            unsigned t12 = 0, t3 = 0;
#pragma unroll
            for (int w = 0; w < 8; ++w) { t12 += rb[w]; t3 += rb[8 + w]; }
            const unsigned n1 = t12 & 0xffffu, n2 = t12 >> 16;
            if (t3 >= (unsigned)cap) T = c3v; else if (n2 >= (unsigned)cap) T = c2v; else if (n1 >= (unsigned)cap) T = c1v;
        }
#pragma unroll
        for (int j = 0; j < 32; ++j) { const unsigned long long mgj = __ballot(v[j] > T), mej = __ballot(v[j] == T && (tid + 512 * j) < n);
            if (lane == 0) { cg[j * 8 + wave] = (unsigned)__popcll(mgj); ce[j * 8 + wave] = (unsigned)__popcll(mej); } }
        __syncthreads();
        if (tid == 0) { unsigned sg = 0, se = 0; for (int i = 0; i < 256; ++i) { const unsigned x = cg[i], y = ce[i]; cg[i] = sg; ce[i] = se; sg += x; se += y; } red[32] = sg; }
        __syncthreads();
        const unsigned ngt = red[32]; const unsigned need_eq = (unsigned)cap - ngt;
        const unsigned long long lt = (lane == 0) ? 0ull : (~0ull >> (64 - lane));
#pragma unroll
        for (int j = 0; j < 32; ++j) { const int idx = tid + 512 * j;
            const unsigned long long mgj = __ballot(v[j] > T), mej = __ballot(v[j] == T && idx < n);
            if (idx < n) {
                const unsigned gb = cg[j * 8 + wave] + (unsigned)__popcll(mgj & lt), eb = ce[j * 8 + wave] + (unsigned)__popcll(mej & lt);
                const bool isg = v[j] > T, ise = v[j] == T; const bool selc = isg || (ise && eb < need_eq);
                const unsigned slot = gb + (eb < need_eq ? eb : need_eq);
                if (selc) { SRCROW[rowbase + slot] = tokbase + idx; GATEV[rowbase + slot] = __uint_as_float(v[j]); }
                SEL[(size_t)(tokbase + idx) * 16 + e] = selc ? (int)slot : -1;
            } }
        if (set4 == 2 && tid >= 64 && tid < 256) { SRCROW[XE_LAT + e * 256 + tid] = NLAT; GATEV[XE_LAT + e * 256 + tid] = 0.f; }
        __syncthreads();
    }
}


constexpr int NPH_LAYER = 11;
constexpr int NPHASES = 1 + 2 * NPH_LAYER + 1;
constexpr bool PER_PHASE_LAUNCH = (MK_N_LAUNCHES != 1);
#ifndef MK_PHASE_MASK
#define MK_PHASE_MASK 0xffffu
#endif
#define EN(k) (((MK_PHASE_MASK) >> (k)) & 1u)

#ifndef MK_CVS
#define MK_CVS 0, 0, 4000, 4000, 4000, 66400, 66400
#endif
__device__ __forceinline__ constexpr int CVS_AT(int s) { constexpr int t[7] = {MK_CVS}; return s <= 0 ? 0 : (s >= 8 ? CV_ALL : t[s - 1]); }
typedef const __attribute__((address_space(4))) Args* KArgPtr;
__device__ __forceinline__ Args load_args(KArgPtr p) { Args a;
#pragma unroll
    for (int i = 0; i < 30; ++i) a.in[i] = p->in[i];
    a.out = p->out; a.ws = p->ws; a.ph_lo = p->ph_lo; a.ph_hi = p->ph_hi; a.li = p->li;
#if defined(MK_PROBE_KIND) && MK_PROBE_KIND >= 0
    a.pad = p->pad;
#else
    a.pad = 0;
#endif
    return a; }
__global__ void __launch_bounds__(512, 2) mk_fwd(Args args) {
    extern __shared__ __attribute__((aligned(16))) unsigned char lds_raw[];
    LAS unsigned char* lds = (LAS unsigned char*)lds_raw;
    const int wave0 = __builtin_amdgcn_readfirstlane((int)threadIdx.x >> 6);
#define MK_TID() (wave0 * 64 + lane_now())
#define LAUNDER() KArgPtr ap_ = kap; asm volatile("" : "+s"(ap_)); const Args A = load_args(ap_); unsigned char* ws = A.ws; (void)ws; int tid = MK_TID(); const int lane = tid & 63, wave = __builtin_amdgcn_readfirstlane(tid >> 6); (void)lane; (void)wave
    const int G = gridDim.x, bid = blockIdx.x; const int vcu = (G % 8 == 0) ? (bid % 8) * (G / 8) + bid / 8 : bid;
    volatile LAS unsigned* MISC = (volatile LAS unsigned*)(lds + MISC_OFF);
    for (int u = MK_TID(); u < (LDS_BYTES - RING_BYTES) / 4; u += 512) ((LAS unsigned*)(lds + RING_BYTES))[u] = 0u;
    __syncthreads();
    KArgPtr kap = (KArgPtr)__builtin_amdgcn_kernarg_segment_ptr();
    unsigned* ctl = (unsigned*)(args.ws + WS_CTL);
    unsigned* barw = ctl + CW_BAR + args.li * XCD_BAR_WORDS;
    XcdBarrier bar; bar.bar = barw; bar.x = 0; bar.st = nullptr;
    if (!PER_PHASE_LAUNCH) bar = xcd_barrier_post(barw, MISC + 8, MK_TID() == 0);
    const int lo = args.ph_lo, hi = args.ph_hi;
#define IN(k) (lo <= (k) && (k) < hi)
#define SEAM(k) do { if (IN(k) && IN((k) + 1)) { if (PER_PHASE_LAUNCH) { if (MK_TID() == 0) __hip_atomic_store(ctl + CW_TMO, 0xBADBA0u, __ATOMIC_RELAXED, __HIP_MEMORY_SCOPE_AGENT); } else { xcd_barrier(bar, MK_TID() == 0); } } } while (0)

#define PH(kind, id, ...) do { if constexpr (EN(kind)) { if (IN(id)) { __VA_ARGS__ } } } while (0)
#define TAIL_CONV(busy_, s_) do { const int busy__ = (busy_) % G; if (bid >= busy__ && CVS_AT(s_) < CVS_AT((s_) + 1)) { __syncthreads(); conv_items(A, 1, CVS_AT(s_), CVS_AT((s_) + 1), lds, lane, wave, (bid - busy__) * 8 + wave, (G - busy__) * 8); } } while (0)
    PH(0, 0, LAUNDER(); pro_phase(A, lds, tid, bid, G); conv_items(A, 0, 0, CV_ALL, lds + 16384, lane, wave, vcu * 8 + wave, G * 8););
    SEAM(0);
#pragma unroll 1
    for (int l = 0; l < 2; ++l) {
        const int pb = 1 + NPH_LAYER * l;
        const int nrow_attn = (l == 0) ? NROW : NLAT;
        PH(1, pb + 0, LAUNDER(); modul_phase(A, l, lane, wave, vcu, G); if (l == 1) { TAIL_CONV(0, 5); });
        SEAM(pb + 0);
        PH(2, pb + 1, LAUNDER(); pg8::Gemm g{(const bf16*)(ws + WS_H), w_in(A, l), NROW, NP, D}; pg8::StaticOrder S; S.init(NROW, NP, G, bid);
            EpiPTile E{(bf16*)(ws + WS_P)};
            pg8::gemm_phase<EpiPTile, pg8::StaticOrder, true, true, false, true>(lds, g, S, E, tid);
            if (l == 0) { TAIL_CONV((NROW / 256) * (NP / 256), 0); } else { TAIL_CONV((NROW / 256) * (NP / 256), 6); });
        SEAM(pb + 1);
        PH(3, pb + 2, LAUNDER(); prep1_phase(A, l, lds, lane, wave, vcu, G););
        SEAM(pb + 2);
        PH(5, pb + 4, LAUNDER(); up2_phase(A, l, lane, wave, vcu, G););
        SEAM(pb + 4);
        PH(6, pb + 5, LAUNDER(); attn_phase(A, l, lds, tid, vcu, G););
        SEAM(pb + 5);
        PH(7, pb + 6, LAUNDER(); pg8::Gemm g{(const bf16*)(ws + WS_O), w_out(A, l), nrow_attn, D, D}; pg8::StaticOrder S; S.init(nrow_attn, D, G, bid);
            EpiRes E{l == 0 ? A.in[I_X] : (const float*)x2_of(A), l == 0 ? A.in[I_CTX] : (const float*)x2_of(A) + (size_t)NLAT * D, (float*)(ws + WS_X1), (const float*)(ws + WS_MOD) + (size_t)l * 3 * 6144};
            pg8::gemm_phase<EpiRes, pg8::StaticOrder, true, true, false, true>(lds, g, S, E, tid);
            if (l == 0) { TAIL_CONV((NROW / 256) * (D / 256), 1); });
        SEAM(pb + 6);
        PH(8, pb + 7, LAUNDER(); router_phase(A, l, lds, tid, lane, wave, vcu, G););
        SEAM(pb + 7);
        PH(9, pb + 8, LAUNDER(); topk_phase(A, l, lds, tid, lane, wave, bid, G); if (l == 0) { TAIL_CONV(64, 2); } else { TAIL_CONV(32, 7); });
        SEAM(pb + 8);
        PH(11, pb + 9, LAUNDER(); pg8::Gemm g{(const bf16*)(ws + WS_H2), w_gu(A, l), XE_LAT, 5632, D}; const int gap = l == 0 ? 0 : GU_GAP_TILES; EpiSwiglu E{(bf16*)(ws + WS_ACT), false}; EpiSwiglu Eh{(bf16*)(ws + WS_ACT), true};
            { ExpertGatherOrder S; S.init(XE_LAT, 5632, G, bid, 0, gap); S.srcrow = (const int*)(ws + WS_SRCROW);
              pg8::gemm_phase<EpiSwiglu, ExpertGatherOrder, true, true, false, true>(lds, g, S, E, tid); }
            if (l == 0) { __syncthreads(); ExpertGatherOrder S; S.init(XE_ALL - XE_LAT, 5632, G, bid, 256); S.srcrow = (const int*)(ws + WS_SRCROW);
              pg8::gemm_phase<EpiSwiglu, ExpertGatherOrder, true, true, true, true>(lds, g, S, Eh, tid);
              TAIL_CONV(((XE_ALL - XE_LAT) / 256) * 22, 3); });
        SEAM(pb + 9);
        PH(12, pb + 10, LAUNDER(); pg8::Gemm g{(const bf16*)(ws + WS_ACT), w_d(A, l), XE_LAT, D, DFF}; EpiDown E{(bf16*)(ws + WS_Y), (const float*)(ws + WS_GATEV), false}; EpiDown Eh{(bf16*)(ws + WS_Y), (const float*)(ws + WS_GATEV), true};
            { ExpertOrder S; S.init(XE_LAT, D, G, bid);
              pg8::gemm_phase<EpiDown, ExpertOrder, true, true, false, true, true>(lds, g, S, E, tid); }
            if (l == 0) { __syncthreads(); ExpertOrder S; S.init(XE_ALL - XE_LAT, D, G, bid, 256);
              pg8::gemm_phase<EpiDown, ExpertOrder, true, true, true, true, true>(lds, g, S, Eh, tid);
              TAIL_CONV(((XE_ALL - XE_LAT) / 256) * 4, 4); });
        SEAM(pb + 10);
    }
    PH(13, NPHASES - 1, LAUNDER(); final_phase(A, lane, wave, vcu, G););
#undef IN
#undef SEAM
}
}

extern "C" void kernel_launch(void* const* d_in, const int* in_sizes, int n_in, void* d_out, int out_size, void* d_ws, size_t ws_size, hipStream_t stream) {
    using namespace mk;
    static int grid = 0;
    if (grid == 0) {
        if (n_in != 30 || out_size != NLAT * D || ws_size < WS_NEED) { fprintf(stderr, "kernel_launch: unexpected shapes: n_in %d out %d ws %zu (need %zu)\n", n_in, out_size, ws_size, (size_t)WS_NEED); grid = -1; return; }
        int dev = 0, cus = 0, per_cu = 0;
        if (hipGetDevice(&dev) != hipSuccess || hipDeviceGetAttribute(&cus, hipDeviceAttributeMultiprocessorCount, dev) != hipSuccess) { grid = -1; return; }
        if (hipFuncSetAttribute((const void*)mk_fwd, hipFuncAttributeMaxDynamicSharedMemorySize, LDS_BYTES) != hipSuccess) { fprintf(stderr, "kernel_launch: hipFuncSetAttribute failed\n"); grid = -1; return; }
        if (hipOccupancyMaxActiveBlocksPerMultiprocessor(&per_cu, (const void*)mk_fwd, 512, LDS_BYTES) != hipSuccess || per_cu < 1) fprintf(stderr, "kernel_launch: occupancy query reports %d\n", per_cu);
        (void)hipGetLastError();
        grid = cus;
    }
    if (grid < 0) return;
    if (hipMemsetAsync((char*)d_ws + WS_CTL, 0, CTL_ZERO_BYTES, stream) != hipSuccess) return;
    Args a{};
    for (int i = 0; i < 30; ++i) a.in[i] = (const float*)d_in[i];
    a.out = (float*)d_out; a.ws = (unsigned char*)d_ws;
    if (PER_PHASE_LAUNCH) {
        for (int p = 0; p < NPHASES; ++p) { a.ph_lo = p; a.ph_hi = p + 1; a.li = 0; hipLaunchKernelGGL(mk_fwd, dim3(grid), dim3(512), LDS_BYTES, stream, a); }
    } else {
#if defined(MK_PROBE_KIND) && MK_PROBE_KIND >= 0
        int cuts[16]; int nc = 0; cuts[nc++] = 0;
        const int k0 = (MK_PROBE_KIND == 0) ? 0 : MK_PROBE_KIND, k1 = (MK_PROBE_KIND == 0 || MK_PROBE_KIND == 13) ? -1 : MK_PROBE_KIND + NPH_LAYER;
        const int kk0 = (MK_PROBE_KIND == 13) ? NPHASES - 1 : k0;
        int li = 0;
        auto launch = [&](int lo, int hi) { a.ph_lo = lo; a.ph_hi = hi; a.li = li++; a.pad = (hi == lo + 1 && li > 1) ? MK_PROBE_VAR : 0; hipLaunchKernelGGL(mk_fwd, dim3(grid), dim3(512), LDS_BYTES, stream, a); };
        launch(0, kk0 + 1); launch(kk0, kk0 + 1);
        if (k1 >= 0) { launch(kk0 + 1, k1 + 1); launch(k1, k1 + 1); if (k1 + 1 < NPHASES) launch(k1 + 1, NPHASES); }
        else if (kk0 + 1 < NPHASES) launch(kk0 + 1, NPHASES);
        (void)cuts; (void)nc;
#else
        a.ph_lo = 0; a.ph_hi = NPHASES; a.li = 0; hipLaunchKernelGGL(mk_fwd, dim3(grid), dim3(512), LDS_BYTES, stream, a);
#endif
    }
}
```
